# Optimizing an MI355X kernel written in HIP

```python
import math
import jax, jax.numpy as jnp
from jax import lax
import numpy as np


D_MODEL = 1024
BATCH = 8
SEQ = 4096
DEPTH = 2

PLE_DIM = 256
MLA_HEADS = 4
MLA_NOPE = 64
MLA_ROPE = 32
MLA_V = 64
MLA_Q_RANK = 192
MLA_KV_RANK = 128
MLA_OUT = MLA_HEADS * MLA_V
FOX_HEADS = 4
FOX_HEAD_DIM = 64
FOX_OUT = FOX_HEADS * FOX_HEAD_DIM
LRU_WIDTH = 512
LRU_BLOCKS = 8
LRU_BLOCK = LRU_WIDTH // LRU_BLOCKS
LRU_CONV = 4
LRU_C = 8.0
D_MIX = MLA_OUT + FOX_OUT + LRU_WIDTH
IN_SIZES = (MLA_Q_RANK, MLA_KV_RANK, MLA_ROPE, FOX_OUT, FOX_OUT, FOX_OUT, FOX_HEADS, LRU_WIDTH, LRU_WIDTH)
D_IN = MLA_Q_RANK + MLA_KV_RANK + MLA_ROPE + 3 * FOX_OUT + FOX_HEADS + 2 * LRU_WIDTH
D_FF = 2816
FFN_CONV = 3
ROPE_THETA = 10000.0
EPS = 1e-6
Q_BLOCK = 128

kernel_name = 'hybrid_mla_fox_rglru_convffn_ple'


def _offsets(sizes):
    out, acc = [], 0
    for s in sizes[:-1]:
        acc += s
        out.append(acc)
    return out


def rms_norm(x, g):
    xf = x.astype(jnp.float32)
    y = xf * lax.rsqrt(jnp.mean(xf * xf, axis=-1, keepdims=True) + EPS)
    return (y * g.astype(jnp.float32)).astype(x.dtype)


def rope(x, positions):
    half = x.shape[-1] // 2
    freqs = ROPE_THETA ** (-jnp.arange(half, dtype=jnp.float32) / half)
    ang = positions.astype(jnp.float32)[..., None] * freqs
    ang = ang.reshape(ang.shape[:2] + (1,) * (x.ndim - 3) + (half,))
    cos, sin = jnp.cos(ang), jnp.sin(ang)
    xf = x.astype(jnp.float32)
    x1, x2 = xf[..., :half], xf[..., half:]
    return jnp.concatenate([x1 * cos - x2 * sin, x2 * cos + x1 * sin], axis=-1).astype(x.dtype)


def causal_dwconv(x, w, b):
    K = w.shape[0]
    S = x.shape[1]
    xp = jnp.pad(x, ((0, 0), (K - 1, 0), (0, 0)))
    out = b + xp[:, 0:S] * w[0]
    for k in range(1, K):
        out = out + xp[:, k:k + S] * w[k]
    return out


def causal_block_attention(q, k, v, scale, decay=None):
    B, S, H, dk = q.shape
    dv = v.shape[-1]
    nb = S // Q_BLOCK
    qb = q.reshape(B, nb, Q_BLOCK, H, dk).transpose(1, 0, 3, 2, 4)
    kh = k.transpose(0, 2, 1, 3)
    vh = v.transpose(0, 2, 1, 3)
    k_pos = jnp.arange(S)
    blk_idx = jnp.arange(nb)
    ck = None if decay is None else decay.transpose(0, 2, 1)

    def block(q_blk, c_blk, idx):
        s = jnp.einsum('bhqd,bhkd->bhqk', q_blk, kh, preferred_element_type=jnp.float32) * scale
        if c_blk is not None:
            s = s + c_blk[..., :, None] - ck[..., None, :]
        q_pos = idx * Q_BLOCK + jnp.arange(Q_BLOCK)
        s = jnp.where(k_pos[None, :] <= q_pos[:, None], s, -jnp.inf)
        pr = jax.nn.softmax(s, axis=-1).astype(vh.dtype)
        return jnp.einsum('bhqk,bhkd->bhqd', pr, vh)

    if decay is None:
        out = lax.map(lambda a: block(a[0], None, a[1]), (qb, blk_idx))
    else:
        cb = ck.reshape(B, H, nb, Q_BLOCK).transpose(2, 0, 1, 3)
        out = lax.map(lambda a: block(a[0], a[1], a[2]), (qb, cb, blk_idx))
    return out.transpose(1, 0, 3, 2, 4).reshape(B, S, H, dv)


def _linear_combine(left, right):
    a_l, b_l = left
    a_r, b_r = right
    return a_l * a_r, a_r * b_l + b_r


def hybrid_mixer(xn, positions, w_in, g_qc, w_uq, g_kvc, w_ukv, b_f, lru_conv_w, lru_conv_b,
                 w_r, b_r, w_i, b_i, lru_lambda, g_out, w_o):
    B, S, _ = xn.shape
    z = xn @ w_in
    q_c, kv_c, k_r, fq, fk, fv, f_logit, lx, lg = jnp.split(z, _offsets(IN_SIZES), axis=-1)

    q = (rms_norm(q_c, g_qc) @ w_uq).reshape(B, S, MLA_HEADS, MLA_NOPE + MLA_ROPE)
    q = jnp.concatenate([q[..., :MLA_NOPE], rope(q[..., MLA_NOPE:], positions)], axis=-1)
    kv = (rms_norm(kv_c, g_kvc) @ w_ukv).reshape(B, S, MLA_HEADS, MLA_NOPE + MLA_V)
    k_nope, v_mla = kv[..., :MLA_NOPE], kv[..., MLA_NOPE:]
    k_rope = rope(k_r, positions)
    k = jnp.concatenate([k_nope, jnp.broadcast_to(k_rope[:, :, None, :], (B, S, MLA_HEADS, MLA_ROPE))], axis=-1)
    o_mla = causal_block_attention(q, k, v_mla, (MLA_NOPE + MLA_ROPE) ** -0.5).reshape(B, S, MLA_OUT)

    log_f = jax.nn.log_sigmoid(f_logit.astype(jnp.float32) + b_f.astype(jnp.float32))
    c = jnp.cumsum(log_f, axis=1)
    o_fox = causal_block_attention(fq.reshape(B, S, FOX_HEADS, FOX_HEAD_DIM),
                                   fk.reshape(B, S, FOX_HEADS, FOX_HEAD_DIM),
                                   fv.reshape(B, S, FOX_HEADS, FOX_HEAD_DIM),
                                   FOX_HEAD_DIM ** -0.5, decay=c).reshape(B, S, FOX_OUT)

    xc = causal_dwconv(lx, lru_conv_w, lru_conv_b)
    xblk = xc.reshape(B, S, LRU_BLOCKS, LRU_BLOCK)
    r = jax.nn.sigmoid(jnp.einsum('bsnc,ncd->bsnd', xblk, w_r).reshape(B, S, LRU_WIDTH) + b_r)
    i = jax.nn.sigmoid(jnp.einsum('bsnc,ncd->bsnd', xblk, w_i).reshape(B, S, LRU_WIDTH) + b_i)
    log_a = -LRU_C * r.astype(jnp.float32) * jax.nn.softplus(-lru_lambda.astype(jnp.float32))
    a_t = jnp.exp(log_a)
    bx = jnp.sqrt(-jnp.expm1(2.0 * log_a)) * (i * xc).astype(jnp.float32)
    _, h = lax.associative_scan(_linear_combine, (a_t, bx), axis=1)
    o_lru = h.astype(xn.dtype) * jax.nn.gelu(lg)

    o = jnp.concatenate([
        rms_norm(o_mla, g_out[:MLA_OUT]),
        rms_norm(o_fox, g_out[MLA_OUT:MLA_OUT + FOX_OUT]),
        rms_norm(o_lru, g_out[MLA_OUT + FOX_OUT:]),
    ], axis=-1)
    return o @ w_o


def conv_ffn(xn, w_up, ffn_conv_w, ffn_conv_b, w_down):
    u = causal_dwconv(xn @ w_up, ffn_conv_w, ffn_conv_b)
    g, v = jnp.split(u, 2, axis=-1)
    return (jax.nn.silu(g) * v) @ w_down


def per_layer_embedding(h, p_i, g_ple, w_ple_gate, w_ple_proj):
    return jax.nn.sigmoid(rms_norm(h, g_ple) @ w_ple_gate) * (p_i @ w_ple_proj)


def setup_inputs(seed: int = 0) -> dict:
    key = jax.random.key(seed)
    ks = iter(jax.random.split(key, 40))

    def nrm(shape, scale):
        return jax.random.normal(next(ks), shape, jnp.float32) * scale

    def gain(shape):
        return 1.0 + nrm(shape, 0.02)

    x = nrm((BATCH, SEQ, D_MODEL), 1.0)
    p = nrm((DEPTH, BATCH, SEQ, PLE_DIM), 1.0)
    offset = jax.random.randint(next(ks), (BATCH, 1), 0, 1024, dtype=jnp.int32)
    positions = (offset + jnp.arange(SEQ, dtype=jnp.int32)[None, :]).astype(jnp.int32)

    u = jax.random.uniform(next(ks), (DEPTH, LRU_WIDTH), jnp.float32, 0.9, 0.999)
    s = u ** (1.0 / LRU_C)
    lru_lambda = jnp.log(s) - jnp.log1p(-s)

    return {
        'x': x,
        'p': p,
        'positions': positions,
        'g_mix': gain((DEPTH, D_MODEL)),
        'w_in': nrm((DEPTH, D_MODEL, D_IN), D_MODEL ** -0.5),
        'g_qc': gain((DEPTH, MLA_Q_RANK)),
        'w_uq': nrm((DEPTH, MLA_Q_RANK, MLA_HEADS * (MLA_NOPE + MLA_ROPE)), MLA_Q_RANK ** -0.5),
        'g_kvc': gain((DEPTH, MLA_KV_RANK)),
        'w_ukv': nrm((DEPTH, MLA_KV_RANK, MLA_HEADS * (MLA_NOPE + MLA_V)), MLA_KV_RANK ** -0.5),
        'b_f': jax.random.uniform(next(ks), (DEPTH, FOX_HEADS), jnp.float32, 1.0, 4.0),
        'lru_conv_w': nrm((DEPTH, LRU_CONV, LRU_WIDTH), LRU_CONV ** -0.5),
        'lru_conv_b': nrm((DEPTH, LRU_WIDTH), 0.02),
        'w_r': nrm((DEPTH, LRU_BLOCKS, LRU_BLOCK, LRU_BLOCK), LRU_BLOCK ** -0.5),
        'b_r': nrm((DEPTH, LRU_WIDTH), 0.02),
        'w_i': nrm((DEPTH, LRU_BLOCKS, LRU_BLOCK, LRU_BLOCK), LRU_BLOCK ** -0.5),
        'b_i': nrm((DEPTH, LRU_WIDTH), 0.02),
        'lru_lambda': lru_lambda,
        'g_out': gain((DEPTH, D_MIX)),
        'w_o': nrm((DEPTH, D_MIX, D_MODEL), D_MIX ** -0.5),
        'g_ffn': gain((DEPTH, D_MODEL)),
        'w_up': nrm((DEPTH, D_MODEL, 2 * D_FF), D_MODEL ** -0.5),
        'ffn_conv_w': nrm((DEPTH, FFN_CONV, 2 * D_FF), FFN_CONV ** -0.5),
        'ffn_conv_b': nrm((DEPTH, 2 * D_FF), 0.02),
        'w_down': nrm((DEPTH, D_FF, D_MODEL), D_FF ** -0.5),
        'g_ple': gain((DEPTH, D_MODEL)),
        'w_ple_gate': nrm((DEPTH, D_MODEL, D_MODEL), D_MODEL ** -0.5),
        'w_ple_proj': nrm((DEPTH, PLE_DIM, D_MODEL), PLE_DIM ** -0.5),
        'g_final': gain((D_MODEL,)),
    }


def reference(x, p, positions, g_mix, w_in, g_qc, w_uq, g_kvc, w_ukv, b_f, lru_conv_w, lru_conv_b,
              w_r, b_r, w_i, b_i, lru_lambda, g_out, w_o, g_ffn, w_up, ffn_conv_w, ffn_conv_b,
              w_down, g_ple, w_ple_gate, w_ple_proj, g_final):
    h = x
    for l in range(DEPTH):
        h = h + hybrid_mixer(rms_norm(h, g_mix[l]), positions, w_in[l], g_qc[l], w_uq[l], g_kvc[l],
                             w_ukv[l], b_f[l], lru_conv_w[l], lru_conv_b[l], w_r[l], b_r[l], w_i[l],
                             b_i[l], lru_lambda[l], g_out[l], w_o[l])
        h = h + conv_ffn(rms_norm(h, g_ffn[l]), w_up[l], ffn_conv_w[l], ffn_conv_b[l], w_down[l])
        h = h + per_layer_embedding(h, p[l], g_ple[l], w_ple_gate[l], w_ple_proj[l])
    return rms_norm(h, g_final)
```

```cpp
#include <hip/hip_runtime.h>
#include <math.h>
#include <stdint.h>

constexpr int D = 1024, NB = 8, S = 4096, DEPTH = 2, PLE = 256;
constexpr int DIN = 2148;
constexpr int O_QC = 0, O_KVC = 192, O_KR = 320, O_FQ = 352, O_FK = 608, O_FV = 864, O_FL = 1120, O_LX = 1124, O_LG = 1636;
constexpr int DFF = 2816;
constexpr int LRU_W = 512;
constexpr float EPS = 1e-6f;
constexpr int MC = S;

__device__ __forceinline__ float wave_sum(float v) {
#pragma unroll
    for (int o = 1; o < 64; o <<= 1) v += __shfl_xor(v, o);
    return v;
}

__global__ void __launch_bounds__(256) rmsnorm_k(const float* in, int ldi, const float* g, float* out, int ldo, int rows, int cols) {
    const int row = blockIdx.x * 4 + (threadIdx.x >> 6), lane = threadIdx.x & 63;
    if (row >= rows) return;
    const float* x = in + (size_t)row * ldi;
    float s = 0.f;
    for (int c = lane; c < cols; c += 64) { const float v = x[c]; s += v * v; }
    s = wave_sum(s);
    const float r = rsqrtf(s / (float)cols + EPS);
    float* o = out + (size_t)row * ldo;
    for (int c = lane; c < cols; c += 64) o[c] = x[c] * r * g[c];
}

template <int MODE>
__global__ void __launch_bounds__(256) sgemm_k(const float* A, int lda, const float* Bm, int ldb, float* C, int ldc, const float* R, int ldr, int M, int N, int K) {
    __shared__ float As[8][128 + 4];
    __shared__ float Bs[8][128 + 4];
    const int tid = threadIdx.x, tx = tid & 15, ty = tid >> 4;
    const int m0 = blockIdx.y * 128, n0 = blockIdx.x * 128;
    float acc[8][8];
#pragma unroll
    for (int i = 0; i < 8; ++i)
#pragma unroll
        for (int j = 0; j < 8; ++j) acc[i][j] = 0.f;
    for (int k0 = 0; k0 < K; k0 += 8) {
        {
            const int r = tid >> 1, c = (tid & 1) * 4;
            const float4 v = *(const float4*)(A + (size_t)(m0 + r) * lda + k0 + c);
            As[c + 0][r] = v.x; As[c + 1][r] = v.y; As[c + 2][r] = v.z; As[c + 3][r] = v.w;
        }
        {
            const int r = tid >> 5, c = (tid & 31) * 4;
            float4 v = make_float4(0.f, 0.f, 0.f, 0.f);
            if (n0 + c < N) v = *(const float4*)(Bm + (size_t)(k0 + r) * ldb + n0 + c);
            *(float4*)&Bs[r][c] = v;
        }
        __syncthreads();
#pragma unroll
        for (int k = 0; k < 8; ++k) {
            const float4 a0 = *(const float4*)&As[k][ty * 4], a1 = *(const float4*)&As[k][64 + ty * 4];
            const float4 b0 = *(const float4*)&Bs[k][tx * 4], b1 = *(const float4*)&Bs[k][64 + tx * 4];
            const float a[8] = {a0.x, a0.y, a0.z, a0.w, a1.x, a1.y, a1.z, a1.w};
            const float b[8] = {b0.x, b0.y, b0.z, b0.w, b1.x, b1.y, b1.z, b1.w};
#pragma unroll
            for (int i = 0; i < 8; ++i)
#pragma unroll
                for (int j = 0; j < 8; ++j) acc[i][j] += a[i] * b[j];
        }
        __syncthreads();
    }
#pragma unroll
    for (int i = 0; i < 8; ++i) {
        const int row = m0 + (i >> 2) * 64 + ty * 4 + (i & 3);
#pragma unroll
        for (int jh = 0; jh < 2; ++jh) {
            const int col = n0 + jh * 64 + tx * 4;
            if (col < N) {
                float4 v = make_float4(acc[i][jh * 4 + 0], acc[i][jh * 4 + 1], acc[i][jh * 4 + 2], acc[i][jh * 4 + 3]);
                if (MODE == 1) { const float4 r = *(const float4*)(R + (size_t)row * ldr + col); v.x += r.x; v.y += r.y; v.z += r.z; v.w += r.w; }
                *(float4*)(C + (size_t)row * ldc + col) = v;
            }
        }
    }
}

__device__ __forceinline__ void rope_pair(float x1, float x2, int pos, int i, float& o1, float& o2) {
    const float freq = powf(10000.0f, -(float)i / 16.0f);
    const float ang = (float)pos * freq;
    const float c = cosf(ang), s = sinf(ang);
    o1 = x1 * c - x2 * s; o2 = x2 * c + x1 * s;
}

__global__ void __launch_bounds__(256) mla_assemble_k(const float* qraw  , const float* kvraw  , const float* z  , const int* pos  ,
                                                       float* q  , float* k  , float* v  ) {
    const int idx = blockIdx.x * 256 + threadIdx.x;
    if (idx >= MC * 384) return;
    const int row = idx / 384, rem = idx % 384, h = rem / 96, j = rem % 96;
    const int p = pos[row];
    const float* qr = qraw + (size_t)row * 384 + h * 96;
    if (j < 64) {
        q[idx] = qr[j];
        k[idx] = kvraw[(size_t)row * 512 + h * 128 + j];
        v[(size_t)row * 256 + h * 64 + j] = kvraw[(size_t)row * 512 + h * 128 + 64 + j];
    } else {
        const int jj = j - 64;
        const int i = jj & 15;
        float o1, o2;
        rope_pair(qr[64 + i], qr[64 + 16 + i], p, i, o1, o2);
        q[idx] = (jj < 16) ? o1 : o2;
        const float* kr = z + (size_t)row * DIN + O_KR;
        rope_pair(kr[i], kr[16 + i], p, i, o1, o2);
        k[idx] = (jj < 16) ? o1 : o2;
    }
}

__global__ void __launch_bounds__(1024) fox_cumsum_k(const float* z, const float* b_f, float* cc  ) {
    __shared__ float part[256][4];
    const int h = threadIdx.x & 3, seg = threadIdx.x >> 2;
    const float bf = b_f[h];
    float lf[16]; float s = 0.f;
#pragma unroll
    for (int i = 0; i < 16; ++i) {
        const float x = z[(size_t)(seg * 16 + i) * DIN + O_FL + h] + bf;
        lf[i] = fminf(x, 0.f) - log1pf(expf(-fabsf(x)));
        s += lf[i];
    }
    part[seg][h] = s;
    __syncthreads();
    if (threadIdx.x < 4) { float run = 0.f; for (int i = 0; i < 256; ++i) { const float t = part[i][threadIdx.x]; part[i][threadIdx.x] = run; run += t; } }
    __syncthreads();
    float run = part[seg][h];
#pragma unroll
    for (int i = 0; i < 16; ++i) { run += lf[i]; cc[(size_t)(seg * 16 + i) * 4 + h] = run; }
}

template <int DK, int DV, bool BIAS>
__global__ void __launch_bounds__(256) attn_k(const float* Q, int ldq, const float* Kp, int ldk, const float* V, int ldv, const float* cc  , float* O, int ldo, float scale) {
    __shared__ float Qt[DK * 68];
    __shared__ float Kt[DK * 36];
    __shared__ float Vs[32 * (DV + 4)];
    __shared__ float Pt[32 * 68];
    const int tid = threadIdx.x, tx = tid & 15, ty = tid >> 4;
    const int qb = blockIdx.x, h = blockIdx.y;
    const int q0 = qb * 64;
    for (int idx = tid; idx < 64 * DK; idx += 256) { const int r = idx / DK, d = idx % DK; Qt[d * 68 + r] = Q[(size_t)(q0 + r) * ldq + h * DK + d] * scale; }
    float m[4], l[4], o[4][4], cq[4];
#pragma unroll
    for (int i = 0; i < 4; ++i) { m[i] = -INFINITY; l[i] = 0.f; cq[i] = BIAS ? cc[(size_t)(q0 + ty * 4 + i) * 4 + h] : 0.f;
#pragma unroll
        for (int j = 0; j < 4; ++j) o[i][j] = 0.f; }
    const int nkt = 2 * qb + 2;
    for (int kb = 0; kb < nkt; ++kb) {
        const int k0 = kb * 32;
        __syncthreads();
        for (int idx = tid; idx < 32 * DK; idx += 256) { const int r = idx / DK, d = idx % DK; Kt[d * 36 + r] = Kp[(size_t)(k0 + r) * ldk + h * DK + d]; }
        for (int idx = tid; idx < 32 * DV; idx += 256) { const int r = idx / DV, d = idx % DV; Vs[r * (DV + 4) + d] = V[(size_t)(k0 + r) * ldv + h * DV + d]; }
        __syncthreads();
        float s[4][2];
#pragma unroll
        for (int i = 0; i < 4; ++i) { s[i][0] = 0.f; s[i][1] = 0.f; }
#pragma unroll 4
        for (int d = 0; d < DK; ++d) {
            const float4 a = *(const float4*)&Qt[d * 68 + ty * 4]; const float2 b = *(const float2*)&Kt[d * 36 + tx * 2];
            const float av[4] = {a.x, a.y, a.z, a.w};
#pragma unroll
            for (int i = 0; i < 4; ++i) { s[i][0] += av[i] * b.x; s[i][1] += av[i] * b.y; }
        }
        float ck[2];
#pragma unroll
        for (int j = 0; j < 2; ++j) ck[j] = BIAS ? cc[(size_t)(k0 + tx * 2 + j) * 4 + h] : 0.f;
#pragma unroll
        for (int i = 0; i < 4; ++i) {
            float rm = -INFINITY;
#pragma unroll
            for (int j = 0; j < 2; ++j) {
                if (BIAS) s[i][j] += cq[i] - ck[j];
                if (k0 + tx * 2 + j > q0 + ty * 4 + i) s[i][j] = -INFINITY;
                rm = fmaxf(rm, s[i][j]);
            }
#pragma unroll
            for (int off = 1; off < 16; off <<= 1) rm = fmaxf(rm, __shfl_xor(rm, off));
            const float mn = fmaxf(m[i], rm);
            const float alpha = expf(m[i] - mn);
            float rs = 0.f;
#pragma unroll
            for (int j = 0; j < 2; ++j) { const float p = expf(s[i][j] - mn); s[i][j] = p; rs += p; }
#pragma unroll
            for (int off = 1; off < 16; off <<= 1) rs += __shfl_xor(rs, off);
            l[i] = l[i] * alpha + rs; m[i] = mn;
#pragma unroll
            for (int j = 0; j < 4; ++j) o[i][j] *= alpha;
        }
#pragma unroll
        for (int j = 0; j < 2; ++j) *(float4*)&Pt[(tx * 2 + j) * 68 + ty * 4] = make_float4(s[0][j], s[1][j], s[2][j], s[3][j]);
        __syncthreads();
#pragma unroll 4
        for (int kk = 0; kk < 32; ++kk) {
            const float4 p = *(const float4*)&Pt[kk * 68 + ty * 4], vv = *(const float4*)&Vs[kk * (DV + 4) + tx * 4];
            const float pv[4] = {p.x, p.y, p.z, p.w}, vw[4] = {vv.x, vv.y, vv.z, vv.w};
#pragma unroll
            for (int i = 0; i < 4; ++i)
#pragma unroll
                for (int j = 0; j < 4; ++j) o[i][j] += pv[i] * vw[j];
        }
    }
#pragma unroll
    for (int i = 0; i < 4; ++i) { const float inv = 1.f / l[i];
        *(float4*)(O + (size_t)(q0 + ty * 4 + i) * ldo + h * DV + tx * 4) = make_float4(o[i][0] * inv, o[i][1] * inv, o[i][2] * inv, o[i][3] * inv); }
}

__global__ void __launch_bounds__(256) lru_conv_k(const float* z, const float* cw  , const float* cb, float* xc  ) {
    const int idx = blockIdx.x * 256 + threadIdx.x; if (idx >= MC * LRU_W) return;
    const int t = idx / LRU_W, c = idx % LRU_W;
    float acc = cb[c];
#pragma unroll
    for (int k = 0; k < 4; ++k) { const int tt = t - 3 + k; if (tt >= 0) acc += cw[k * LRU_W + c] * z[(size_t)tt * DIN + O_LX + c]; }
    xc[idx] = acc;
}
__device__ __forceinline__ float sigmoidf_(float x) { return 1.f / (1.f + expf(-x)); }
__global__ void __launch_bounds__(256) lru_gate_k(const float* xc, const float* rpre, const float* ipre, const float* b_r, const float* b_i, const float* lam, float* a, float* bx) {
    const int idx = blockIdx.x * 256 + threadIdx.x; if (idx >= MC * LRU_W) return;
    const int c = idx % LRU_W;
    const float r = sigmoidf_(rpre[idx] + b_r[c]), ig = sigmoidf_(ipre[idx] + b_i[c]);
    const float nl = -lam[c];
    const float sp = fmaxf(nl, 0.f) + log1pf(expf(-fabsf(nl)));
    const float log_a = -8.0f * r * sp;
    a[idx] = expf(log_a);
    bx[idx] = sqrtf(-expm1f(2.0f * log_a)) * (ig * xc[idx]);
}
__device__ __forceinline__ float gelu_tanh(float x) { return 0.5f * x * (1.f + tanhf(0.7978845608028654f * (x + 0.044715f * x * x * x))); }
__global__ void __launch_bounds__(1024) lru_scan_k(const float* a, const float* bx, const float* z, float* olru  ) {
    __shared__ float sA[16][64], sH[16][64];
    const int cl = threadIdx.x & 63, seg = threadIdx.x >> 6, c = blockIdx.x * 64 + cl;
    float A = 1.f, H = 0.f;
    for (int i = 0; i < 256; ++i) { const size_t idx = (size_t)(seg * 256 + i) * LRU_W + c; const float av = a[idx]; H = av * H + bx[idx]; A *= av; }
    sA[seg][cl] = A; sH[seg][cl] = H;
    __syncthreads();
    if (seg == 0) { float run = 0.f; for (int s2 = 0; s2 < 16; ++s2) { const float t = sH[s2][cl], aa = sA[s2][cl]; sH[s2][cl] = run; run = aa * run + t; } }
    __syncthreads();
    H = sH[seg][cl];
    for (int i = 0; i < 256; ++i) { const int t = seg * 256 + i; const size_t idx = (size_t)t * LRU_W + c; H = a[idx] * H + bx[idx]; olru[(size_t)t * D + c] = H * gelu_tanh(z[(size_t)t * DIN + O_LG + c]); }
}

__global__ void __launch_bounds__(256) ffn_act_k(const float* u  , const float* cw  , const float* cb, float* act  ) {
    const int idx = blockIdx.x * 256 + threadIdx.x; if (idx >= MC * DFF) return;
    const int t = idx / DFF, j = idx % DFF;
    float g = cb[j], v = cb[DFF + j];
#pragma unroll
    for (int k = 0; k < 3; ++k) { const int tt = t - 2 + k; if (tt >= 0) { g += cw[k * 2 * DFF + j] * u[(size_t)tt * 2 * DFF + j]; v += cw[k * 2 * DFF + DFF + j] * u[(size_t)tt * 2 * DFF + DFF + j]; } }
    act[idx] = g / (1.f + expf(-g)) * v;
}
__global__ void __launch_bounds__(256) ple_fin_k(float* h, const float* gbuf, const float* pbuf) {
    const int idx = blockIdx.x * 256 + threadIdx.x; if (idx >= MC * D) return;
    h[idx] = h[idx] + sigmoidf_(gbuf[idx]) * pbuf[idx];
}

template <int MODE>
void gemm(hipStream_t st, const float* A, int lda, const float* Bm, int ldb, float* C, int ldc, const float* R, int ldr, int M, int N, int K) {
    dim3 grid((N + 127) / 128, M / 128);
    hipLaunchKernelGGL(sgemm_k<MODE>, grid, dim3(256), 0, st, A, lda, Bm, ldb, C, ldc, R, ldr, M, N, K);
}

extern "C" void kernel_launch(void* const* d_in, const int* in_sizes, int n_in, void* d_out, int out_size, void* d_ws, size_t ws_size, hipStream_t stream) {
    const float* x = (const float*)d_in[0];
    const float* p = (const float*)d_in[1];
    const int* positions = (const int*)d_in[2];
    const float* g_mix = (const float*)d_in[3];
    const float* w_in = (const float*)d_in[4];
    const float* g_qc = (const float*)d_in[5];
    const float* w_uq = (const float*)d_in[6];
    const float* g_kvc = (const float*)d_in[7];
    const float* w_ukv = (const float*)d_in[8];
    const float* b_f = (const float*)d_in[9];
    const float* lru_conv_w = (const float*)d_in[10];
    const float* lru_conv_b = (const float*)d_in[11];
    const float* w_r = (const float*)d_in[12];
    const float* b_r = (const float*)d_in[13];
    const float* w_i = (const float*)d_in[14];
    const float* b_i = (const float*)d_in[15];
    const float* lru_lambda = (const float*)d_in[16];
    const float* g_out = (const float*)d_in[17];
    const float* w_o = (const float*)d_in[18];
    const float* g_ffn = (const float*)d_in[19];
    const float* w_up = (const float*)d_in[20];
    const float* ffn_conv_w = (const float*)d_in[21];
    const float* ffn_conv_b = (const float*)d_in[22];
    const float* w_down = (const float*)d_in[23];
    const float* g_ple = (const float*)d_in[24];
    const float* w_ple_gate = (const float*)d_in[25];
    const float* w_ple_proj = (const float*)d_in[26];
    const float* g_final = (const float*)d_in[27];
    float* out = (float*)d_out;

    float* w = (float*)d_ws;
    size_t off = 0;
    auto take = [&](size_t n) { float* r = w + off; off += (n + 63) & ~(size_t)63; return r; };
    float* xn = take((size_t)MC * D);
    float* z = take((size_t)MC * DIN);
    float* t192 = take((size_t)MC * 192);
    float* t128 = take((size_t)MC * 128);
    float* qraw = take((size_t)MC * 384);
    float* kvraw = take((size_t)MC * 512);
    float* qm = take((size_t)MC * 384);
    float* km = take((size_t)MC * 384);
    float* vm = take((size_t)MC * 256);
    float* cc = take((size_t)MC * 4);
    float* ob = take((size_t)MC * D);
    float* on = take((size_t)MC * D);
    float* xc = take((size_t)MC * LRU_W);
    float* rpre = take((size_t)MC * LRU_W);
    float* ipre = take((size_t)MC * LRU_W);
    float* av = take((size_t)MC * LRU_W);
    float* bxv = take((size_t)MC * LRU_W);
    float* u = take((size_t)MC * 2 * DFF);
    float* act = take((size_t)MC * DFF);
    float* gbuf = take((size_t)MC * D);
    float* pbuf = take((size_t)MC * D);

    (void)hipMemcpyAsync(out, x, (size_t)NB * S * D * sizeof(float), hipMemcpyDeviceToDevice, stream);

    for (int b = 0; b < NB; ++b) {
        float* h = out + (size_t)b * S * D;
        const int* pos = positions + (size_t)b * S;
        for (int l = 0; l < DEPTH; ++l) {
            hipLaunchKernelGGL(rmsnorm_k, dim3(MC / 4), dim3(256), 0, stream, h, D, g_mix + l * D, xn, D, MC, D);
            gemm<0>(stream, xn, D, w_in + (size_t)l * D * DIN, DIN, z, DIN, nullptr, 0, MC, DIN, D);
            hipLaunchKernelGGL(rmsnorm_k, dim3(MC / 4), dim3(256), 0, stream, z + O_QC, DIN, g_qc + l * 192, t192, 192, MC, 192);
            gemm<0>(stream, t192, 192, w_uq + (size_t)l * 192 * 384, 384, qraw, 384, nullptr, 0, MC, 384, 192);
            hipLaunchKernelGGL(rmsnorm_k, dim3(MC / 4), dim3(256), 0, stream, z + O_KVC, DIN, g_kvc + l * 128, t128, 128, MC, 128);
            gemm<0>(stream, t128, 128, w_ukv + (size_t)l * 128 * 512, 512, kvraw, 512, nullptr, 0, MC, 512, 128);
            hipLaunchKernelGGL(mla_assemble_k, dim3(MC * 384 / 256), dim3(256), 0, stream, qraw, kvraw, z, pos, qm, km, vm);
            hipLaunchKernelGGL((attn_k<96, 64, false>), dim3(S / 64, 4), dim3(256), 0, stream, qm, 384, km, 384, vm, 256, nullptr, ob, D, 0.10206207261596577f);
            hipLaunchKernelGGL(fox_cumsum_k, dim3(1), dim3(1024), 0, stream, z, b_f + l * 4, cc);
            hipLaunchKernelGGL((attn_k<64, 64, true>), dim3(S / 64, 4), dim3(256), 0, stream, z + O_FQ, DIN, z + O_FK, DIN, z + O_FV, DIN, cc, ob + 256, D, 0.125f);
            hipLaunchKernelGGL(lru_conv_k, dim3(MC * LRU_W / 256), dim3(256), 0, stream, z, lru_conv_w + (size_t)l * 4 * LRU_W, lru_conv_b + l * LRU_W, xc);
            for (int n = 0; n < 8; ++n) {
                gemm<0>(stream, xc + n * 64, LRU_W, w_r + ((size_t)l * 8 + n) * 64 * 64, 64, rpre + n * 64, LRU_W, nullptr, 0, MC, 64, 64);
                gemm<0>(stream, xc + n * 64, LRU_W, w_i + ((size_t)l * 8 + n) * 64 * 64, 64, ipre + n * 64, LRU_W, nullptr, 0, MC, 64, 64);
            }
            hipLaunchKernelGGL(lru_gate_k, dim3(MC * LRU_W / 256), dim3(256), 0, stream, xc, rpre, ipre, b_r + l * LRU_W, b_i + l * LRU_W, lru_lambda + l * LRU_W, av, bxv);
            hipLaunchKernelGGL(lru_scan_k, dim3(8), dim3(1024), 0, stream, av, bxv, z, ob + 512);
            hipLaunchKernelGGL(rmsnorm_k, dim3(MC / 4), dim3(256), 0, stream, ob, D, g_out + l * D, on, D, MC, 256);
            hipLaunchKernelGGL(rmsnorm_k, dim3(MC / 4), dim3(256), 0, stream, ob + 256, D, g_out + l * D + 256, on + 256, D, MC, 256);
            hipLaunchKernelGGL(rmsnorm_k, dim3(MC / 4), dim3(256), 0, stream, ob + 512, D, g_out + l * D + 512, on + 512, D, MC, 512);
            gemm<1>(stream, on, D, w_o + (size_t)l * D * D, D, h, D, h, D, MC, D, D);
            hipLaunchKernelGGL(rmsnorm_k, dim3(MC / 4), dim3(256), 0, stream, h, D, g_ffn + l * D, xn, D, MC, D);
            gemm<0>(stream, xn, D, w_up + (size_t)l * D * 2 * DFF, 2 * DFF, u, 2 * DFF, nullptr, 0, MC, 2 * DFF, D);
            hipLaunchKernelGGL(ffn_act_k, dim3(MC * DFF / 256), dim3(256), 0, stream, u, ffn_conv_w + (size_t)l * 3 * 2 * DFF, ffn_conv_b + (size_t)l * 2 * DFF, act);
            gemm<1>(stream, act, DFF, w_down + (size_t)l * DFF * D, D, h, D, h, D, MC, D, DFF);
            hipLaunchKernelGGL(rmsnorm_k, dim3(MC / 4), dim3(256), 0, stream, h, D, g_ple + l * D, xn, D, MC, D);
            gemm<0>(stream, xn, D, w_ple_gate + (size_t)l * D * D, D, gbuf, D, nullptr, 0, MC, D, D);
            gemm<0>(stream, p + ((size_t)l * NB + b) * S * PLE, PLE, w_ple_proj + (size_t)l * PLE * D, D, pbuf, D, nullptr, 0, MC, D, PLE);
            hipLaunchKernelGGL(ple_fin_k, dim3(MC * D / 256), dim3(256), 0, stream, h, gbuf, pbuf);
        }
        hipLaunchKernelGGL(rmsnorm_k, dim3(MC / 4), dim3(256), 0, stream, h, D, g_final, h, D, MC, D);
    }
}
```

```cpp
#include <hip/hip_runtime.h>
#include <cstdio>
#include <cstdint>
#include <math.h>
constexpr int D = 1024, NB = 8, S = 4096, DEPTH = 2, PLE = 256, M = NB * S;
constexpr int DIN = 2148, DINP = 2304;
constexpr int O_QC = 0, O_KVC = 192, O_KR = 320, O_FQ = 352, O_FK = 608, O_FV = 864, O_LX = 1120, O_LG = 1632, O_FL = 2144;
constexpr int DFF = 2816, LRU_W = 512;
constexpr float EPS = 1e-6f;
constexpr int NWAVES = 8;
constexpr size_t MiB = 1u << 20;
constexpr size_t WS_CTL = 0, CTL_ZERO_BYTES = 1 * MiB;
constexpr size_t WS_SSA = 1 * MiB, WS_SSB = 3 * MiB, WS_FL = 5 * MiB, WS_CBX = 5632 * 1024, WS_CWT = 6 * MiB, WS_LRUSUM = 6656 * 1024, WS_ROPE = 7680 * 1024;
constexpr size_t WS_W = 12 * MiB, W_LAYER = 27 * MiB;
constexpr size_t W_IN = 0, W_UQ = 4608 * 1024, W_UKV = 4864 * 1024, W_R = 5120 * 1024, W_I = 5184 * 1024, W_O = 5632 * 1024, W_UP = 7680 * 1024, W_DN = 18944 * 1024, W_PG = 24576 * 1024, W_PP = 26624 * 1024;
constexpr size_t WS_HB = 68 * MiB;
constexpr size_t WS_PB = 133 * MiB;
constexpr size_t WS_PP = 165 * MiB;
constexpr size_t WS_Z = 229 * MiB;
constexpr size_t WS_Q = 373 * MiB, WS_K = 397 * MiB, WS_V = 421 * MiB;
constexpr size_t WS_O = 437 * MiB;
constexpr size_t WS_ACT = 229 * MiB;
constexpr size_t WS_END = 501 * MiB;
static_assert(WS_ACT + (size_t)M * DFF * 2 <= WS_O && WS_O + (size_t)M * D * 2 <= WS_END && WS_W + 2 * W_LAYER <= WS_HB - MiB && WS_HB + (size_t)(M + 256) * D * 2 <= WS_PB, "ws map");
constexpr int CW_BAR = 4096;
constexpr int RING_OFF = 0, RING_BYTES = 131072;
constexpr int LDSCTL_OFF = RING_BYTES, MISC_OFF = LDSCTL_OFF + 320;
constexpr int LDS_BYTES = 163840, LRU_TAB_OFF = 147456;

struct Args { const float* in[28]; float* out; unsigned char* ws; int ph_lo, ph_hi, pad0, pad1; };


typedef const __attribute__((address_space(4))) Args* KArgs;
__device__ __forceinline__ KArgs kargs() { KArgs p = (KArgs)__builtin_amdgcn_kernarg_segment_ptr(); asm volatile("" : "+s"(p)); return p; }
__device__ __forceinline__ int lane_id() { int r; asm volatile("v_mbcnt_lo_u32_b32 %0, -1, 0\n\tv_mbcnt_hi_u32_b32 %0, -1, %0" : "=v"(r)); return r; }
__device__ __forceinline__ float lshfl(float v, int src_lane) { return __builtin_bit_cast(float, __builtin_amdgcn_ds_bpermute(src_lane << 2, __builtin_bit_cast(int, v))); }
__device__ __forceinline__ double lshfl(double v, int src_lane) { const unsigned long long u = __builtin_bit_cast(unsigned long long, v);
    const unsigned lo = (unsigned)__builtin_amdgcn_ds_bpermute(src_lane << 2, (int)(unsigned)u), hi = (unsigned)__builtin_amdgcn_ds_bpermute(src_lane << 2, (int)(unsigned)(u >> 32));
    return __builtin_bit_cast(double, ((unsigned long long)hi << 32) | lo); }
__device__ __forceinline__ float wave_sum(float v, int lane) {
#pragma unroll
    for (int o = 1; o < 64; o <<= 1) v += lshfl(v, lane ^ o);
    return v;
}
namespace pg8 {
#define PG8_LAS __attribute__((address_space(3)))
typedef unsigned short bf16_t;
typedef short bf16x8 __attribute__((ext_vector_type(8)));
typedef float f32x4 __attribute__((ext_vector_type(4)));
typedef unsigned u32x4 __attribute__((ext_vector_type(4)));
constexpr int BM = 256, BK = 64, HALF = 128, HTB = HALF * BK * 2  , STAGE_BYTES = 8 * HTB, NXCD = 8, WGM = 8;

__host__ __device__ __forceinline__ int lds_byte(int r, int c) { const int st = (r >> 4) * 2 + (c >> 5), rr = r & 15, cc = c & 31, ob = rr * 64 + cc * 2; return st * 1024 + (ob ^ (((ob >> 9) & 1) << 5)); }
__host__ __device__ __forceinline__ void stage_rc(int b, int& R, int& C) { const int st = b / 1024, sb = b % 1024, swz = sb ^ (((sb >> 9) & 1) << 5); R = (st >> 1) * 16 + swz / 64; C = (st & 1) * 32 + (swz % 64) / 2; }
__host__ __device__ __forceinline__ int perm32(int rho) { const int n = rho >> 4, i = rho & 15; return 8 * (i >> 2) + 4 * n + (i & 3); }

struct Unit { int pm, pn, par; };
struct Gemm { const bf16_t* A; const bf16_t* Bt; int M, N, K; };

struct StaticOrder {
    int nM, nN, nwg, G, c;
    __host__ __device__ void init(int M, int N, int G_, int c_) { nM = M / BM; nN = N / BM; nwg = nM * nN; G = G_; c = c_; }
    __host__ __device__ bool next(int i, Unit& u) const {
        const long L = (long)i * G + c; if (L >= nwg) return false;
        int wgid = (int)L; { const int q = nwg / NXCD, r = nwg % NXCD, xcd = wgid % NXCD, off = wgid / NXCD; wgid = (xcd < r ? xcd * (q + 1) : r * (q + 1) + (xcd - r) * q) + off; }
        const int nig = WGM * nN, gid = wgid / nig, fm = gid * WGM, gsz = (nM - fm) < WGM ? (nM - fm) : WGM;
        u.pm = fm + ((wgid % nig) % gsz); u.pn = (wgid % nig) / gsz; u.par = i & 1; return true;
    }
    __device__ __forceinline__ void a_ready(const Unit&) const {}
    __device__ __forceinline__ void done(const Unit&) const {}
};
struct TailOrder : StaticOrder {
    int c0, u0, u1;
    __host__ __device__ bool next(int i, Unit& u) const {
        if (c < c0) return false;
        const int Lu = u0 + i * (G - c0) + (c - c0); if (Lu >= u1) return false;
        u.pm = Lu / nN; u.pn = Lu % nN; u.par = i & 1; return true;
    }
};
constexpr int RSTD_TBL_OFF = 131072 + 1024;
constexpr int CWT_TBL_OFF = RSTD_TBL_OFF + 2048;
struct StatOrder : StaticOrder {
    int ss_sel, row62, wave, cwt_layer;
    __device__ __forceinline__ void a_ready(const Unit& u) const {
        if (wave < 4) { const int t = wave * 64 + lane_id();
            int row = row62 ? 248 * u.pm + 62 * (t >> 6) + (4 * (t & 15) + ((t >> 4) & 3)) - 2 : BM * u.pm + t; row = row < 0 ? 0 : (row > 32767 ? 32767 : row);
            const f32x4* p = (const f32x4*)((const float*)(kargs()->ws + (ss_sel ? WS_SSB : WS_SSA)) + (size_t)row * 16);
            const f32x4 a = p[0], b = p[1], c = p[2], d = p[3];
            const float s = (((a[0] + a[1]) + (a[2] + a[3])) + ((b[0] + b[1]) + (b[2] + b[3]))) + (((c[0] + c[1]) + (c[2] + c[3])) + ((d[0] + d[1]) + (d[2] + d[3])));
            ((PG8_LAS float*)(uintptr_t)RSTD_TBL_OFF)[u.par * 256 + t] = rsqrtf(s * (1.0f / 1024.0f) + 1e-6f); }
        else if (row62) { const int t = (wave - 4) * 64 + lane_id();
            const u32x4 v = *(const u32x4*)(kargs()->ws + WS_CWT + (size_t)cwt_layer * 90112 + (size_t)u.pn * 4096 + t * 16);
            *(PG8_LAS u32x4*)(uintptr_t)(CWT_TBL_OFF + u.par * 4096 + t * 16) = v; }
    }
};
__device__ __forceinline__ float rstd_tbl(const Unit& u, int row_in_tile) { return ((const PG8_LAS float*)(uintptr_t)RSTD_TBL_OFF)[u.par * 256 + row_in_tile]; }
typedef __bf16 bf2_t __attribute__((ext_vector_type(2)));
typedef float fl2_t __attribute__((ext_vector_type(2)));
__device__ __forceinline__ unsigned cvt_pk_bf16(float lo, float hi) { const fl2_t v = {lo, hi}; return __builtin_bit_cast(unsigned, __builtin_convertvector(v, bf2_t)); }
typedef float f32x2 __attribute__((ext_vector_type(2)));
__device__ __forceinline__ f32x2 gelu_pk(f32x2 v) {
    const f32x2 av = __builtin_elementwise_abs(v), d = av * 0.2316418882f + 1.0f;
    f32x2 t; t.x = __builtin_amdgcn_rcpf(d.x); t.y = __builtin_amdgcn_rcpf(d.y);
    f32x2 q = t * 0.5307027145f + (-0.7265760135f); q = q * t + 0.7107068705f; q = q * t + (-0.142248368f); q = q * t + 0.127414796f; q = q * t;
    const f32x2 s = (v * v) * (-0.72134752044f);
    f32x2 e; e.x = __builtin_amdgcn_exp2f(s.x); e.y = __builtin_amdgcn_exp2f(s.y);
    const f32x2 m = v * (q * e), r = v - m;
    f32x2 o; o.x = v.x < 0.f ? m.x : r.x; o.y = v.y < 0.f ? m.y : r.y; return o;
}
template <int ACT  > struct EpiBf16 {
    static constexpr bool PERM = true, AFTER_DRAIN = false; static_assert(ACT == 0 || ACT == 1, "EpiBf16: ACT is 0 (none) or 1 (gelu_pk)");
    bf16_t* O; int ldc; const float* bias; int split_cols; size_t split_stride; float scale0;
    __device__ __forceinline__ void operator()(const f32x4 (&acc)[2][2][4][2], const Unit& u, int wr, int wc, int fr, int fq) const {
        const int row0 = u.pm * BM + wr * 64 + fr; int colt = u.pn * BM; bf16_t* base = O;
        float sc = 1.f; if (split_cols) { const int t = colt / split_cols; base += (size_t)t * split_stride; colt -= t * split_cols; if (t == 0) sc = scale0; }
        const int col0 = colt + wc * 32 + 8 * fq, bcol0 = u.pn * BM + wc * 32 + 8 * fq;
        f32x4 bv[2][2];
#pragma unroll
        for (int bj = 0; bj < 2; ++bj)
#pragma unroll
            for (int n = 0; n < 2; ++n) bv[bj][n] = bias ? *(const f32x4*)(bias + bcol0 + bj * HALF + 4 * n) : (f32x4){0.f, 0.f, 0.f, 0.f};
#pragma unroll
        for (int ai = 0; ai < 2; ++ai)
#pragma unroll
            for (int m = 0; m < 4; ++m) { bf16_t* rowp = base + (size_t)(row0 + ai * HALF + m * 16) * ldc + col0;
#pragma unroll
                for (int bj = 0; bj < 2; ++bj) { f32x4 v0 = acc[ai][bj][m][0] + bv[bj][0], v1 = acc[ai][bj][m][1] + bv[bj][1];
                    if (ACT == 1) { f32x2 a = gelu_pk((f32x2){v0[0], v0[1]}), b = gelu_pk((f32x2){v0[2], v0[3]}), c = gelu_pk((f32x2){v1[0], v1[1]}), d = gelu_pk((f32x2){v1[2], v1[3]});
                        v0 = (f32x4){a.x, a.y, b.x, b.y}; v1 = (f32x4){c.x, c.y, d.x, d.y}; }
                    v0 = v0 * sc; v1 = v1 * sc; u32x4 w; w.x = cvt_pk_bf16(v0[0], v0[1]); w.y = cvt_pk_bf16(v0[2], v0[3]); w.z = cvt_pk_bf16(v1[0], v1[1]); w.w = cvt_pk_bf16(v1[2], v1[3]);
                    *(u32x4*)(rowp + bj * HALF) = w; } }
    }
};


constexpr float RMS_EPS = 1e-6f;
constexpr int TOK = 32768;
typedef unsigned u32x2 __attribute__((ext_vector_type(2)));
__device__ __forceinline__ float rstd16(const float* SS, int row) {
    const f32x4* p = (const f32x4*)(SS + (size_t)row * 16);
    const f32x4 a = p[0], b = p[1], c = p[2], d = p[3];
    const float s = (((a[0] + a[1]) + (a[2] + a[3])) + ((b[0] + b[1]) + (b[2] + b[3]))) + (((c[0] + c[1]) + (c[2] + c[3])) + ((d[0] + d[1]) + (d[2] + d[3])));
    return rsqrtf(s * (1.0f / 1024.0f) + RMS_EPS);
}
__device__ __forceinline__ float bf_lo(unsigned w) { return __uint_as_float(w << 16); }
__device__ __forceinline__ float bf_hi(unsigned w) { return __uint_as_float(w & 0xffff0000u); }
struct EpiPlain {
    static constexpr bool PERM = true, AFTER_DRAIN = false;
    size_t ws_off; int ldc;
    __device__ __forceinline__ void operator()(const f32x4 (&acc)[2][2][4][2], const Unit& u, int wr, int wc, int fr_, int fq_) const {
        int lane_ = lane_id(); asm volatile("" : "+v"(lane_)); const int fr = lane_ & 15, fq = lane_ >> 4;
        const KArgs ka = kargs(); bf16_t* O = (bf16_t*)(ka->ws + ws_off);
        const int row0 = u.pm * BM + wr * 64 + fr, col0 = u.pn * BM + wc * 32 + 8 * fq;
#pragma unroll
        for (int ai = 0; ai < 2; ++ai)
#pragma unroll
            for (int m = 0; m < 4; ++m) { bf16_t* rowp = O + (size_t)(row0 + ai * HALF + m * 16) * ldc + col0;
#pragma unroll
                for (int bj = 0; bj < 2; ++bj) { const f32x4 v0 = acc[ai][bj][m][0], v1 = acc[ai][bj][m][1];
                    u32x4 w; w.x = cvt_pk_bf16(v0[0], v0[1]); w.y = cvt_pk_bf16(v0[2], v0[3]); w.z = cvt_pk_bf16(v1[0], v1[1]); w.w = cvt_pk_bf16(v1[2], v1[3]);
                    *(u32x4*)(rowp + bj * HALF) = w; } }
    }
};
struct EpiPP {
    static constexpr bool PERM = true, AFTER_DRAIN = false;
    int pad;
    __device__ __forceinline__ void operator()(const f32x4 (&acc)[2][2][4][2], const Unit& u, int wr, int wc, int fr_, int fq_) const {
        int lane_ = lane_id(); asm volatile("" : "+v"(lane_)); const int fr = lane_ & 15, fq = lane_ >> 4;
        const KArgs ka = kargs(); bf16_t* O = (bf16_t*)ka->out + (size_t)32768 * 1024;
        const int row0 = u.pm * BM + wr * 64 + fr, col0 = u.pn * BM + wc * 32 + 8 * fq;
#pragma unroll
        for (int ai = 0; ai < 2; ++ai)
#pragma unroll
            for (int m = 0; m < 4; ++m) { bf16_t* rowp = O + (size_t)(row0 + ai * HALF + m * 16) * 1024 + col0;
#pragma unroll
                for (int bj = 0; bj < 2; ++bj) { const f32x4 v0 = acc[ai][bj][m][0], v1 = acc[ai][bj][m][1];
                    u32x4 w; w.x = cvt_pk_bf16(v0[0], v0[1]); w.y = cvt_pk_bf16(v0[2], v0[3]); w.z = cvt_pk_bf16(v1[0], v1[1]); w.w = cvt_pk_bf16(v1[2], v1[3]);
                    *(u32x4*)(rowp + bj * HALF) = w; } }
    }
};
struct EpiZ {
    static constexpr bool PERM = true, AFTER_DRAIN = false;
    int ss_sel;
    __device__ __forceinline__ void operator()(const f32x4 (&acc)[2][2][4][2], const Unit& u, int wr, int wc, int fr_, int fq_) const {
        int lane_ = lane_id(); asm volatile("" : "+v"(lane_)); const int fr = lane_ & 15, fq = lane_ >> 4;
        const KArgs ka = kargs(); unsigned char* ws = ka->ws;
        bf16_t* Z = (bf16_t*)(ws + WS_Z); const float* SS = (const float*)(ws + (ss_sel ? WS_SSB : WS_SSA)); float* FL = (float*)(ws + WS_FL);
        const int row0 = u.pm * BM + wr * 64 + fr, col0 = u.pn * BM + wc * 32 + 8 * fq;
        const bool fl = (u.pn == 8) && (wc == 3) && (fq == 0);
#pragma unroll
        for (int ai = 0; ai < 2; ++ai)
#pragma unroll
            for (int m = 0; m < 4; ++m) { const int row = row0 + ai * HALF + m * 16; const float rs = rstd_tbl(u, ai * HALF + wr * 64 + m * 16 + fr); bf16_t* rowp = Z + (size_t)row * 2304 + col0;
#pragma unroll
                for (int bj = 0; bj < 2; ++bj) { const int g32 = (u.pn * BM + bj * HALF + wc * 32) >> 5;
                    const float rq = (g32 >= 11 && g32 < 19) ? rs * 0.18033688011112042f : rs;
                    const f32x4 v0 = acc[ai][bj][m][0] * rq, v1 = acc[ai][bj][m][1] * rq;
                    u32x4 w; w.x = cvt_pk_bf16(v0[0], v0[1]); w.y = cvt_pk_bf16(v0[2], v0[3]); w.z = cvt_pk_bf16(v1[0], v1[1]); w.w = cvt_pk_bf16(v1[2], v1[3]);
                    *(u32x4*)(rowp + bj * HALF) = w; }
                if (fl) *(f32x4*)(FL + (size_t)row * 4) = acc[ai][0][m][0] * rs; asm volatile("" ::: "memory"); }
    }
};
__device__ __forceinline__ float quad16_sum(float x) {
    auto s = __builtin_amdgcn_permlane16_swap(__float_as_uint(x), __float_as_uint(x), false, false); x = __uint_as_float(s[0]) + __uint_as_float(s[1]);
    auto t = __builtin_amdgcn_permlane32_swap(__float_as_uint(x), __float_as_uint(x), false, false); return __uint_as_float(t[0]) + __uint_as_float(t[1]);
}
template <int MODE> struct EpiRes {
    static constexpr bool PERM = true, AFTER_DRAIN = false;
    int r_src;
    int o_dst;
    int sso_sel;
    __device__ __forceinline__ void operator()(const f32x4 (&acc)[2][2][4][2], const Unit& u, int wr, int wc, int fr_, int fq_) const {
        int lane_ = lane_id(); asm volatile("" : "+v"(lane_)); const int fr = lane_ & 15, fq = lane_ >> 4;
        const KArgs ka = kargs(); unsigned char* ws = ka->ws;
        const bf16_t* R = r_src ? (const bf16_t*)ka->out : (const bf16_t*)(ws + WS_HB);
        bf16_t* HBo = o_dst == 0 ? (bf16_t*)(ws + WS_HB) : (o_dst == 1 ? (bf16_t*)ka->out : (bf16_t*)(ws + WS_O)); float* SSo = (float*)(ws + (sso_sel ? WS_SSB : WS_SSA));
        const float* SSi = (const float*)(ws + (sso_sel ? WS_SSA : WS_SSB)); const bf16_t* PP = (const bf16_t*)ka->out + (size_t)32768 * 1024;
        const int row0 = u.pm * BM + wr * 64 + fr, col0 = u.pn * BM + wc * 32 + 8 * fq;
#pragma unroll
        for (int ai = 0; ai < 2; ++ai) {
            u32x4 rwv[4][2], pwv[4][2];
#pragma unroll
            for (int m = 0; m < 4; ++m)
#pragma unroll
                for (int bj = 0; bj < 2; ++bj) { const size_t off = (size_t)(row0 + ai * HALF + m * 16) * 1024 + col0 + bj * HALF; rwv[m][bj] = *(const u32x4*)(R + off); if (MODE == 1) pwv[m][bj] = *(const u32x4*)(PP + off); }
            asm volatile("" ::: "memory");
#pragma unroll
            for (int m = 0; m < 4; ++m) { const int row = row0 + ai * HALF + m * 16; const size_t off = (size_t)row * 1024 + col0; float q = 0.f;
                float rs = 1.f; if (MODE == 1) rs = rstd_tbl(u, ai * HALF + wr * 64 + m * 16 + fr);
#pragma unroll
                for (int bj = 0; bj < 2; ++bj) { const u32x4 rw = rwv[m][bj]; f32x4 o0 = {bf_lo(rw.x), bf_hi(rw.x), bf_lo(rw.y), bf_hi(rw.y)}, o1 = {bf_lo(rw.z), bf_hi(rw.z), bf_lo(rw.w), bf_hi(rw.w)};
                    if (MODE == 0) { o0 = o0 + acc[ai][bj][m][0]; o1 = o1 + acc[ai][bj][m][1]; }
                    else { const f32x4 g0 = acc[ai][bj][m][0] * rs, g1 = acc[ai][bj][m][1] * rs; const u32x4 pw = pwv[m][bj];
                        o0[0] += bf_lo(pw.x) * __builtin_amdgcn_rcpf(1.f + __expf(-g0[0])); o0[1] += bf_hi(pw.x) * __builtin_amdgcn_rcpf(1.f + __expf(-g0[1])); o0[2] += bf_lo(pw.y) * __builtin_amdgcn_rcpf(1.f + __expf(-g0[2])); o0[3] += bf_hi(pw.y) * __builtin_amdgcn_rcpf(1.f + __expf(-g0[3]));
                        o1[0] += bf_lo(pw.z) * __builtin_amdgcn_rcpf(1.f + __expf(-g1[0])); o1[1] += bf_hi(pw.z) * __builtin_amdgcn_rcpf(1.f + __expf(-g1[1])); o1[2] += bf_lo(pw.w) * __builtin_amdgcn_rcpf(1.f + __expf(-g1[2])); o1[3] += bf_hi(pw.w) * __builtin_amdgcn_rcpf(1.f + __expf(-g1[3])); }
                    u32x4 w; w.x = cvt_pk_bf16(o0[0], o0[1]); w.y = cvt_pk_bf16(o0[2], o0[3]); w.z = cvt_pk_bf16(o1[0], o1[1]); w.w = cvt_pk_bf16(o1[2], o1[3]);
                    *(u32x4*)(HBo + off + bj * HALF) = w;
                    const float a0 = bf_lo(w.x), a1 = bf_hi(w.x), a2 = bf_lo(w.y), a3 = bf_hi(w.y), a4 = bf_lo(w.z), a5 = bf_hi(w.z), a6 = bf_lo(w.w), a7 = bf_hi(w.w);
                    q += ((a0 * a0 + a1 * a1) + (a2 * a2 + a3 * a3)) + ((a4 * a4 + a5 * a5) + (a6 * a6 + a7 * a7)); }
                q = quad16_sum(q);
                if (fq == 0) SSo[(size_t)row * 16 + u.pn * 4 + wc] = q; }
            asm volatile("" ::: "memory"); }
    }
};
template <int CTRL> __device__ __forceinline__ float dppf(float x) { return __builtin_bit_cast(float, __builtin_amdgcn_update_dpp(0, __builtin_bit_cast(int, x), CTRL, 0xf, 0xf, false)); }
struct EpiUp {
    static constexpr bool PERM = true, AFTER_DRAIN = false;
    int layer, ss_sel;
#define EPIUP_FMAC_DPP(y, x, w, CTRL) asm volatile("v_fmac_f32_dpp %0, %1, %2 " CTRL " row_mask:0xf bank_mask:0xf" : "+v"(y) : "v"(x), "v"(w))
    template <bool SEQ> __device__ __forceinline__ void conv(f32x4 (&x)[4][2], int n, int tb  , unsigned cwt  , bool silu) const {
        const f32x4 w0 = *(const PG8_LAS f32x4*)(uintptr_t)cwt, w1 = *(const PG8_LAS f32x4*)(uintptr_t)(cwt + 16), w2 = *(const PG8_LAS f32x4*)(uintptr_t)(cwt + 32), b = *(const PG8_LAS f32x4*)(uintptr_t)(cwt + 48);
        float k1[4] = {1.f, 1.f, 1.f, 1.f}, k2[4] = {1.f, 1.f, 1.f, 1.f};
        if (SEQ) {
#pragma unroll
            for (int m = 0; m < 4; ++m) { const int tpos = (tb + m) & 4095; k1[m] = tpos < 1 ? 0.f : 1.f; k2[m] = tpos < 2 ? 0.f : 1.f; } }
#pragma unroll
        for (int e = 0; e < 4; ++e) {
            const float x0 = x[0][n][e], x1 = x[1][n][e], x2 = x[2][n][e], x3 = x[3][n][e];
            float yv[4];
            { float y = b[e] + w2[e] * x0; const float a1 = SEQ ? w1[e] * k1[0] : w1[e], a0 = SEQ ? w0[e] * k2[0] : w0[e];
              EPIUP_FMAC_DPP(y, x3, a1, "row_shr:1"); EPIUP_FMAC_DPP(y, x2, a0, "row_shr:1"); yv[0] = y; }
            { float y = b[e] + w2[e] * x1; y += (SEQ ? w1[e] * k1[1] : w1[e]) * x0; const float a0 = SEQ ? w0[e] * k2[1] : w0[e];
              EPIUP_FMAC_DPP(y, x3, a0, "row_shr:1"); yv[1] = y; }
            yv[2] = b[e] + w2[e] * x2 + (SEQ ? w1[e] * k1[2] : w1[e]) * x1 + (SEQ ? w0[e] * k2[2] : w0[e]) * x0;
            yv[3] = b[e] + w2[e] * x3 + (SEQ ? w1[e] * k1[3] : w1[e]) * x2 + (SEQ ? w0[e] * k2[3] : w0[e]) * x1;
            if (silu) {
                float t[4];
#pragma unroll
                for (int m = 0; m < 4; ++m) t[m] = __builtin_amdgcn_exp2f(yv[m]);
#pragma unroll
                for (int m = 0; m < 4; ++m) t[m] = 1.f + t[m];
#pragma unroll
                for (int m = 0; m < 4; ++m) t[m] = __builtin_amdgcn_rcpf(t[m]);
#pragma unroll
                for (int m = 0; m < 4; ++m) yv[m] *= t[m]; }
#pragma unroll
            for (int m = 0; m < 4; ++m) x[m][n][e] = yv[m]; }
    }
    __device__ __forceinline__ void operator()(f32x4 (&acc)[2][2][4][2], const Unit& u, int wr, int wc, int fr_, int fq_) const {
        int lane_ = lane_id(); asm volatile("" : "+v"(lane_));
        const int fr = lane_ & 15, fq = lane_ >> 4;
        const KArgs ka = kargs(); unsigned char* ws = ka->ws;
        char* ACT = (char*)(ws + WS_ACT);
        const unsigned j0 = 128 * u.pn + 32 * wc + 8 * fq;
        const unsigned cw0 = CWT_TBL_OFF + u.par * 4096 + (8 * wc + 2 * fq) * 128;
#pragma unroll
        for (int ai = 0; ai < 2; ++ai) {
            asm volatile("" ::: "memory");
            const int tb0 = 248 * u.pm + 62 * (2 * ai + wr) - 2;
            const int tb = tb0 + 4 * fr;
#pragma unroll
            for (int m = 0; m < 4; ++m) { const float rs = rstd_tbl(u, ai * HALF + wr * 64 + m * 16 + fr);
#pragma unroll
                for (int bj = 0; bj < 2; ++bj)
#pragma unroll
                    for (int n = 0; n < 2; ++n) acc[ai][bj][m][n] = acc[ai][bj][m][n] * rs; }
            const bool seq = ((tb0 + 63) & 4095) < 65;
#pragma unroll
            for (int n = 0; n < 2; ++n) {
                __builtin_amdgcn_sched_barrier(0);
                if (seq) { conv<true>(acc[ai][0], n, tb, cw0 + n * 128, true); conv<true>(acc[ai][1], n, tb, cw0 + n * 128 + 64, false); }
                else { conv<false>(acc[ai][0], n, tb, cw0 + n * 128, true); __builtin_amdgcn_sched_barrier(0); conv<false>(acc[ai][1], n, tb, cw0 + n * 128 + 64, false); }
            }
#pragma unroll
            for (int m = 0; m < 4; ++m) { const int tok = tb + m; const f32x4 a0 = acc[ai][0][m][0] * acc[ai][1][m][0], a1 = acc[ai][0][m][1] * acc[ai][1][m][1];
                u32x4 w; w.x = cvt_pk_bf16(a0[0], a0[1]); w.y = cvt_pk_bf16(a0[2], a0[3]); w.z = cvt_pk_bf16(a1[0], a1[1]); w.w = cvt_pk_bf16(a1[2], a1[3]);
                if (4 * fr + m >= 2 && tok < TOK) *(u32x4*)(ACT + ((unsigned)tok * 5632u + j0 * 2u)) = w; }
            asm volatile("" ::: "memory");
        }
    }
#undef EPIUP_FMAC_DPP
};

template <class Epi, class Sched, bool ALIGN_EPI = false, bool SP2 = false, bool ROW62 = false, int KC = 0>
__device__ __forceinline__ void gemm_phase(PG8_LAS unsigned char* lds, const Gemm g, const Sched& S, const Epi& E, int wave_id) {
    int lane_ = lane_id(); asm volatile("" : "+v"(lane_));
    const int wid = wave_id, lane = lane_, tid = wid * 64 + lane, wr = wid >> 2, wc = wid & 3, fr = lane & 15, fq = lane >> 4;
    const int K = KC ? KC : g.K, nt = K / BK;
    unsigned voffA, voffB;
    { int R, C; stage_rc(tid * 16, R, C); const int Rb = Epi::PERM ? ((R & ~31) + perm32(R & 31)) : R; const int Ra = ROW62 ? 4 * (R & 15) + (R >> 4) : R;
      voffA = (unsigned)(Ra * K + C) * 2u; voffB = (unsigned)(Rb * K + C) * 2u; }
    const size_t dltA = (size_t)(ROW62 ? 62 : 64) * K * 2, dltB = (size_t)64 * K * 2;
    const size_t kstep = (size_t)(BK * 2);
    const size_t hstepB = (size_t)HALF * K * 2; const size_t hstepA = ROW62 ? (size_t)124 * K * 2 : hstepB;
    const size_t tstepB = 2 * hstepB, tstepA = 2 * hstepA;
    const unsigned ldsw = (unsigned)wid * 1024u;
    const int aoff = lds_byte(wr * 64 + fr, fq * 8), boff = lds_byte(wc * 32 + fr, fq * 8);
#define PG8_SA(b, h) (((b) * 2 + (h)) * HTB)
#define PG8_SB(b, h) ((4 + (b) * 2 + (h)) * HTB)
#define PG8_STAGE(bufoff, gbase, voff) do { _Pragma("unroll") for (int _i = 0; _i < 2; ++_i) \
        __builtin_amdgcn_global_load_lds((const unsigned*)((const char*)(gbase) + _i * dlt_##voff + voff), (PG8_LAS unsigned*)(lds + (bufoff) + ldsw + _i * 8192), 16, 0, 0); } while (0)
#define dlt_voffA dltA
#define dlt_voffB dltB
#define PG8_LDA(dst, b, h) do { _Pragma("unroll") for (int m = 0; m < 4; ++m) _Pragma("unroll") for (int k = 0; k < 2; ++k) dst[m][k] = *(const PG8_LAS bf16x8*)(lds + PG8_SA(b, h) + aoff + m * 2048 + k * 1024); } while (0)
#define PG8_LDB(dst, b, h) do { _Pragma("unroll") for (int n = 0; n < 2; ++n) _Pragma("unroll") for (int k = 0; k < 2; ++k) dst[n][k] = *(const PG8_LAS bf16x8*)(lds + PG8_SB(b, h) + boff + n * 2048 + k * 1024); } while (0)
#define PG8_MMA(ai, bj, At, Bt) do { __builtin_amdgcn_s_setprio(1); _Pragma("unroll") for (int m = 0; m < 4; ++m) _Pragma("unroll") for (int n = 0; n < 2; ++n) _Pragma("unroll") for (int k = 0; k < 2; ++k) \
        acc[ai][bj][m][n] = __builtin_amdgcn_mfma_f32_16x16x32_bf16(Bt[n][k], At[m][k], acc[ai][bj][m][n], 0, 0, 0); __builtin_amdgcn_s_setprio(0); } while (0)
#define PG8_WAIT_V(n) asm volatile("s_waitcnt vmcnt(" #n ")" ::: "memory")
#define PG8_WAIT_L(n) asm volatile("s_waitcnt lgkmcnt(" #n ")" ::: "memory")
#define PG8_BAR __builtin_amdgcn_s_barrier()
#define PG8_SCHED __builtin_amdgcn_sched_barrier(0)
    Unit cur, nxt; int ui = 0;
    if (!S.next(0, cur)) return;
    f32x4 acc[2][2][4][2];
#pragma unroll
    for (int a = 0; a < 2; ++a)
#pragma unroll
        for (int b = 0; b < 2; ++b)
#pragma unroll
            for (int m = 0; m < 4; ++m)
#pragma unroll
                for (int n = 0; n < 2; ++n) acc[a][b][m][n] = (f32x4){0.f, 0.f, 0.f, 0.f};
    bf16x8 At[4][2], B0[2][2], B1[2][2];
    const char* cA = (const char*)g.A + (size_t)cur.pm * tstepA; const char* cB = (const char*)g.Bt + (size_t)cur.pn * tstepB;
    S.a_ready(cur);
    if constexpr (SP2) {
        PG8_STAGE(PG8_SB(0, 0), cB, voffB); PG8_STAGE(PG8_SB(0, 1), cB + hstepB, voffB); PG8_STAGE(PG8_SA(0, 0), cA, voffA); PG8_STAGE(PG8_SA(0, 1), cA + hstepA, voffA);
        if (wr == 1) PG8_BAR;
        PG8_WAIT_V(2); PG8_BAR;
        PG8_STAGE(PG8_SB(1, 0), cB + kstep, voffB); PG8_STAGE(PG8_SA(1, 0), cA + kstep, voffA); PG8_STAGE(PG8_SB(1, 1), cB + hstepB + kstep, voffB);
        PG8_WAIT_V(6); PG8_BAR;
    } else {
        PG8_STAGE(PG8_SB(0, 0), cB, voffB); PG8_STAGE(PG8_SA(0, 0), cA, voffA); PG8_STAGE(PG8_SB(0, 1), cB + hstepB, voffB); PG8_STAGE(PG8_SA(0, 1), cA + hstepA, voffA);
        if (wr == 1) PG8_BAR;
        PG8_WAIT_V(4); PG8_BAR;
        PG8_STAGE(PG8_SB(1, 0), cB + kstep, voffB); PG8_STAGE(PG8_SA(1, 0), cA + kstep, voffA); PG8_STAGE(PG8_SB(1, 1), cB + hstepB + kstep, voffB);
        PG8_WAIT_V(6); PG8_BAR;
    }
    for (;;) {
        const bool has_next = S.next(ui + 1, nxt);
        const char* nA = has_next ? (const char*)g.A + (size_t)nxt.pm * tstepA : cA; const char* nB = has_next ? (const char*)g.Bt + (size_t)nxt.pn * tstepB : cB;
#pragma nounroll
        for (int t = 0; t < nt; t += 2) {
            const bool last = (t == nt - 2);
            const char* a1 = cA + (size_t)(t + 1) * kstep;
            const char* a2 = last ? nA : cA + (size_t)(t + 2) * kstep; const char* b2 = last ? nB : cB + (size_t)(t + 2) * kstep;
            const char* a3 = a2 + kstep; const char* b3 = b2 + kstep;
            if (last && has_next) S.a_ready(nxt);
            if constexpr (SP2) {
            PG8_LDB(B0, 0, 0); PG8_LDB(B1, 0, 1); PG8_SCHED; PG8_LDA(At, 0, 0); PG8_STAGE(PG8_SA(1, 1), a1 + hstepA, voffA);
            PG8_WAIT_V(8); PG8_WAIT_L(0); PG8_BAR; PG8_MMA(0, 0, At, B0); PG8_MMA(0, 1, At, B1); PG8_BAR; PG8_SCHED;
            PG8_LDA(At, 0, 1); PG8_STAGE(PG8_SB(0, 0), b2, voffB); PG8_STAGE(PG8_SB(0, 1), b2 + hstepB, voffB); PG8_STAGE(PG8_SA(0, 0), a2, voffA);
            PG8_WAIT_V(8); PG8_WAIT_L(0); PG8_BAR; PG8_MMA(1, 0, At, B0); PG8_MMA(1, 1, At, B1); PG8_BAR; PG8_SCHED;
            PG8_LDB(B0, 1, 0); PG8_LDB(B1, 1, 1); PG8_SCHED; PG8_LDA(At, 1, 0); PG8_STAGE(PG8_SA(0, 1), a2 + hstepA, voffA);
            PG8_WAIT_V(8); PG8_WAIT_L(0); PG8_BAR; PG8_MMA(0, 0, At, B0); PG8_MMA(0, 1, At, B1); PG8_BAR; PG8_SCHED;
            PG8_LDA(At, 1, 1); PG8_STAGE(PG8_SB(1, 0), b3, voffB); PG8_STAGE(PG8_SB(1, 1), b3 + hstepB, voffB); PG8_STAGE(PG8_SA(1, 0), a3, voffA);
            PG8_WAIT_V(8); PG8_WAIT_L(0); PG8_BAR; PG8_MMA(1, 0, At, B0); PG8_MMA(1, 1, At, B1); PG8_BAR; PG8_SCHED;
            } else {
            PG8_LDB(B0, 0, 0); PG8_SCHED; PG8_LDA(At, 0, 0); PG8_STAGE(PG8_SA(1, 1), a1 + hstepA, voffA);
            PG8_WAIT_L(8); PG8_BAR; PG8_WAIT_L(0); PG8_MMA(0, 0, At, B0); PG8_BAR; PG8_SCHED;
            PG8_LDB(B1, 0, 1); PG8_STAGE(PG8_SB(0, 0), b2, voffB);
            PG8_BAR; PG8_WAIT_L(0); PG8_MMA(0, 1, At, B1); PG8_BAR;
            PG8_LDA(At, 0, 1); PG8_STAGE(PG8_SA(0, 0), a2, voffA);
            PG8_BAR; PG8_WAIT_L(0); PG8_MMA(1, 0, At, B0); PG8_BAR; PG8_SCHED;
            PG8_STAGE(PG8_SB(0, 1), b2 + hstepB, voffB);
            PG8_WAIT_V(6); PG8_BAR; PG8_MMA(1, 1, At, B1); PG8_BAR;
            PG8_LDB(B0, 1, 0); PG8_SCHED; PG8_LDA(At, 1, 0); PG8_STAGE(PG8_SA(0, 1), a2 + hstepA, voffA);
            PG8_WAIT_L(8); PG8_BAR; PG8_WAIT_L(0); PG8_MMA(0, 0, At, B0); PG8_BAR; PG8_SCHED;
            PG8_LDB(B1, 1, 1); PG8_STAGE(PG8_SB(1, 0), b3, voffB);
            PG8_BAR; PG8_WAIT_L(0); PG8_MMA(0, 1, At, B1); PG8_BAR;
            PG8_LDA(At, 1, 1); PG8_STAGE(PG8_SA(1, 0), a3, voffA);
            PG8_BAR; PG8_WAIT_L(0); PG8_MMA(1, 0, At, B0); PG8_BAR; PG8_SCHED;
            PG8_STAGE(PG8_SB(1, 1), b3 + hstepB, voffB);
            PG8_WAIT_V(6); PG8_BAR; PG8_MMA(1, 1, At, B1); PG8_BAR;
            }
        }
        if constexpr (ALIGN_EPI) { if (wr == 0) PG8_BAR; }
        if constexpr (!Epi::AFTER_DRAIN) { E(acc, cur, wr, wc, fr, fq); S.done(cur); }
        if (!has_next) break;
#pragma unroll
        for (int a = 0; a < 2; ++a)
#pragma unroll
            for (int b = 0; b < 2; ++b)
#pragma unroll
                for (int m = 0; m < 4; ++m)
#pragma unroll
                    for (int n = 0; n < 2; ++n) acc[a][b][m][n] = (f32x4){0.f, 0.f, 0.f, 0.f};
        cur = nxt; cA = nA; cB = nB; ++ui;
        if constexpr (ALIGN_EPI) { if (wr == 1) PG8_BAR; }
    }
    PG8_WAIT_V(0);
    if constexpr (!ALIGN_EPI) { if (wr == 0) PG8_BAR; }
    PG8_BAR;
    if constexpr (Epi::AFTER_DRAIN) { E.fused(acc, cur, wr, wc, fr, fq, lds, wid, lane); S.done(cur); }
#undef PG8_SA
#undef PG8_SB
#undef PG8_STAGE
#undef dlt_voffA
#undef dlt_voffB
#undef PG8_LDA
#undef PG8_LDB
#undef PG8_MMA
#undef PG8_WAIT_V
#undef PG8_WAIT_L
#undef PG8_BAR
#undef PG8_SCHED
}
}
#define GAS __attribute__((address_space(1)))
#define LAS __attribute__((address_space(3)))
typedef unsigned short bf16;
typedef unsigned v4u __attribute__((ext_vector_type(4)));
typedef float f32x4 __attribute__((ext_vector_type(4)));
typedef short bf16x8 __attribute__((ext_vector_type(8)));
typedef GAS unsigned gu32;
typedef GAS unsigned long long gu64;
#define RLX_AGENT __ATOMIC_RELAXED, __HIP_MEMORY_SCOPE_AGENT
#define LDS_WAIT() asm volatile("s_waitcnt lgkmcnt(0)" ::: "memory")
#define VM_WAIT() asm volatile("s_waitcnt vmcnt(0)" ::: "memory")
__device__ __forceinline__ unsigned long long rt() { return __builtin_amdgcn_s_memrealtime(); }
__device__ __forceinline__ unsigned f2bf(float f) { unsigned u = __builtin_bit_cast(unsigned, f); return (u + 0x7fffu + ((u >> 16) & 1u)) >> 16; }
__device__ __forceinline__ unsigned pk2(float lo, float hi) { return f2bf(lo) | (f2bf(hi) << 16); }

#define XB_TMO      128
#define XB_XCNT(j)  (256  + 64 * (j))
#define XB_XSUB(j)  (1280 + 64 * (j))
#define XB_XGEN(j)  (2304 + 64 * (j))
#define XB_TOP      3328
#define XB_TOPGEN   3392
#define XCD_BAR_WORDS 3456
#define XB_SPIN_CAP (1u << 18)

__device__ __forceinline__ unsigned xb_ld(unsigned* p)              { return __hip_atomic_load(p, __ATOMIC_RELAXED, __HIP_MEMORY_SCOPE_AGENT); }
__device__ __forceinline__ unsigned xb_add(unsigned* p, unsigned v) { return __hip_atomic_fetch_add(p, v, __ATOMIC_RELAXED, __HIP_MEMORY_SCOPE_AGENT); }
__device__ __forceinline__ unsigned xb_xcc_id() { return (unsigned)__builtin_amdgcn_s_getreg((3 << 11) | 20) & 0xFu; }
#define XB_SPIN(cond, bar) do { unsigned _sp = 0; while (cond) { __builtin_amdgcn_s_sleep(1); \
    if ((++_sp & 255u) == 0u) { if (xb_ld(&(bar)[XB_TMO])) break; if (_sp > XB_SPIN_CAP) { atomicAdd(&(bar)[XB_TMO], 1u); break; } } } } while (0)

struct XcdBarrier {
    unsigned* bar; unsigned x;
    volatile LAS unsigned* st;
};

__device__ __forceinline__ XcdBarrier xcd_barrier_post(unsigned* bar, volatile LAS unsigned* st) {
    XcdBarrier b; b.bar = bar; b.x = xb_xcc_id(); b.st = st;
    if (threadIdx.x == 0) (void)xb_add(&bar[XB_XCNT(b.x)], 1u);
    return b;
}
__device__ __forceinline__ void xcd_barrier_complete(unsigned* bar, unsigned x, unsigned& nloc, unsigned& nx) {
    const unsigned G = gridDim.x * gridDim.y * gridDim.z;
    unsigned sum, cnt, mine, sp = 0u;
    for (;;) {
        sum = 0u; cnt = 0u; mine = 0u;
#pragma unroll
        for (unsigned j = 0; j < 16; ++j) { const unsigned c = xb_ld(&bar[XB_XCNT(j)]); sum += c; cnt += (c > 0u) ? 1u : 0u; mine = (j == x) ? c : mine; }
        if (sum == G) break;
        __builtin_amdgcn_s_sleep(1);
        if ((++sp & 255u) == 0u) { if (xb_ld(&bar[XB_TMO])) break; if (sp > XB_SPIN_CAP) { atomicAdd(&bar[XB_TMO], 1u); break; } }
    }
    nloc = mine > 0u ? mine : 1u; nx = cnt > 0u ? cnt : 1u;
}

__device__ __forceinline__ void xcd_barrier(const XcdBarrier& b) {
    asm volatile("s_waitcnt vmcnt(0)" ::: "memory");
    __syncthreads();
    if (threadIdx.x == 0) {
        unsigned* bar = b.bar;
        __builtin_amdgcn_s_waitcnt(0);
        unsigned nloc = b.st[0], nx = b.st[1];
        if (nloc == 0u) { xcd_barrier_complete(bar, b.x, nloc, nx); b.st[0] = nloc; b.st[1] = nx; }
        const unsigned old = xb_add(&bar[XB_XSUB(b.x)], 1u);
        const unsigned gen = old / nloc;
        if (old + 1u == (gen + 1u) * nloc) {
            __builtin_amdgcn_fence(__ATOMIC_RELEASE, "agent");
            asm volatile("s_waitcnt vmcnt(0)" ::: "memory");
            const unsigned og = xb_add(&bar[XB_TOP], 1u);
            const unsigned tg = og / nx;
            if (og + 1u == (tg + 1u) * nx) xb_add(&bar[XB_TOPGEN], 1u);
            else XB_SPIN(xb_ld(&bar[XB_TOPGEN]) == tg, bar);
            __builtin_amdgcn_fence(__ATOMIC_ACQUIRE, "agent");
            xb_add(&bar[XB_XGEN(b.x)], 1u);
            asm volatile("s_waitcnt vmcnt(0)" ::: "memory");
        } else {
            XB_SPIN(xb_ld(&bar[XB_XGEN(b.x)]) == gen, bar);
            __builtin_amdgcn_fence(__ATOMIC_ACQUIRE, "agent");
            asm volatile("s_waitcnt vmcnt(0)" ::: "memory");
        }
    }
    __syncthreads();
}
namespace att {
using bf16x8 = __attribute__((ext_vector_type(8))) short;
using s16x4 = __attribute__((ext_vector_type(4))) short;
using f32x16 = __attribute__((ext_vector_type(16))) float;
using u32x4 = __attribute__((ext_vector_type(4))) unsigned;
typedef short v4i16_t __attribute__((ext_vector_type(4)));
typedef __attribute__((address_space(3))) char* lptr;
typedef __attribute__((address_space(3))) const char* lcptr;
constexpr int KSLOT = 12288, VSLOT = 8192, BSLOT = 1024;
constexpr int NSLOT = 4;
constexpr int LDS_K = 0, LDS_V = NSLOT * KSLOT, LDS_B = LDS_V + NSLOT * VSLOT, LDS_WS = LDS_B + NSLOT * BSLOT, LDS_OST = LDS_WS + 8 * 512, LDS_BYTES = LDS_OST + 8 * 4096;
__device__ __forceinline__ int crow(int r, int hi) { return (r & 3) + 8 * (r >> 2) + 4 * hi; }
__device__ __forceinline__ void glds16(const void* g, unsigned lds_base) {
    unsigned sv; asm volatile("s_mov_b32 %0, m0\n\ts_mov_b32 m0, %2\n\ts_nop 0\n\tglobal_load_lds_dwordx4 %1, off\n\ts_mov_b32 m0, %0" : "=&s"(sv) : "v"(g), "s"(lds_base) : "memory"); }
typedef __bf16 bf2_t __attribute__((ext_vector_type(2)));
typedef float fl2_t __attribute__((ext_vector_type(2)));
__device__ __forceinline__ unsigned cvtpk(float lo, float hi) { const fl2_t v = {lo, hi}; return __builtin_bit_cast(unsigned, __builtin_convertvector(v, bf2_t)); }
__device__ __forceinline__ s16x4 vtr(lcptr p) { return __builtin_bit_cast(s16x4, __builtin_amdgcn_ds_read_tr16_b64_v4i16((__attribute__((address_space(3))) v4i16_t*)p)); }
#define ATT_MX3(a, b, c) __builtin_fmaxf(__builtin_fmaxf((a), (b)), (c))
__device__ __forceinline__ float rowmax(const f32x16& p0, const f32x16& p1) {
    float a = ATT_MX3(p0[0], p0[1], p1[0]), b = ATT_MX3(p0[2], p0[3], p1[1]); a = ATT_MX3(a, p1[2], p1[3]);
#pragma unroll
    for (int r = 4; r < 16; r += 4) { a = ATT_MX3(a, p0[r], p0[r + 1]); b = ATT_MX3(b, p0[r + 2], p0[r + 3]); a = ATT_MX3(a, p1[r], p1[r + 1]); b = ATT_MX3(b, p1[r + 2], p1[r + 3]); }
    float m = __builtin_fmaxf(a, b); auto rr = __builtin_amdgcn_permlane32_swap(__float_as_uint(m), __float_as_uint(m), false, false);
    return __builtin_fmaxf(__uint_as_float(rr[0]), __uint_as_float(rr[1])); }
__device__ __forceinline__ void cmask(f32x16& p0, f32x16& p1, int jb, int qrel, int hi) {
    const int kb = 64 * jb + 4 * hi;
#pragma unroll
    for (int r = 0; r < 16; ++r) { const int kv = kb + (r & 3) + 8 * (r >> 2); if (kv > qrel) p0[r] = -INFINITY; if (kv + 32 > qrel) p1[r] = -INFINITY; } }
#define ATT_WAIT_BAR(N) asm volatile("s_waitcnt vmcnt(" #N ") lgkmcnt(0)\n\ts_barrier" ::: "memory")
#define ATT_MFMA(a, b, c) __builtin_amdgcn_mfma_f32_32x32x16_bf16(a, b, c, 0, 0, 0)

template <int ND, bool BIAS>
__device__ __forceinline__ void attn_unit(const unsigned short* Qh, int pq, const unsigned short* Kh, int pk, const unsigned short* Vh, int pv, unsigned short* Oh, int po,
                                          const float* cbx, int hb, int qb, lptr lds, int wid) {
    const int lane = lane_id(), r32 = lane & 31, hi = lane >> 5;
    const int q0 = qb * 512, NT = 8 * qb + 8;
    constexpr int KSL = ND * 2048;
    const unsigned lds0 = (unsigned)(uintptr_t)lds;
    bf16x8 qa[ND], qc[ND];
    { const unsigned short* Qw = Qh + (size_t)(q0 + wid * 64 + r32) * pq + hi * 8;
#pragma unroll
      for (int d0 = 0; d0 < ND; ++d0) { qa[d0] = *reinterpret_cast<const bf16x8*>(Qw + d0 * 16); qc[d0] = *reinterpret_cast<const bf16x8*>(Qw + (size_t)32 * pq + d0 * 16); }
 }
    const unsigned short* ksrc0 = Kh + (size_t)lane * pk + wid * 8;
    const unsigned short* ksrc1 = Kh + (size_t)lane * pk + (8 + (wid & 3)) * 8;
    const unsigned short* vsrc = Vh + (size_t)(16 * (wid & 3) + (lane >> 2)) * pv + (wid >> 2) * 32 + (lane & 3) * 8;
    const float* bsrc = cbx + lane * 4;
    const unsigned kdst0 = lds0 + LDS_K + wid * 1024, kdst1 = lds0 + LDS_K + (8 + (wid & 3)) * 1024, vdst = lds0 + LDS_V + wid * 1024, bdst = lds0 + LDS_B;
#define ATT_DMA(t, s) do { glds16(ksrc0 + (size_t)(t) * 64 * pk, (unsigned)__builtin_amdgcn_readfirstlane(kdst0 + (s) * KSL)); \
        if (ND == 6) glds16(ksrc1 + (size_t)(t) * 64 * pk, (unsigned)__builtin_amdgcn_readfirstlane(kdst1 + (s) * KSL)); \
        glds16(vsrc + (size_t)(t) * 64 * pv, (unsigned)__builtin_amdgcn_readfirstlane(vdst + (s) * VSLOT)); \
        if (BIAS) glds16(bsrc + (size_t)(t) * 256, (unsigned)__builtin_amdgcn_readfirstlane(bdst + (s) * BSLOT)); } while (0)
    const lcptr kp0 = (lcptr)lds + LDS_K + hi * 1024 + r32 * 16;
    const lcptr vp0 = (lcptr)lds + LDS_V + ((lane >> 4) & 1) * 32 + (lane & 3) * 8 + (4 * hi + ((lane & 15) >> 2)) * 64;
    const lcptr bp0 = (lcptr)lds + LDS_B + hb * 256 + hi * 128;
    __attribute__((address_space(3))) float* wsf = (__attribute__((address_space(3))) float*)(lds + LDS_WS) + wid * 128;
    ATT_DMA(NT - 1, 0); ATT_DMA(NT - 2, 1); ATT_DMA(NT - 3, 2);
#pragma unroll
    for (int d0 = 0; d0 < ND; ++d0) { asm volatile("" : "+v"(qa[d0])); asm volatile("" : "+v"(qc[d0])); }
    float ma = -INFINITY, la = 0.f, mb = -INFINITY, lb = 0.f; f32x16 oa[2], ob[2];
    { float z0; asm volatile("v_mov_b32 %0, 0" : "=v"(z0));
#pragma unroll
      for (int r = 0; r < 16; ++r) { oa[0][r] = z0; oa[1][r] = z0; ob[0][r] = z0; ob[1][r] = z0; } }
    f32x16 pa, pb, pa2, pb2;
#define ATT_SKIP(t) ((t) < 8 && (7 - (t)) > wid)
#define ATT_CINIT(PA_, PB_, t, H) do { if (BIAS) { const lcptr bp = bp0 + ((t) & 3) * BSLOT + (H) * 64; \
            _Pragma("unroll") for (int g = 0; g < 4; ++g) { const f32x4 x_ = *(const __attribute__((address_space(3))) f32x4*)(bp + g * 16); \
                _Pragma("unroll") for (int e = 0; e < 4; ++e) { PA_[4 * g + e] = x_[e]; PB_[4 * g + e] = x_[e]; } } } \
        else { PA_ = f32x16{}; PB_ = f32x16{}; } } while (0)
#define ATT_QK(t, H) do { const lcptr kb_ = kp0 + ((t) & 3) * KSL + (H) * 512; ATT_CINIT(pa, pb, t, H); bf16x8 kf_[ND]; \
        _Pragma("unroll") for (int d0 = 0; d0 < ND; ++d0) kf_[d0] = *(const __attribute__((address_space(3))) bf16x8*)(kb_ + d0 * 2048); \
        __builtin_amdgcn_s_setprio(1); _Pragma("unroll") for (int d0 = 0; d0 < ND; ++d0) { pa = ATT_MFMA(kf_[d0], qa[d0], pa); pb = ATT_MFMA(kf_[d0], qc[d0], pb); } __builtin_amdgcn_s_setprio(0); } while (0)
#define ATT_VF(i) ({ const s16x4 lo_ = vtr(vp + (((i) >> 2) * 4096 + ((i) & 3) * 1024)), hi_ = vtr(vp + (((i) >> 2) * 4096 + ((i) & 3) * 1024 + 512)); (bf16x8){lo_[0], lo_[1], lo_[2], lo_[3], hi_[0], hi_[1], hi_[2], hi_[3]}; })
#define ATT_RMAX(P, RM) do { float a_ = ATT_MX3(P[0], P[1], P[2]), b_ = ATT_MX3(P[3], P[4], P[5]); a_ = ATT_MX3(a_, P[6], P[7]); b_ = ATT_MX3(b_, P[8], P[9]); a_ = ATT_MX3(a_, P[10], P[11]); b_ = ATT_MX3(b_, P[12], P[13]); a_ = ATT_MX3(a_, P[14], P[15]); \
        RM = __builtin_fmaxf(a_, b_); { auto rr_ = __builtin_amdgcn_permlane32_swap(__float_as_uint(RM), __float_as_uint(RM), false, false); RM = __builtin_fmaxf(__uint_as_float(rr_[0]), __uint_as_float(rr_[1])); } } while (0)
#define ATT_EXPS(P, MR, LR) do { float sum_ = 0.f; \
        _Pragma("unroll") for (int r = 0; r < 16; ++r) { P[r] = __builtin_amdgcn_exp2f(P[r] - MR); sum_ += P[r]; } \
        asm volatile("" : "+v"(sum_));            \
        LR += sum_; asm volatile("" : "+v"(LR)); } while (0)
#define ATT_PK(P, o) (u32x4){cvtpk(P[o], P[o + 1]), cvtpk(P[o + 2], P[o + 3]), cvtpk(P[o + 4], P[o + 5]), cvtpk(P[o + 6], P[o + 7])}
#define ATT_PV(WA, WB, i) do { const bf16x8 v0_ = ATT_VF(i), v1_ = ATT_VF((i) + 4); __builtin_amdgcn_s_setprio(1); \
        oa[0] = ATT_MFMA(__builtin_bit_cast(bf16x8, WA), v0_, oa[0]); ob[0] = ATT_MFMA(__builtin_bit_cast(bf16x8, WB), v0_, ob[0]); \
        oa[1] = ATT_MFMA(__builtin_bit_cast(bf16x8, WA), v1_, oa[1]); ob[1] = ATT_MFMA(__builtin_bit_cast(bf16x8, WB), v1_, ob[1]); __builtin_amdgcn_s_setprio(0); } while (0)
#define ATT_SMPV(t, H, MASKED_) do { const int s_ = (t) & 3; \
        if (MASKED_) { if (7 - (t) == wid) { const int l3_ = lane_id(), kb3_ = 32 * (H) + 4 * (l3_ >> 5), qa3_ = l3_ & 31; \
            _Pragma("unroll") for (int r = 0; r < 16; ++r) { const int kv = kb3_ + (r & 3) + 8 * (r >> 2); if (kv > qa3_) pa[r] = -INFINITY; if (kv > qa3_ + 32) pb[r] = -INFINITY; } } } \
        float rma, rmb; ATT_RMAX(pa, rma); ATT_RMAX(pb, rmb); \
          \
        if (__any(rma > ma + 40.f || rmb > mb + 40.f)) { \
            const float na = __builtin_fmaxf(ma, rma), nb = __builtin_fmaxf(mb, rmb); const float ala = __builtin_amdgcn_exp2f(ma - na), alb = __builtin_amdgcn_exp2f(mb - nb); ma = na; mb = nb; la *= ala; lb *= alb; \
            if (hi == 0) { wsf[r32] = ala; wsf[32 + r32] = alb; } \
            asm volatile("s_waitcnt lgkmcnt(0)" ::: "memory"); \
            asm volatile("" : "+v"(oa[0]), "+v"(oa[1]));       \
            _Pragma("unroll") for (int r = 0; r < 16; ++r) { const float fa = wsf[crow(r, hi)]; oa[0][r] *= fa; oa[1][r] *= fa; if ((r & 3) == 3) asm volatile("" ::: "memory"); } \
            asm volatile("" : "+v"(oa[0]), "+v"(oa[1])); \
            asm volatile("" : "+v"(ob[0]), "+v"(ob[1])); \
            _Pragma("unroll") for (int r = 0; r < 16; ++r) { const float fb = wsf[32 + crow(r, hi)]; ob[0][r] *= fb; ob[1][r] *= fb; if ((r & 3) == 3) asm volatile("" ::: "memory"); } \
            asm volatile("" : "+v"(ob[0]), "+v"(ob[1])); } \
        ATT_EXPS(pa, ma, la); ATT_EXPS(pb, mb, lb); \
        const lcptr vp = vp0 + s_ * VSLOT; \
        { const u32x4 wa_ = ATT_PK(pa, 0), wb_ = ATT_PK(pb, 0); ATT_PV(wa_, wb_, 2 * (H)); } \
        { const u32x4 wa_ = ATT_PK(pa, 8), wb_ = ATT_PK(pb, 8); ATT_PV(wa_, wb_, 2 * (H) + 1); } } while (0)
#define ATT_HALF(CA, CB, NA, NB, t, H, tn, Hn, HASNEXT) do { const int s_ = (t) & 3; \
        bf16x8 kf_[ND]; if (HASNEXT) { const lcptr kb_ = kp0 + ((tn) & 3) * KSL + (Hn) * 512; \
            _Pragma("unroll") for (int d0 = 0; d0 < ND; ++d0) kf_[d0] = *(const __attribute__((address_space(3))) bf16x8*)(kb_ + d0 * 2048); } \
        float rma, rmb; ATT_RMAX(CA, rma); ATT_RMAX(CB, rmb); \
        if (__any(rma > ma + 40.f || rmb > mb + 40.f)) { \
            const float na = __builtin_fmaxf(ma, rma), nb = __builtin_fmaxf(mb, rmb); const float ala = __builtin_amdgcn_exp2f(ma - na), alb = __builtin_amdgcn_exp2f(mb - nb); ma = na; mb = nb; la *= ala; lb *= alb; \
            if (hi == 0) { wsf[r32] = ala; wsf[32 + r32] = alb; } \
            asm volatile("s_waitcnt lgkmcnt(0)" ::: "memory"); \
            asm volatile("" : "+v"(oa[0]), "+v"(oa[1])); \
            _Pragma("unroll") for (int r = 0; r < 16; ++r) { const float fa = wsf[crow(r, hi)]; oa[0][r] *= fa; oa[1][r] *= fa; if ((r & 3) == 3) asm volatile("" ::: "memory"); } \
            asm volatile("" : "+v"(oa[0]), "+v"(oa[1])); \
            asm volatile("" : "+v"(ob[0]), "+v"(ob[1])); \
            _Pragma("unroll") for (int r = 0; r < 16; ++r) { const float fb = wsf[32 + crow(r, hi)]; ob[0][r] *= fb; ob[1][r] *= fb; if ((r & 3) == 3) asm volatile("" ::: "memory"); } \
            asm volatile("" : "+v"(ob[0]), "+v"(ob[1])); } \
        float suma_ = 0.f, sumb_ = 0.f; if (HASNEXT) ATT_CINIT(NA, NB, tn, Hn); \
        __builtin_amdgcn_sched_barrier(0); \
        _Pragma("unroll") for (int d0 = 0; d0 < ND; ++d0) { \
            if (HASNEXT) { NA = ATT_MFMA(kf_[d0], qa[d0], NA); NB = ATT_MFMA(kf_[d0], qc[d0], NB); } \
            _Pragma("unroll") for (int r = (16 * d0) / ND; r < (16 * (d0 + 1)) / ND; ++r) { CA[r] = __builtin_amdgcn_exp2f(CA[r] - ma); suma_ += CA[r]; CB[r] = __builtin_amdgcn_exp2f(CB[r] - mb); sumb_ += CB[r]; } \
            asm volatile("" : "+v"(suma_), "+v"(sumb_)); \
            __builtin_amdgcn_sched_barrier(0); } \
        la += suma_; lb += sumb_; asm volatile("" : "+v"(la), "+v"(lb)); \
        const lcptr vp = vp0 + s_ * VSLOT; \
        { const u32x4 wa_ = ATT_PK(CA, 0), wb_ = ATT_PK(CB, 0); ATT_PV(wa_, wb_, 2 * (H)); } \
        { const u32x4 wa_ = ATT_PK(CA, 8), wb_ = ATT_PK(CB, 8); ATT_PV(wa_, wb_, 2 * (H) + 1); } } while (0)
    asm volatile("s_waitcnt vmcnt(6) lgkmcnt(0)\n\ts_barrier" ::: "memory");
    if (!ATT_SKIP(0)) ATT_QK(0, 0);
    int t = 0;
    for (; t < 8; ++t) {
        if (t + 2 < NT) { ATT_WAIT_BAR(3); } else { ATT_WAIT_BAR(0); }
        if (t + 3 < NT) ATT_DMA(NT - 4 - t, (t + 3) & 3);
        if (!ATT_SKIP(t)) { ATT_SMPV(t, 0, true); ATT_QK(t, 1); ATT_SMPV(t, 1, true); }
        __builtin_amdgcn_sched_barrier(0);
        if (t + 1 < NT && !ATT_SKIP(t + 1)) ATT_QK(t + 1, 0);
    }
    for (; t < NT; ++t) {
        if (t + 2 < NT) { ATT_WAIT_BAR(3); } else { ATT_WAIT_BAR(0); }
        if (t + 3 < NT) ATT_DMA(NT - 4 - t, (t + 3) & 3);
        ATT_HALF(pa, pb, pa2, pb2, t, 0, t, 1, true);
        ATT_HALF(pa2, pb2, pa, pb, t, 1, t + 1, 0, t + 1 < NT);
    }
#undef ATT_SKIP
#undef ATT_HALF
#undef ATT_QK
#undef ATT_CINIT
#undef ATT_SMPV
#undef ATT_VF
#undef ATT_RMAX
#undef ATT_EXPS
#undef ATT_PK
#undef ATT_PV
    { auto rr = __builtin_amdgcn_permlane32_swap(__float_as_uint(la), __float_as_uint(la), false, false); la = __uint_as_float(rr[0]) + __uint_as_float(rr[1]); }
    { auto rr = __builtin_amdgcn_permlane32_swap(__float_as_uint(lb), __float_as_uint(lb), false, false); lb = __uint_as_float(rr[0]) + __uint_as_float(rr[1]); }
    if (hi == 0) { wsf[64 + r32] = la; wsf[96 + r32] = lb; }
    asm volatile("s_waitcnt lgkmcnt(0)" ::: "memory");
    { const int l2 = lane_id(), c2 = l2 & 31, h2 = l2 >> 5;
      __attribute__((address_space(3))) unsigned short* stg = (__attribute__((address_space(3))) unsigned short*)(lds + LDS_OST) + wid * 2048;
      __attribute__((address_space(3))) unsigned short* stw = stg + h2 * 256 + c2;
      const __attribute__((address_space(3))) float* wl = wsf + 64 + 4 * h2;
#pragma unroll
      for (int sb = 0; sb < 2; ++sb) {
#pragma unroll
        for (int r = 0; r < 16; ++r) { constexpr int dummy = 0; (void)dummy; const int cr = (r & 3) + 8 * (r >> 2); const float rl = __builtin_amdgcn_rcpf(wl[sb * 32 + cr]);
#pragma unroll
            for (int d0 = 0; d0 < 2; ++d0) stw[cr * 64 + d0 * 32] = (unsigned short)f2bf((sb ? ob[d0][r] : oa[d0][r]) * rl); }
        asm volatile("s_waitcnt lgkmcnt(0)" ::: "memory");
        unsigned short* Ow = Oh + (size_t)(q0 + wid * 64 + sb * 32) * po;
#pragma unroll
        for (int i = 0; i < 4; ++i) { const int row = i * 8 + (l2 >> 3), ch = l2 & 7; *(u32x4*)(Ow + (size_t)row * po + ch * 8) = *(const __attribute__((address_space(3))) u32x4*)(stg + row * 64 + ch * 8); }
        asm volatile("s_waitcnt lgkmcnt(0)" ::: "memory");
      } }
    asm volatile("s_waitcnt lgkmcnt(0)\n\ts_barrier" ::: "memory");
#undef ATT_DMA
}
}
namespace mid {
using bf16x8 = __attribute__((ext_vector_type(8))) short;
using f32x16 = __attribute__((ext_vector_type(16))) float;
using u32x4 = __attribute__((ext_vector_type(4))) unsigned;
typedef __attribute__((address_space(3))) char* lptr;
#define MID_MFMA(a, b, c) __builtin_amdgcn_mfma_f32_32x32x16_bf16(a, b, c, 0, 0, 0)
__device__ __forceinline__ int crow(int r, int hi) { return (r & 3) + 8 * (r >> 2) + 4 * hi; }
__device__ __forceinline__ float bf_lo(unsigned w) { return __uint_as_float(w << 16); }
__device__ __forceinline__ float bf_hi(unsigned w) { return __uint_as_float(w & 0xffff0000u); }
__device__ __forceinline__ float bfu(unsigned short v) { return __uint_as_float((unsigned)v << 16); }
__device__ __forceinline__ float xhalf_sum(float x) { auto t = __builtin_amdgcn_permlane32_swap(__float_as_uint(x), __float_as_uint(x), false, false); return __uint_as_float(t[0]) + __uint_as_float(t[1]); }
__device__ __forceinline__ float sumsq8(bf16x8 v) { float s = 0.f;
#pragma unroll
    for (int j = 0; j < 8; ++j) { const float f = bfu((unsigned short)v[j]); s += f * f; } return s; }

typedef __bf16 bf2_t __attribute__((ext_vector_type(2)));
typedef float fl2_t __attribute__((ext_vector_type(2)));
__device__ __forceinline__ unsigned cvtpk(float lo, float hi) { const fl2_t v = {lo, hi}; return __builtin_bit_cast(unsigned, __builtin_convertvector(v, bf2_t)); }
template <int KS, int NT>
__device__ __forceinline__ void latent_gemm(f32x16 (&acc)[NT], __attribute__((address_space(3))) const char* arow  , const unsigned short* wt  , float post) {
    float ss = 0.f;
#pragma unroll
    for (int nt = 0; nt < NT; ++nt) acc[nt] = f32x16{};
#pragma unroll
    for (int ks = 0; ks < KS; ++ks) { const bf16x8 a = *(const __attribute__((address_space(3))) bf16x8*)(arow + 32 * ks); ss += sumsq8(a);
#pragma unroll
        for (int nt = 0; nt < NT; ++nt) { const bf16x8 b = *reinterpret_cast<const bf16x8*>(wt + (size_t)(nt * KS + ks) * 512); acc[nt] = MID_MFMA(b, a, acc[nt]); }
        if ((ks & 3) == 3) asm volatile("" ::: "memory"); }
    ss = xhalf_sum(ss);
    const float rstd = rsqrtf(ss * (1.0f / (16 * KS)) + EPS) * post;
#pragma unroll
    for (int nt = 0; nt < NT; ++nt) acc[nt] = acc[nt] * rstd;
}
__device__ __forceinline__ void rope_tile(f32x16& x, const float* rp, int hi) {
#pragma unroll
    for (int g = 0; g < 2; ++g) { const f32x4 c0 = *(const f32x4*)(rp + (8 * g + 4 * hi) * 2), c1 = *(const f32x4*)(rp + (8 * g + 4 * hi) * 2 + 4);
        const float cs[4][2] = {{c0[0], c0[1]}, {c0[2], c0[3]}, {c1[0], c1[1]}, {c1[2], c1[3]}};
#pragma unroll
        for (int e = 0; e < 4; ++e) { const int r = 4 * g + e; const float x1 = x[r], x2 = x[r + 8]; x[r] = x1 * cs[e][0] - x2 * cs[e][1]; x[r + 8] = x2 * cs[e][0] + x1 * cs[e][1]; } }
}
__device__ __forceinline__ void stage_tiles(__attribute__((address_space(3))) char* stg, const f32x16& t0, const f32x16& t1, int r32, int hi) {
    typedef unsigned u32x2_ __attribute__((ext_vector_type(2)));
#pragma unroll
    for (int n2 = 0; n2 < 2; ++n2) { const f32x16& t = n2 ? t1 : t0;
#pragma unroll
        for (int g = 0; g < 4; ++g) { u32x2_ w; w.x = cvtpk(t[4 * g], t[4 * g + 1]); w.y = cvtpk(t[4 * g + 2], t[4 * g + 3]);
            *(__attribute__((address_space(3))) u32x2_*)(stg + r32 * 144 + (32 * n2 + 8 * g + 4 * hi) * 2) = w; } }
}

constexpr float QSCALE = 0.10206207261596577f * 1.4426950408889634f;
constexpr int STG_BYTES = 16384;
template <class F> __device__ __forceinline__ void stage_out(__attribute__((address_space(3))) const char* stg, int lane, F dst) {
#pragma unroll
    for (int it = 0; it < 4; ++it) { const int row = it * 8 + (lane >> 3), ch = lane & 7;
        *(u32x4*)dst(row, ch) = *(const __attribute__((address_space(3))) u32x4*)(stg + row * 144 + ch * 16); }
}

constexpr int ATILE_BYTES = 128 * 704, OSTG_OFF = ATILE_BYTES, OSTG_BYTES = 4608;
__device__ __forceinline__ void glds16(const void* g, unsigned lds_base) {
    unsigned sv; asm volatile("s_mov_b32 %0, m0\n\ts_mov_b32 m0, %2\n\ts_nop 0\n\tglobal_load_lds_dwordx4 %1, off\n\ts_mov_b32 m0, %0" : "=&s"(sv) : "v"(g), "s"(lds_base) : "memory"); }
constexpr int LAT_TBL = OSTG_OFF + 8 * OSTG_BYTES;
template <int KS> __device__ __forceinline__ void latent_tile(f32x16 (&acc)[4], __attribute__((address_space(3))) const char* a0, const unsigned short* wt) {
#pragma unroll
    for (int blk = 0; blk < 4; ++blk) acc[blk] = f32x16{};
#pragma unroll
    for (int ks = 0; ks < KS; ++ks) { const bf16x8 w = *reinterpret_cast<const bf16x8*>(wt + (size_t)ks * 512);
#pragma unroll
        for (int blk = 0; blk < 4; ++blk) { const bf16x8 a = *(const __attribute__((address_space(3))) bf16x8*)(a0 + blk * (32 * 704) + 32 * ks); acc[blk] = MID_MFMA(w, a, acc[blk]); } }
}
__device__ __forceinline__ void p2_latent(KArgs ka, int l, int tok0, lptr L, int wv) {
    unsigned char* ws = ka->ws; const int lane = lane_id(), r32 = lane & 31, hi = lane >> 5, tb = wv & 3, g = wv >> 2;
    const unsigned short* Z = (const unsigned short*)(ws + WS_Z); const size_t wl = WS_W + (size_t)l * W_LAYER;
    {
        const unsigned lds0 = (unsigned)(uintptr_t)L;
#pragma unroll
        for (int p = 0; p < 11; ++p) { const int id = (wv * 11 + p) * 64 + lane, row = id / 44, ch = id % 44;
            glds16(Z + (size_t)(tok0 + row) * DINP + ch * 8, (unsigned)__builtin_amdgcn_readfirstlane(lds0 + (wv * 11 + p) * 1024)); }
        asm volatile("s_waitcnt vmcnt(0)" ::: "memory"); __syncthreads();
    }
    __attribute__((address_space(3))) float* tbl = (__attribute__((address_space(3))) float*)(L + LAT_TBL);
    {   const int tid = wv * 64 + lane, tl = tid & 127, lat = (tid >> 7) & 1, half = tid >> 8;
        __attribute__((address_space(3))) const char* row = (__attribute__((address_space(3))) const char*)L + tl * 704 + (lat ? O_KVC * 2 + half * 128 : half * 192);
        float sq = 0.f;
#pragma unroll
        for (int c = 0; c < 12; ++c) if (c < 8 || lat == 0) sq += sumsq8(*(const __attribute__((address_space(3))) bf16x8*)(row + 16 * c));
        tbl[(half * 2 + lat) * 128 + tl] = sq;
        __syncthreads();
        if (tid < 256) { const int l2 = tid >> 7, t2 = tid & 127; const float ss = tbl[l2 * 128 + t2] + tbl[(2 + l2) * 128 + t2];
            tbl[512 + l2 * 128 + t2] = rsqrtf(ss * (l2 ? 1.0f / 128.0f : 1.0f / 192.0f) + EPS) * (l2 ? 1.0f : QSCALE); }
        __syncthreads();
    }
    __attribute__((address_space(3))) char* stg = (__attribute__((address_space(3))) char*)(L + OSTG_OFF + wv * OSTG_BYTES);
    for (int it = 0; it < 4; ++it) {
        int jt; bool isq;
        if (wv < 4) { if (it == 3) break; isq = it < 2; jt = it < 2 ? wv + 8 * it : wv; }
        else { isq = it == 0; jt = it == 0 ? wv : 4 + 3 * (wv - 4) + (it - 1); }
        f32x16 acc[4];
        __attribute__((address_space(3))) const char* a0 = (__attribute__((address_space(3))) const char*)L + r32 * 704 + 16 * hi + (isq ? 0 : O_KVC * 2);
        if (isq) latent_tile<12>(acc, a0, (const unsigned short*)(ws + wl + W_UQ) + (size_t)jt * 12 * 512 + lane * 8);
        else latent_tile<8>(acc, a0, (const unsigned short*)(ws + wl + W_UKV) + (size_t)jt * 8 * 512 + lane * 8);
        const bool rope = isq && (jt % 3) == 2;
#pragma unroll
        for (int blk = 0; blk < 4; ++blk) {
            const float rs = tbl[512 + (isq ? 0 : 128) + 32 * blk + r32];
            f32x16 t = acc[blk] * rs;
            if (rope) rope_tile(t, (const float*)(ws + WS_ROPE) + (size_t)(tok0 + 32 * blk + r32) * 32, hi);
            typedef unsigned u32x2_ __attribute__((ext_vector_type(2)));
#pragma unroll
            for (int g = 0; g < 4; ++g) { u32x2_ w; w.x = cvtpk(t[4 * g], t[4 * g + 1]); w.y = cvtpk(t[4 * g + 2], t[4 * g + 3]);
                *(__attribute__((address_space(3))) u32x2_*)(stg + r32 * 80 + (8 * g + 4 * hi) * 2) = w; }
            asm volatile("s_waitcnt lgkmcnt(0)" ::: "memory");
            unsigned short* dst; int pitch;
            if (isq) { dst = (unsigned short*)(ws + WS_Q) + (size_t)(tok0 + 32 * blk) * 384 + 32 * jt; pitch = 384; }
            else { const int head = jt >> 2, nt = jt & 3;
                if (nt < 2) { dst = (unsigned short*)(ws + WS_K) + (size_t)(tok0 + 32 * blk) * 384 + head * 96 + 32 * nt; pitch = 384; }
                else { dst = (unsigned short*)(ws + WS_V) + (size_t)(tok0 + 32 * blk) * 256 + head * 64 + 32 * (nt - 2); pitch = 256; } }
#pragma unroll
            for (int i2 = 0; i2 < 2; ++i2) { const int row = i2 * 16 + (lane >> 2), ch = lane & 3;
                *(u32x4*)(dst + (size_t)row * pitch + ch * 8) = *(const __attribute__((address_space(3))) u32x4*)(stg + row * 80 + ch * 16); }
            asm volatile("s_waitcnt lgkmcnt(0)" ::: "memory");
        }
    }
    {
        const int tid = wv * 64 + lane, tl = tid & 127, t = tok0 + tl, i0 = 4 * (tid >> 7);
        __attribute__((address_space(3))) const unsigned short* zr = (__attribute__((address_space(3))) const unsigned short*)(L + tl * 704 + O_KR * 2); const float* rk = (const float*)(ws + WS_ROPE) + (size_t)t * 32;
        __syncthreads();
        __attribute__((address_space(3))) unsigned short* rt = (__attribute__((address_space(3))) unsigned short*)(L + OSTG_OFF);
#pragma unroll
        for (int q = 0; q < 4; ++q) { const int i = i0 + q; const float x1 = bfu(zr[i]), x2 = bfu(zr[16 + i]), c = rk[2 * i], sn = rk[2 * i + 1];
            rt[tl * 32 + i] = (unsigned short)f2bf(x1 * c - x2 * sn); rt[tl * 32 + 16 + i] = (unsigned short)f2bf(x2 * c + x1 * sn); }
        __syncthreads();
        unsigned short* K = (unsigned short*)(ws + WS_K) + (size_t)tok0 * 384;
#pragma unroll
        for (int k = 0; k < 4; ++k) { const int cidx = tid + 512 * k, tok = cidx >> 4, hd = (cidx >> 2) & 3, part = cidx & 3;
            *(u32x4*)(K + (size_t)tok * 384 + hd * 96 + 64 + part * 8) = *(const __attribute__((address_space(3))) u32x4*)(rt + tok * 32 + part * 8); }
    }
    __syncthreads();
}

__device__ __forceinline__ float log_sigmoid(float x) { return fminf(x, 0.f) - 0.6931471805599453f * __builtin_amdgcn_logf(1.f + __builtin_amdgcn_exp2f(-1.4426950408889634f * fabsf(x))); }
__device__ __forceinline__ void p2_forget(KArgs ka, int l, int b, int tt, lptr L, int wv) {
    unsigned char* ws = ka->ws; const int lane = lane_id(), tid = wv * 64 + lane, h = tid & 3, j = tid >> 2;
    const float* FL = (const float*)(ws + WS_FL) + (size_t)b * S * 4; const float bf = ka->in[9][l * 4 + h];
    __attribute__((address_space(3))) double* red = (__attribute__((address_space(3))) double*)(L + 8 * STG_BYTES + 1024);
    __attribute__((address_space(3))) float* own = (__attribute__((address_space(3))) float*)(L + 8 * STG_BYTES + 1024 + 4096);
    double part = 0.0;
#pragma unroll 8
    for (int t = j; t < 128 * tt; t += 128) part += (double)log_sigmoid(FL[(size_t)t * 4 + h] + bf);
    red[h * 128 + j] = part; own[h * 128 + j] = log_sigmoid(FL[(size_t)(128 * tt + j) * 4 + h] + bf);
    __syncthreads();
    if (wv < 4) {
        const int hh = wv; double c = red[hh * 128 + 2 * lane] + red[hh * 128 + 2 * lane + 1];
#pragma unroll
        for (int o = 1; o < 64; o <<= 1) c += lshfl(c, lane ^ o);
        const float v0 = own[hh * 128 + 2 * lane], v1 = own[hh * 128 + 2 * lane + 1]; float s = v0 + v1, incl = s;
#pragma unroll
        for (int o = 1; o < 64; o <<= 1) { const float up = lshfl(incl, (lane - o) & 63); if (lane >= o) incl += up; }
        const double c0 = c + (double)(incl - s) + (double)v0, c1 = c0 + (double)v1;
        float* cbx = (float*)(ws + WS_CBX) + ((size_t)(b * 64 + 2 * tt) * 4 + hh) * 64;
#pragma unroll
        for (int q = 0; q < 2; ++q) { const int k128 = 2 * lane + q, tile = k128 >> 6, k = k128 & 63, khi = (k >> 2) & 1, n = k >> 5, r = (k & 3) + 4 * ((k & 31) >> 3);
            cbx[(size_t)tile * 256 + khi * 32 + n * 16 + r] = (float)(-(q ? c1 : c0) * 1.4426950408889634); }
    }
    __syncthreads();
}

__device__ __forceinline__ float gelu_tanh(float x) { const float u = 0.7978845608028654f * (x + 0.044715f * x * x * x); const float e = __expf(2.f * u); return x * (1.f - __builtin_amdgcn_rcpf(e + 1.f)); }
__device__ __forceinline__ void lru_load_table(KArgs ka, int l, lptr L, int wv) {
    const int tid = wv * 64 + lane_id(); __attribute__((address_space(3))) float* tab = (__attribute__((address_space(3))) float*)(L + LRU_TAB_OFF);
    const float* cw = ka->in[10] + (size_t)l * 4 * LRU_W; const float* cbias = ka->in[11] + (size_t)l * LRU_W;
    for (int i = tid; i < 5 * LRU_W; i += 512) tab[i] = i < 4 * LRU_W ? cw[i] : cbias[i - 4 * LRU_W];
    __syncthreads();
}
__device__ __forceinline__ void lru_pass1(KArgs ka, int l, int b, int tt, lptr L, int wv) {
    unsigned char* ws = ka->ws; const int lane = lane_id(), r32 = lane & 31, hi = lane >> 5;
    const int cb0 = 64 * wv, u = b * 32 + tt;
    const unsigned short* Z = (const unsigned short*)(ws + WS_Z); const size_t wl = WS_W + (size_t)l * W_LAYER;
    const __attribute__((address_space(3))) float* tab = (const __attribute__((address_space(3))) float*)(L + LRU_TAB_OFF) + cb0 + 8 * hi;
    bf16x8 idf[2];
#pragma unroll
    for (int q = 0; q < 2; ++q)
#pragma unroll
        for (int j = 0; j < 8; ++j) idf[q][j] = ((r32 >> 4) == q && (r32 & 15) == 8 * hi + j) ? (short)0x3f80 : (short)0;
    float A_run[2] = {1.f, 1.f}, H_run[2] = {0.f, 0.f};
    const unsigned short* zl = Z + (size_t)(b * S) * DINP + O_LX + cb0 + 8 * hi;
#define LRU_LOADZ(dst, sbi) do { const int t_ = 128 * tt + 32 * (sbi) + r32; const int tc_ = t_ < 0 ? 0 : t_; _Pragma("unroll") for (int ks = 0; ks < 4; ++ks) { \
        bf16x8 v_ = *reinterpret_cast<const bf16x8*>(zl + (size_t)tc_ * DINP + 16 * ks); if (t_ < 0) v_ = bf16x8{}; dst[ks] = v_; } } while (0)
    bf16x8 wrf[2][4], wif[2][4];
#pragma unroll
    for (int nt = 0; nt < 2; ++nt)
#pragma unroll
        for (int ks = 0; ks < 4; ++ks) { const size_t o = (size_t)wv * 4096 + (size_t)(nt * 4 + ks) * 512 + lane * 8;
            wrf[nt][ks] = *reinterpret_cast<const bf16x8*>((const unsigned short*)(ws + wl + W_R) + o); wif[nt][ks] = *reinterpret_cast<const bf16x8*>((const unsigned short*)(ws + wl + W_I) + o); }
    bf16x8 zprev[4], zcur[4], znext[4];
    LRU_LOADZ(zprev, -1); LRU_LOADZ(zcur, 0);
    for (int sb = 0; sb < 4; ++sb) {
        if (sb < 3) LRU_LOADZ(znext, sb + 1);
        bf16x8 af[4];
#pragma unroll
        for (int ks = 0; ks < 4; ++ks) {
            float xv[8];
            { const f32x4 b0 = *(const __attribute__((address_space(3))) f32x4*)(tab + 4 * LRU_W + 16 * ks), b1 = *(const __attribute__((address_space(3))) f32x4*)(tab + 4 * LRU_W + 16 * ks + 4);
              const f32x4 w0 = *(const __attribute__((address_space(3))) f32x4*)(tab + 3 * LRU_W + 16 * ks), w1 = *(const __attribute__((address_space(3))) f32x4*)(tab + 3 * LRU_W + 16 * ks + 4);
#pragma unroll
              for (int j = 0; j < 4; ++j) { xv[j] = b0[j] + w0[j] * bfu((unsigned short)zcur[ks][j]); xv[4 + j] = b1[j] + w1[j] * bfu((unsigned short)zcur[ks][4 + j]); } }
            const u32x4 cu = __builtin_bit_cast(u32x4, zcur[ks]), pu = __builtin_bit_cast(u32x4, zprev[ks]);
#pragma unroll
            for (int d = 1; d <= 3; ++d) {
                const int src = (((r32 - d) & 31) + 32 * hi) * 4; u32x4 sh;
#pragma unroll
                for (int q = 0; q < 4; ++q) { const unsigned c_ = (unsigned)__builtin_amdgcn_ds_bpermute(src, (int)cu[q]), p_ = (unsigned)__builtin_amdgcn_ds_bpermute(src, (int)pu[q]); sh[q] = r32 >= d ? c_ : p_; }
                const f32x4 w0 = *(const __attribute__((address_space(3))) f32x4*)(tab + (3 - d) * LRU_W + 16 * ks), w1 = *(const __attribute__((address_space(3))) f32x4*)(tab + (3 - d) * LRU_W + 16 * ks + 4);
                xv[0] += w0[0] * bf_lo(sh[0]); xv[1] += w0[1] * bf_hi(sh[0]); xv[2] += w0[2] * bf_lo(sh[1]); xv[3] += w0[3] * bf_hi(sh[1]);
                xv[4] += w1[0] * bf_lo(sh[2]); xv[5] += w1[1] * bf_hi(sh[2]); xv[6] += w1[2] * bf_lo(sh[3]); xv[7] += w1[3] * bf_hi(sh[3]); }
#pragma unroll
            for (int j = 0; j < 8; ++j) af[ks][j] = (short)f2bf(xv[j]);
        }
#pragma unroll
        for (int nt = 0; nt < 2; ++nt) {
            __builtin_amdgcn_sched_barrier(0);
            const int ch = cb0 + 32 * nt + r32;
            f32x16 rp = f32x16{}, ip = f32x16{}, xc = f32x16{};
#pragma unroll
            for (int ks = 0; ks < 4; ++ks) { rp = MID_MFMA(af[ks], wrf[nt][ks], rp); ip = MID_MFMA(af[ks], wif[nt][ks], ip); }
            xc = MID_MFMA(af[2 * nt], idf[0], xc); xc = MID_MFMA(af[2 * nt + 1], idf[1], xc);
            u32x4 pk[4];
            {   const float br = ka->in[13][l * LRU_W + ch], bi = ka->in[15][l * LRU_W + ch]; const float nl = -ka->in[16][l * LRU_W + ch]; const float la8 = -8.0f * (fmaxf(nl, 0.f) + 0.6931471805599453f * __builtin_amdgcn_logf(1.f + __builtin_amdgcn_exp2f(-1.4426950408889634f * fabsf(nl))));
#pragma unroll
                for (int r = 0; r < 16; ++r) { const float rg = __builtin_amdgcn_rcpf(1.f + __expf(-(rp[r] + br))), ig = __builtin_amdgcn_rcpf(1.f + __expf(-(ip[r] + bi)));
                    const float a = __expf(rg * la8); rp[r] = 1.f - a; ip[r] = __builtin_amdgcn_sqrtf(fmaxf(1.f - a * a, 0.f)) * (ig * xc[r]); }
#pragma unroll
                for (int r = 0; r < 16; r += 2) { const unsigned wa = pk2(rp[r], rp[r + 1]), wb = pk2(ip[r], ip[r + 1]); pk[r >> 3][(r >> 1) & 3] = wa; pk[2 + (r >> 3)][(r >> 1) & 3] = wb;
                    rp[r] = 1.f - bf_lo(wa); rp[r + 1] = 1.f - bf_hi(wa); ip[r] = bf_lo(wb); ip[r + 1] = bf_hi(wb); } }
            float st = H_run[nt], ap = A_run[nt];
#pragma unroll
            for (int g = 0; g < 4; ++g) { float A = 1.f, Bv = 0.f;
#pragma unroll
                for (int q = 0; q < 4; ++q) { const float a = rp[4 * g + q]; Bv = a * Bv + ip[4 * g + q]; A *= a; }
                auto ta = __builtin_amdgcn_permlane32_swap(__float_as_uint(A), __float_as_uint(A), false, false); auto tb = __builtin_amdgcn_permlane32_swap(__float_as_uint(Bv), __float_as_uint(Bv), false, false);
                const float oA = __uint_as_float(hi ? ta[0] : ta[1]), oB = __uint_as_float(hi ? tb[0] : tb[1]);
                const float pA = hi ? oA : A, pB = hi ? oB : Bv, qA = hi ? A : oA, qB = hi ? Bv : oB;
                st = pA * st + pB; st = qA * st + qB; ap *= pA * qA; }
            H_run[nt] = st; A_run[nt] = ap;
        }
#pragma unroll
        for (int ks = 0; ks < 4; ++ks) { zprev[ks] = zcur[ks]; zcur[ks] = znext[ks]; }
    }
#undef LRU_LOADZ
    if (hi == 0) {
#pragma unroll
        for (int nt = 0; nt < 2; ++nt) { float* sum = (float*)(ws + WS_LRUSUM) + (size_t)u * 1024 + cb0 + 32 * nt + r32; sum[0] = A_run[nt]; sum[512] = H_run[nt]; } }
}
__device__ __forceinline__ void lru_pass2r(KArgs ka, int l, int b, int tt, lptr L, int wv) {
    unsigned char* ws = ka->ws; const int lane = lane_id(), r32 = lane & 31, hi = lane >> 5;
    const int cb0 = 64 * wv, u = b * 32 + tt;
    const unsigned short* Z = (const unsigned short*)(ws + WS_Z); const size_t wl = WS_W + (size_t)l * W_LAYER;
    const __attribute__((address_space(3))) float* tab = (const __attribute__((address_space(3))) float*)(L + LRU_TAB_OFF) + cb0 + 8 * hi;
    bf16x8 idf[2];
#pragma unroll
    for (int q = 0; q < 2; ++q)
#pragma unroll
        for (int j = 0; j < 8; ++j) idf[q][j] = ((r32 >> 4) == q && (r32 & 15) == 8 * hi + j) ? (short)0x3f80 : (short)0;
    float H_run[2] = {0.f, 0.f}; const int tok0 = b * S + 128 * tt;
    { const float* sum = (const float*)(ws + WS_LRUSUM) + (size_t)(b * 32) * 1024;
#pragma unroll 8
      for (int t2 = 0; t2 < tt; ++t2)
#pragma unroll
          for (int nt = 0; nt < 2; ++nt) { const int ch = cb0 + 32 * nt + r32; H_run[nt] = sum[(size_t)t2 * 1024 + ch] * H_run[nt] + sum[(size_t)t2 * 1024 + 512 + ch]; } }
    __attribute__((address_space(3))) float* otile = (__attribute__((address_space(3))) float*)L;
    bf16x8 lg[4];
#define LRU_LOADG(sbi) do { _Pragma("unroll") for (int ks = 0; ks < 4; ++ks) lg[ks] = *reinterpret_cast<const bf16x8*>(Z + (size_t)(tok0 + 32 * (sbi) + r32) * DINP + O_LG + cb0 + 16 * ks + 8 * hi); } while (0)
    const unsigned short* zl = Z + (size_t)(b * S) * DINP + O_LX + cb0 + 8 * hi;
#define LRU_LOADZ(dst, sbi) do { const int t_ = 128 * tt + 32 * (sbi) + r32; const int tc_ = t_ < 0 ? 0 : t_; _Pragma("unroll") for (int ks = 0; ks < 4; ++ks) { \
        bf16x8 v_ = *reinterpret_cast<const bf16x8*>(zl + (size_t)tc_ * DINP + 16 * ks); if (t_ < 0) v_ = bf16x8{}; dst[ks] = v_; } } while (0)
    bf16x8 wrf[2][4], wif[2][4];
#pragma unroll
    for (int nt = 0; nt < 2; ++nt)
#pragma unroll
        for (int ks = 0; ks < 4; ++ks) { const size_t o = (size_t)wv * 4096 + (size_t)(nt * 4 + ks) * 512 + lane * 8;
            wrf[nt][ks] = *reinterpret_cast<const bf16x8*>((const unsigned short*)(ws + wl + W_R) + o); wif[nt][ks] = *reinterpret_cast<const bf16x8*>((const unsigned short*)(ws + wl + W_I) + o); }
    bf16x8 zprev[4], zcur[4], znext[4];
    LRU_LOADZ(zprev, -1); LRU_LOADZ(zcur, 0);
    for (int sb = 0; sb < 4; ++sb) {
        if (sb < 3) LRU_LOADZ(znext, sb + 1);
        LRU_LOADG(sb);
        bf16x8 af[4];
#pragma unroll
        for (int ks = 0; ks < 4; ++ks) {
            float xv[8];
            { const f32x4 b0 = *(const __attribute__((address_space(3))) f32x4*)(tab + 4 * LRU_W + 16 * ks), b1 = *(const __attribute__((address_space(3))) f32x4*)(tab + 4 * LRU_W + 16 * ks + 4);
              const f32x4 w0 = *(const __attribute__((address_space(3))) f32x4*)(tab + 3 * LRU_W + 16 * ks), w1 = *(const __attribute__((address_space(3))) f32x4*)(tab + 3 * LRU_W + 16 * ks + 4);
#pragma unroll
              for (int j = 0; j < 4; ++j) { xv[j] = b0[j] + w0[j] * bfu((unsigned short)zcur[ks][j]); xv[4 + j] = b1[j] + w1[j] * bfu((unsigned short)zcur[ks][4 + j]); } }
            const u32x4 cu = __builtin_bit_cast(u32x4, zcur[ks]), pu = __builtin_bit_cast(u32x4, zprev[ks]);
#pragma unroll
            for (int d = 1; d <= 3; ++d) {
                const int src = (((r32 - d) & 31) + 32 * hi) * 4; u32x4 sh;
#pragma unroll
                for (int q = 0; q < 4; ++q) { const unsigned c_ = (unsigned)__builtin_amdgcn_ds_bpermute(src, (int)cu[q]), p_ = (unsigned)__builtin_amdgcn_ds_bpermute(src, (int)pu[q]); sh[q] = r32 >= d ? c_ : p_; }
                const f32x4 w0 = *(const __attribute__((address_space(3))) f32x4*)(tab + (3 - d) * LRU_W + 16 * ks), w1 = *(const __attribute__((address_space(3))) f32x4*)(tab + (3 - d) * LRU_W + 16 * ks + 4);
                xv[0] += w0[0] * bf_lo(sh[0]); xv[1] += w0[1] * bf_hi(sh[0]); xv[2] += w0[2] * bf_lo(sh[1]); xv[3] += w0[3] * bf_hi(sh[1]);
                xv[4] += w1[0] * bf_lo(sh[2]); xv[5] += w1[1] * bf_hi(sh[2]); xv[6] += w1[2] * bf_lo(sh[3]); xv[7] += w1[3] * bf_hi(sh[3]); }
#pragma unroll
            for (int j = 0; j < 8; ++j) af[ks][j] = (short)f2bf(xv[j]);
        }
#pragma unroll
        for (int nt = 0; nt < 2; ++nt) {
            __builtin_amdgcn_sched_barrier(0);
            const int ch = cb0 + 32 * nt + r32;
            f32x16 rp = f32x16{}, ip = f32x16{}, xc = f32x16{};
#pragma unroll
            for (int ks = 0; ks < 4; ++ks) { rp = MID_MFMA(af[ks], wrf[nt][ks], rp); ip = MID_MFMA(af[ks], wif[nt][ks], ip); }
            xc = MID_MFMA(af[2 * nt], idf[0], xc); xc = MID_MFMA(af[2 * nt + 1], idf[1], xc);
            u32x4 pk[4];
            {   const float br = ka->in[13][l * LRU_W + ch], bi = ka->in[15][l * LRU_W + ch]; const float nl = -ka->in[16][l * LRU_W + ch]; const float la8 = -8.0f * (fmaxf(nl, 0.f) + 0.6931471805599453f * __builtin_amdgcn_logf(1.f + __builtin_amdgcn_exp2f(-1.4426950408889634f * fabsf(nl))));
#pragma unroll
                for (int r = 0; r < 16; ++r) { const float rg = __builtin_amdgcn_rcpf(1.f + __expf(-(rp[r] + br))), ig = __builtin_amdgcn_rcpf(1.f + __expf(-(ip[r] + bi)));
                    const float a = __expf(rg * la8); rp[r] = 1.f - a; ip[r] = __builtin_amdgcn_sqrtf(fmaxf(1.f - a * a, 0.f)) * (ig * xc[r]); }
#pragma unroll
                for (int r = 0; r < 16; r += 2) { const unsigned wa = pk2(rp[r], rp[r + 1]), wb = pk2(ip[r], ip[r + 1]); pk[r >> 3][(r >> 1) & 3] = wa; pk[2 + (r >> 3)][(r >> 1) & 3] = wb;
                    rp[r] = 1.f - bf_lo(wa); rp[r + 1] = 1.f - bf_hi(wa); ip[r] = bf_lo(wb); ip[r + 1] = bf_hi(wb); } }
            f32x16 lgc = f32x16{}; lgc = MID_MFMA(lg[2 * nt], idf[0], lgc); lgc = MID_MFMA(lg[2 * nt + 1], idf[1], lgc);
            float carry[4]; float st = H_run[nt];
#pragma unroll
            for (int g = 0; g < 4; ++g) { float A = 1.f, Bv = 0.f;
#pragma unroll
                for (int q = 0; q < 4; ++q) { const float a = rp[4 * g + q]; Bv = a * Bv + ip[4 * g + q]; A *= a; }
                auto ta = __builtin_amdgcn_permlane32_swap(__float_as_uint(A), __float_as_uint(A), false, false); auto tb = __builtin_amdgcn_permlane32_swap(__float_as_uint(Bv), __float_as_uint(Bv), false, false);
                const float oA = __uint_as_float(hi ? ta[0] : ta[1]), oB = __uint_as_float(hi ? tb[0] : tb[1]);
                const float pA = hi ? oA : A, pB = hi ? oB : Bv, qA = hi ? A : oA, qB = hi ? Bv : oB;
                const float c0 = st; st = pA * st + pB; const float c1 = st; st = qA * st + qB; carry[g] = hi ? c1 : c0; }
            H_run[nt] = st;
#pragma unroll
            for (int g = 0; g < 4; ++g) { float hcur = carry[g];
#pragma unroll
                for (int q = 0; q < 4; ++q) { const int r = 4 * g + q; hcur = rp[r] * hcur + ip[r]; otile[(sb & 1) * 16384 + crow(r, hi) * 512 + ch] = hcur * gelu_tanh(lgc[r]); } }
        }
        __syncthreads();
#pragma unroll
        for (int q = 0; q < 4; ++q) { const int row = 4 * wv + q; const __attribute__((address_space(3))) float* src = otile + (sb & 1) * 16384 + row * 512 + 8 * lane;
            const f32x4 x0 = *(const __attribute__((address_space(3))) f32x4*)src, x1 = *(const __attribute__((address_space(3))) f32x4*)(src + 4);
            float s = (x0[0] * x0[0] + x0[1] * x0[1]) + (x0[2] * x0[2] + x0[3] * x0[3]) + (x1[0] * x1[0] + x1[1] * x1[1]) + (x1[2] * x1[2] + x1[3] * x1[3]);
            s = wave_sum(s, lane); const float rn = rsqrtf(s * (1.0f / 512.0f) + EPS);
            u32x4 o; o.x = pk2(x0[0] * rn, x0[1] * rn); o.y = pk2(x0[2] * rn, x0[3] * rn); o.z = pk2(x1[0] * rn, x1[1] * rn); o.w = pk2(x1[2] * rn, x1[3] * rn);
            *(u32x4*)((unsigned short*)(ws + WS_O) + (size_t)(tok0 + 32 * sb + row) * D + 512 + 8 * lane) = o; }
#pragma unroll
        for (int ks = 0; ks < 4; ++ks) { zprev[ks] = zcur[ks]; zcur[ks] = znext[ks]; }
    }
#undef LRU_LOADZ
#undef LRU_LOADG
}
__device__ __forceinline__ void attn_group_norm(KArgs ka, int b, int tt, int wv) {
    unsigned char* ws = ka->ws; const int lane = lane_id(); const int tok0 = b * S + 128 * tt;
#pragma unroll
    for (int q0 = 0; q0 < 16; q0 += 8) { u32x4 v[8]; unsigned short* p0 = (unsigned short*)(ws + WS_O) + (size_t)(tok0 + 16 * wv + q0) * D + 8 * lane;
#pragma unroll
        for (int q = 0; q < 8; ++q) v[q] = *(const u32x4*)(p0 + (size_t)q * D);
#pragma unroll
        for (int q = 0; q < 8; ++q) {
            float f[8] = {bf_lo(v[q].x), bf_hi(v[q].x), bf_lo(v[q].y), bf_hi(v[q].y), bf_lo(v[q].z), bf_hi(v[q].z), bf_lo(v[q].w), bf_hi(v[q].w)};
            float s = 0.f;
#pragma unroll
            for (int j = 0; j < 8; ++j) s += f[j] * f[j];
#pragma unroll
            for (int o = 1; o < 32; o <<= 1) s += lshfl(s, lane ^ o);
            const float rn = rsqrtf(s * (1.0f / 256.0f) + EPS);
            u32x4 w; w.x = pk2(f[0] * rn, f[1] * rn); w.y = pk2(f[2] * rn, f[3] * rn); w.z = pk2(f[4] * rn, f[5] * rn); w.w = pk2(f[6] * rn, f[7] * rn); *(u32x4*)(p0 + (size_t)q * D) = w; } }
}
}
__device__ __forceinline__ int zcol_perm(int n) { return n < 1120 ? n : (n < 1124 ? 2144 + (n - 1120) : (n < DIN ? n - 4 : n)); }
__device__ __forceinline__ int up_perm(int n) { return n < DFF ? 256 * (n >> 7) + (n & 127) : 256 * ((n - DFF) >> 7) + 128 + ((n - DFF) & 127); }
__device__ __forceinline__ void tr_item(const float* W, int K, int N, const float* g, bf16* WT, int mode, LAS float* scr, int kb, int nb, int lane) {
    const int k0 = 64 * kb, n0 = 32 * nb;
#pragma unroll 8
    for (int i = 0; i < 32; ++i) { const int kk = 2 * i + (lane >> 5), n = n0 + (lane & 31); float v = (n < N) ? W[(size_t)(k0 + kk) * N + n] : 0.f; if (g) v *= g[k0 + kk]; scr[kk * 33 + (lane & 31)] = v; }
    LDS_WAIT(); asm volatile("" ::: "memory");
    const int c = lane & 7;
#pragma unroll
    for (int j = 0; j < 4; ++j) { const int nl = (lane >> 3) + 8 * j, n = n0 + nl; const int dest = mode == 1 ? up_perm(n) : (mode == 2 ? zcol_perm(n) : n); const LAS float* s = scr + (8 * c) * 33 + nl;
        v4u o; o.x = pk2(s[0 * 33], s[1 * 33]); o.y = pk2(s[2 * 33], s[3 * 33]); o.z = pk2(s[4 * 33], s[5 * 33]); o.w = pk2(s[6 * 33], s[7 * 33]);
        if (mode == 3) { const int c8 = (k0 >> 3) + c;
            *(GAS v4u*)(WT + ((size_t)((n >> 5) * (K >> 4) + (c8 >> 1)) * 64 + (c8 & 1) * 32 + (n & 31)) * 8) = o; }
        else *(GAS v4u*)(WT + (size_t)dest * K + k0 + 8 * c) = o; }
    LDS_WAIT(); asm volatile("" ::: "memory");
}
__global__ void __launch_bounds__(NWAVES * 64, 2) mega(Args args) {
    extern __shared__ __attribute__((aligned(16))) unsigned char lds[];
    LAS unsigned char* L = (LAS unsigned char*)lds;
    const int wave = __builtin_amdgcn_readfirstlane((int)threadIdx.x >> 6);
    {
        const int t0 = wave * 64 + lane_id();
        for (int u = t0; u < (LDS_BYTES - LDSCTL_OFF) / 4; u += NWAVES * 64) ((LAS unsigned*)(L + LDSCTL_OFF))[u] = 0u;
        __syncthreads();
        if (kargs()->ph_hi - kargs()->ph_lo > 1) (void)xcd_barrier_post((unsigned*)(kargs()->ws + WS_CTL) + CW_BAR, (volatile LAS unsigned*)(L + MISC_OFF) + 8);
    }
#define GRID_BAR(p) do { if (IN(p) && IN((p) + 1)) { XcdBarrier gb_; gb_.bar = (unsigned*)(kargs()->ws + WS_CTL) + CW_BAR; gb_.x = xb_xcc_id(); gb_.st = (volatile LAS unsigned*)(L + MISC_OFF) + 8; xcd_barrier(gb_); } } while (0)
#define GRID_IDS int G = gridDim.x, bx = blockIdx.x, wv = wave; asm volatile("" : "+s"(G), "+s"(bx), "+s"(wv)); const int vcu = (G % 8 == 0) ? (bx % 8) * (G / 8) + bx / 8 : bx; const int gw = vcu * NWAVES + wv, NGW = G * NWAVES; (void)gw; (void)NGW
#ifndef PH_MASK
#define PH_MASK 0xFFFFFF
#endif
#ifndef REPEAT_MASK
#define REPEAT_MASK 0
#endif
#define IN(p) (kargs()->ph_lo <= (p) && (p) < kargs()->ph_hi)
#define PHASE_PTRS const KArgs ka = kargs(); unsigned char* ws = ka->ws; (void)ws; GRID_IDS
#define LANE_IDS const int lane = lane_id(), tid = wv * 64 + lane; (void)tid
    if ((PH_MASK & 1) && IN(0)) {
            PHASE_PTRS; LANE_IDS; bf16* HB = (bf16*)(ws + WS_HB); float* SSA = (float*)(ws + WS_SSA);
            LAS float* scr = (LAS float*)(L + RING_OFF + wv * 16384);
            {
                constexpr int I_IN = (D / 64) * (DINP / 32), I_O = (D / 64) * (D / 32), I_UP = (D / 64) * (2 * DFF / 32), I_DN = (DFF / 64) * (D / 32), I_PG = I_O, I_PP = (PLE / 64) * (D / 32);
                constexpr int I_UQ = (192 / 64) * (384 / 32), I_UKV = (128 / 64) * (512 / 32), I_RI = 32;
                constexpr int I_LAYER = I_IN + I_O + I_UP + I_DN + I_PG + I_PP + I_UQ + I_UKV + I_RI;
                for (int it0 = gw; it0 < DEPTH * I_LAYER; it0 += NGW) {
                    const int ll = it0 / I_LAYER; int it = it0 % I_LAYER;
                    unsigned char* w2 = ws + WS_W + (size_t)ll * W_LAYER;
                    const float* W; const float* gs; bf16* WT; int K, N, Npad, mode = 0;
                    if (it < I_IN) { W = ka->in[4] + (size_t)ll * D * DIN; gs = ka->in[3] + ll * D; WT = (bf16*)(w2 + W_IN); K = D; N = DIN; Npad = DINP; mode = 2; }
                    else if ((it -= I_IN) < I_O) { W = ka->in[18] + (size_t)ll * D * D; gs = ka->in[17] + ll * D; WT = (bf16*)(w2 + W_O); K = D; N = D; Npad = D; }
                    else if ((it -= I_O) < I_UP) { W = ka->in[20] + (size_t)ll * D * 2 * DFF; gs = ka->in[19] + ll * D; WT = (bf16*)(w2 + W_UP); K = D; N = 2 * DFF; Npad = 2 * DFF; mode = 1; }
                    else if ((it -= I_UP) < I_DN) { W = ka->in[23] + (size_t)ll * DFF * D; gs = nullptr; WT = (bf16*)(w2 + W_DN); K = DFF; N = D; Npad = D; }
                    else if ((it -= I_DN) < I_PG) { W = ka->in[25] + (size_t)ll * D * D; gs = ka->in[24] + ll * D; WT = (bf16*)(w2 + W_PG); K = D; N = D; Npad = D; }
                    else if ((it -= I_PG) < I_PP) { W = ka->in[26] + (size_t)ll * PLE * D; gs = nullptr; WT = (bf16*)(w2 + W_PP); K = PLE; N = D; Npad = D; }
                    else if ((it -= I_PP) < I_UQ) { W = ka->in[6] + (size_t)ll * 192 * 384; gs = ka->in[5] + ll * 192; WT = (bf16*)(w2 + W_UQ); K = 192; N = 384; Npad = 384; mode = 3; }
                    else if ((it -= I_UQ) < I_UKV) { W = ka->in[8] + (size_t)ll * 128 * 512; gs = ka->in[7] + ll * 128; WT = (bf16*)(w2 + W_UKV); K = 128; N = 512; Npad = 512; mode = 3; }
                    else { it -= I_UKV; const int mi = it >> 1; it &= 1;
                        W = (mi < 8 ? ka->in[12] : ka->in[14]) + ((size_t)ll * 8 + (mi & 7)) * 4096; gs = nullptr; WT = (bf16*)(w2 + (mi < 8 ? W_R : W_I)) + (size_t)(mi & 7) * 4096; K = 64; N = 64; Npad = 64; mode = 3; }
                    const int nblk = Npad / 32;
                    tr_item(W, K, N, gs, WT, mode, scr, it / nblk, it % nblk, lane);
                }
            }
            const float* x = ka->in[0];
            for (int m = gw; m < M; m += NGW) {
                const GAS f32x4* xr = (const GAS f32x4*)(x + (size_t)m * D) + lane;
                f32x4 v[4]; float s = 0.f;
#pragma unroll
                for (int j = 0; j < 4; ++j) { v[j] = xr[64 * j]; s += (v[j].x * v[j].x + v[j].y * v[j].y) + (v[j].z * v[j].z + v[j].w * v[j].w); }
                s = wave_sum(s, lane);
                GAS unsigned long long* o8 = (GAS unsigned long long*)(HB + (size_t)m * D) + lane;
#pragma unroll
                for (int j = 0; j < 4; ++j) o8[64 * j] = (unsigned long long)pk2(v[j].x, v[j].y) | ((unsigned long long)pk2(v[j].z, v[j].w) << 32);
                if (lane < 4) { f32x4 z4 = {lane == 0 ? s : 0.f, 0.f, 0.f, 0.f}; *(f32x4*)(SSA + (size_t)m * 16 + lane * 4) = z4; }
            }
            {
                float* rope = (float*)(ws + WS_ROPE); const int* pos = (const int*)ka->in[2];
                for (int i = bx * 512 + tid; i < M * 16; i += G * 512) { const int t = i >> 4, f = i & 15;
                    const float ang = (float)pos[t] * __builtin_amdgcn_exp2f(-0.8304820237218406f * (float)f);
                    double rv = (double)ang * 0.15915494309189535; rv -= __builtin_floor(rv); const float fr = (float)rv;
                    rope[2 * i] = __builtin_amdgcn_cosf(fr); rope[2 * i + 1] = __builtin_amdgcn_sinf(fr); }
            }
            {
                float* cwt = (float*)(ws + WS_CWT);
                for (int i = bx * 512 + tid; i < DEPTH * 704 * 32; i += G * 512) {
                    const int e = i & 3, slot = (i >> 2) & 7, jg = (i >> 5) % 704, ll = i / (704 * 32);
                    const int col = (slot < 4 ? 0 : DFF) + 4 * jg + e, k = slot & 3;
                    cwt[i] = (slot < 4 ? -1.4426950408889634f : -0.6931471805599453f) * (k < 3 ? ka->in[21][(size_t)ll * 3 * 2 * DFF + (size_t)k * 2 * DFF + col] : ka->in[22][(size_t)ll * 2 * DFF + col]);
                }
            }
            const float* p = ka->in[1]; bf16* PB = (bf16*)(ws + WS_PB);
            const size_t n8 = (size_t)DEPTH * M * PLE / 8;
            for (size_t i = (size_t)bx * 512 + tid; i < n8; i += (size_t)G * 512) {
                const f32x4 a = *(const f32x4*)(p + i * 8), b = *(const f32x4*)(p + i * 8 + 4);
                v4u o; o.x = pk2(a.x, a.y); o.y = pk2(a.z, a.w); o.z = pk2(b.x, b.y); o.w = pk2(b.z, b.w);
                *(v4u*)(PB + i * 8) = o;
            }
        }
    GRID_BAR(0);
    for (int l = 0; l < DEPTH; ++l) {
        const size_t wl = WS_W + (size_t)l * W_LAYER;
        if ((PH_MASK & (1 << 1)) && IN(8 * l + 1)) { for (int rep_ = 0; rep_ < ((REPEAT_MASK >> 1) & 1) + 1; ++rep_) { if (rep_) { XcdBarrier gb_; gb_.bar = (unsigned*)(kargs()->ws + WS_CTL) + CW_BAR; gb_.x = xb_xcc_id(); gb_.st = (volatile LAS unsigned*)(L + MISC_OFF) + 8; xcd_barrier(gb_); }
            PHASE_PTRS;
            pg8::Gemm g{l == 0 ? (const bf16*)(ws + WS_HB) : (const bf16*)ka->out, (const bf16*)(ws + wl + W_IN), M, DINP, D}; pg8::StatOrder So; So.init(M, DINP, G, bx); So.ss_sel = l; So.row62 = 0; So.wave = wv; So.cwt_layer = 0;
            pg8::EpiZ E{l};
            pg8::gemm_phase<pg8::EpiZ, pg8::StatOrder, true, true, false, D>(L + RING_OFF, g, So, E, wv);
            {
                pg8::Gemm gp{(const bf16*)(ws + WS_PB) + (size_t)l * M * PLE, (const bf16*)(ws + wl + W_PP), M, D, PLE}; pg8::TailOrder To; To.init(M, D, G, bx);
                To.c0 = ((M / 256) * (DINP / 256)) % G; To.u0 = 0; To.u1 = 256; if (To.c0 == 0) To.u1 = 0;
                pg8::EpiPP Ep{0};
                pg8::gemm_phase<pg8::EpiPP, pg8::TailOrder, true, true, false, PLE>(L + RING_OFF, gp, To, Ep, wv); }
        } }
        GRID_BAR(8 * l + 1);
        if ((PH_MASK & (1 << 2)) && IN(8 * l + 2)) { for (int rep_ = 0; rep_ < ((REPEAT_MASK >> 2) & 1) + 1; ++rep_) { if (rep_) { XcdBarrier gb_; gb_.bar = (unsigned*)(kargs()->ws + WS_CTL) + CW_BAR; gb_.x = xb_xcc_id(); gb_.st = (volatile LAS unsigned*)(L + MISC_OFF) + 8; xcd_barrier(gb_); }
            PHASE_PTRS;
            mid::lru_load_table(ka, l, (mid::lptr)L, wv);
            for (int u = vcu; u < 256; ) {
                const KArgs k2 = kargs(); const int b = u >> 5, tt = u & 31;
                int w2 = wv;
                asm volatile("" : "+s"(w2)); mid::p2_latent(k2, l, b * S + 128 * tt, (mid::lptr)(L + RING_OFF), w2);
                asm volatile("" : "+s"(w2)); mid::p2_forget(kargs(), l, b, tt, (mid::lptr)(L + RING_OFF), w2);
                asm volatile("" : "+s"(w2)); mid::lru_pass1(kargs(), l, b, tt, (mid::lptr)(L + RING_OFF), w2);
                int g2 = gridDim.x; asm volatile("" : "+s"(g2)); u += g2;
            }
        } }
        GRID_BAR(8 * l + 2);
        if ((PH_MASK & (1 << 3)) && IN(8 * l + 3)) { for (int rep_ = 0; rep_ < ((REPEAT_MASK >> 3) & 1) + 1; ++rep_) { if (rep_) { XcdBarrier gb_; gb_.bar = (unsigned*)(kargs()->ws + WS_CTL) + CW_BAR; gb_.x = xb_xcc_id(); gb_.st = (volatile LAS unsigned*)(L + MISC_OFF) + 8; xcd_barrier(gb_); }
            PHASE_PTRS;
            for (int v = vcu; v < 256; ) {
                const int stream = v >> 2, s4 = v & 3, mixer = stream & 1, bh = stream >> 1, b = bh >> 2, h = bh & 3;
                if (mixer == 0) {
                    for (int i = 0; i < 2; ++i) {
                        const int qb = (i == 0) ? s4 : 7 - s4;
                        unsigned char* ws = kargs()->ws;
                        att::attn_unit<6, false>((const bf16*)(ws + WS_Q) + (size_t)b * S * 384 + h * 96, 384, (const bf16*)(ws + WS_K) + (size_t)b * S * 384 + h * 96, 384,
                                                 (const bf16*)(ws + WS_V) + (size_t)b * S * 256 + h * 64, 256, (bf16*)(ws + WS_O) + (size_t)b * S * D + h * 64, D, nullptr, 0, qb, (att::lptr)(L + RING_OFF), wv);
                    }
                } else {
                    for (int i = 0; i < 2; ++i) {
                        const int qb = (i == 0) ? s4 : 7 - s4;
                        unsigned char* ws = kargs()->ws;
                        att::attn_unit<4, true>((const bf16*)(ws + WS_Z) + (size_t)b * S * DINP + O_FQ + h * 64, DINP, (const bf16*)(ws + WS_Z) + (size_t)b * S * DINP + O_FK + h * 64, DINP,
                                                (const bf16*)(ws + WS_Z) + (size_t)b * S * DINP + O_FV + h * 64, DINP, (bf16*)(ws + WS_O) + (size_t)b * S * D + 256 + h * 64, D,
                                                (const float*)(ws + WS_CBX) + (size_t)b * 64 * 256, h, qb, (att::lptr)(L + RING_OFF), wv);
                    }
                }
                int g2 = gridDim.x; asm volatile("" : "+s"(g2)); v += g2;
            }
        } }
        GRID_BAR(8 * l + 3);
        if ((PH_MASK & (1 << 4)) && IN(8 * l + 4)) { for (int rep_ = 0; rep_ < ((REPEAT_MASK >> 4) & 1) + 1; ++rep_) { if (rep_) { XcdBarrier gb_; gb_.bar = (unsigned*)(kargs()->ws + WS_CTL) + CW_BAR; gb_.x = xb_xcc_id(); gb_.st = (volatile LAS unsigned*)(L + MISC_OFF) + 8; xcd_barrier(gb_); }
            PHASE_PTRS;
            mid::lru_load_table(ka, l, (mid::lptr)L, wv);
            for (int u = vcu; u < 256; ) {
                const KArgs k2 = kargs(); const int b = u >> 5, tt = u & 31;
                int w2 = wv; asm volatile("" : "+s"(w2)); mid::lru_pass2r(k2, l, b, tt, (mid::lptr)(L + RING_OFF), w2);
                __syncthreads();
                asm volatile("" : "+s"(w2)); mid::attn_group_norm(kargs(), b, tt, w2);
                int g2 = gridDim.x; asm volatile("" : "+s"(g2)); u += g2;
            }
        } }
        GRID_BAR(8 * l + 4);
        if ((PH_MASK & (1 << 5)) && IN(8 * l + 5)) {
            PHASE_PTRS;
            pg8::Gemm g{(const bf16*)(ws + WS_O), (const bf16*)(ws + wl + W_O), M, D, D}; pg8::StaticOrder So; So.init(M, D, G, bx);
            pg8::EpiRes<0> E{l == 0 ? 0 : 1, 0, l == 0 ? 1 : 0};
            pg8::gemm_phase<pg8::EpiRes<0>, pg8::StaticOrder, true, true, false, D>(L + RING_OFF, g, So, E, wv);
        }
        GRID_BAR(8 * l + 5);
        if ((PH_MASK & (1 << 6)) && IN(8 * l + 6)) { for (int rep_ = 0; rep_ < ((REPEAT_MASK >> 6) & 1) + 1; ++rep_) { if (rep_) { XcdBarrier gb_; gb_.bar = (unsigned*)(kargs()->ws + WS_CTL) + CW_BAR; gb_.x = xb_xcc_id(); gb_.st = (volatile LAS unsigned*)(L + MISC_OFF) + 8; xcd_barrier(gb_); }
            PHASE_PTRS;
            pg8::Gemm g{(const bf16*)(ws + WS_HB) - 2 * D, (const bf16*)(ws + wl + W_UP), 133 * 256, 2 * DFF, D}; pg8::StatOrder So; So.init(133 * 256, 2 * DFF, G, bx); So.ss_sel = l == 0 ? 1 : 0; So.row62 = 1; So.wave = wv; So.cwt_layer = l;
            pg8::EpiUp E{l, l == 0 ? 1 : 0};
            pg8::gemm_phase<pg8::EpiUp, pg8::StatOrder, true, true, true, D>(L + RING_OFF, g, So, E, wv);
            {   pg8::Gemm gp{(const bf16*)(ws + WS_PB) + (size_t)l * M * PLE, (const bf16*)(ws + wl + W_PP), M, D, PLE}; pg8::TailOrder To; To.init(M, D, G, bx);
                To.c0 = (133 * (2 * DFF / 256)) % G; To.u0 = (((M / 256) * (DINP / 256)) % G) ? 256 : 0; To.u1 = 512;
                pg8::EpiPP Ep{0};
                pg8::gemm_phase<pg8::EpiPP, pg8::TailOrder, true, true, false, PLE>(L + RING_OFF, gp, To, Ep, wv); }
        } }
        GRID_BAR(8 * l + 6);
        if ((PH_MASK & (1 << 7)) && IN(8 * l + 7)) {
            PHASE_PTRS;
            pg8::Gemm g{(const bf16*)(ws + WS_ACT), (const bf16*)(ws + wl + W_DN), M, D, DFF}; pg8::StaticOrder So; So.init(M, D, G, bx);
            pg8::EpiRes<0> E{0, 0, l == 0 ? 0 : 1};
            pg8::gemm_phase<pg8::EpiRes<0>, pg8::StaticOrder, true, true, false, DFF>(L + RING_OFF, g, So, E, wv);
        }
        GRID_BAR(8 * l + 7);
        if ((PH_MASK & (1 << 8)) && IN(8 * l + 8)) {
            PHASE_PTRS;
            {   pg8::Gemm g{(const bf16*)(ws + WS_HB), (const bf16*)(ws + wl + W_PG), M, D, D}; pg8::StatOrder So; So.init(M, D, G, bx); So.ss_sel = l == 0 ? 0 : 1; So.row62 = 0; So.wave = wv; So.cwt_layer = 0;
                pg8::EpiRes<1> E{0, l == 0 ? 1 : 2, l == 0 ? 1 : 0};
                pg8::gemm_phase<pg8::EpiRes<1>, pg8::StatOrder, true, true, false, D>(L + RING_OFF, g, So, E, wv); }
        }
        GRID_BAR(8 * l + 8);
    }
    if ((PH_MASK & (1 << 17)) && IN(17)) {
            PHASE_PTRS; LANE_IDS; const float* gf = ka->in[27]; const float* ss = (const float*)(ws + WS_SSA); float* H = ka->out;
            const bf16* hb = (const bf16*)(ws + WS_O);
            for (int m = gw; m < M; m += NGW) {
                const float rs = pg8::rstd16(ss, m);
#pragma unroll
                for (int j = 0; j < 2; ++j) { const v4u w = *((const GAS v4u*)(hb + (size_t)m * D) + lane + 64 * j); const int c0 = (lane + 64 * j) * 8;
                    const f32x4 g0 = *(const GAS f32x4*)(gf + c0), g1 = *(const GAS f32x4*)(gf + c0 + 4);
                    f32x4 o0 = {pg8::bf_lo(w.x), pg8::bf_hi(w.x), pg8::bf_lo(w.y), pg8::bf_hi(w.y)}, o1 = {pg8::bf_lo(w.z), pg8::bf_hi(w.z), pg8::bf_lo(w.w), pg8::bf_hi(w.w)};
                    o0 = o0 * rs * g0; o1 = o1 * rs * g1;
                    *(GAS f32x4*)(H + (size_t)m * D + c0) = o0; *(GAS f32x4*)(H + (size_t)m * D + c0 + 4) = o1; }
            }
    }
}

extern "C" void kernel_launch(void* const* d_in, const int* in_sizes, int n_in, void* d_out, int out_size, void* d_ws, size_t ws_size, hipStream_t stream) {
    static int grid = 0;
    if (grid == 0) {
        int dev = 0, cus = 0;
        if (hipGetDevice(&dev) != hipSuccess || hipDeviceGetAttribute(&cus, hipDeviceAttributeMultiprocessorCount, dev) != hipSuccess) { grid = -1; return; }
        if (hipFuncSetAttribute((const void*)mega, hipFuncAttributeMaxDynamicSharedMemorySize, LDS_BYTES) != hipSuccess) { fprintf(stderr, "hipFuncSetAttribute failed\n"); grid = -1; return; }
        grid = cus;
        if (ws_size < WS_END) { fprintf(stderr, "workspace too small: %zu < %zu\n", ws_size, (size_t)WS_END); grid = -1; return; }
    }
    if (grid < 0) return;
    (void)hipMemsetAsync((char*)d_ws + WS_CTL, 0, CTL_ZERO_BYTES, stream);
    Args a{};
    for (int i = 0; i < 28; ++i) a.in[i] = (const float*)d_in[i];
    a.out = (float*)d_out; a.ws = (unsigned char*)d_ws;
#ifndef N_LAUNCH_MODE
#define N_LAUNCH_MODE 1
#endif
    auto run = [&](int lo, int hi) { a.ph_lo = lo; a.ph_hi = hi; hipLaunchKernelGGL(mega, dim3(grid), dim3(NWAVES * 64), LDS_BYTES, stream, a); };
    if (N_LAUNCH_MODE == 1) run(0, 18);
    else for (int ph = 0; ph < 18; ++ph) run(ph, ph + 1);
}
```

```cpp
#include <hip/hip_runtime.h>
#include <cstdio>
#include <cstdint>
#include <math.h>
constexpr int D = 1024, NB = 8, S = 4096, DEPTH = 2, PLE = 256, M = NB * S;
constexpr int DIN = 2148, DINP = 2304;
constexpr int O_QC = 0, O_KVC = 192, O_KR = 320, O_FQ = 352, O_FK = 608, O_FV = 864, O_LX = 1120, O_LG = 1632, O_FL = 2144;
constexpr int DFF = 2816, LRU_W = 512;
constexpr float EPS = 1e-6f;
constexpr int NWAVES = 8;
constexpr size_t MiB = 1u << 20;
constexpr size_t WS_CTL = 0, CTL_ZERO_BYTES = 1 * MiB;
constexpr size_t WS_SSA = 1 * MiB, WS_SSB = 3 * MiB, WS_FL = 5 * MiB, WS_CBX = 5632 * 1024, WS_CWT = 6 * MiB, WS_LRUSUM = 6656 * 1024, WS_ROPE = 7680 * 1024;
constexpr size_t WS_W = 12 * MiB, W_LAYER = 27 * MiB;
constexpr size_t W_IN = 0, W_UQ = 4608 * 1024, W_UKV = 4864 * 1024, W_R = 5120 * 1024, W_I = 5184 * 1024, W_O = 5632 * 1024, W_UP = 7680 * 1024, W_DN = 18944 * 1024, W_PG = 24576 * 1024, W_PP = 26624 * 1024;
constexpr size_t WS_HB = 68 * MiB;
constexpr size_t WS_PB = 133 * MiB;
constexpr size_t WS_PP = 165 * MiB;
constexpr size_t WS_Z = 229 * MiB;
constexpr size_t WS_Q = 373 * MiB, WS_K = 397 * MiB, WS_V = 421 * MiB;
constexpr size_t WS_O = 437 * MiB;
constexpr size_t WS_ACT = 229 * MiB;
constexpr size_t WS_END = 501 * MiB;
static_assert(WS_ACT + (size_t)M * DFF * 2 <= WS_O && WS_O + (size_t)M * D * 2 <= WS_END && WS_W + 2 * W_LAYER <= WS_HB - MiB && WS_HB + (size_t)(M + 256) * D * 2 <= WS_PB, "ws map");
constexpr int CW_BAR = 4096;
constexpr int RING_OFF = 0, RING_BYTES = 131072;
constexpr int LDSCTL_OFF = RING_BYTES, MISC_OFF = LDSCTL_OFF + 320;
constexpr int LDS_BYTES = 163840, LRU_TAB_OFF = 147456;

struct Args { const float* in[28]; float* out; unsigned char* ws; int ph_lo, ph_hi, pad0, pad1; };


typedef const __attribute__((address_space(4))) Args* KArgs;
__device__ __forceinline__ KArgs kargs() { KArgs p = (KArgs)__builtin_amdgcn_kernarg_segment_ptr(); asm volatile("" : "+s"(p)); return p; }
__device__ __forceinline__ int lane_id() { int r; asm volatile("v_mbcnt_lo_u32_b32 %0, -1, 0\n\tv_mbcnt_hi_u32_b32 %0, -1, %0" : "=v"(r)); return r; }
__device__ __forceinline__ float lshfl(float v, int src_lane) { return __builtin_bit_cast(float, __builtin_amdgcn_ds_bpermute(src_lane << 2, __builtin_bit_cast(int, v))); }
__device__ __forceinline__ double lshfl(double v, int src_lane) { const unsigned long long u = __builtin_bit_cast(unsigned long long, v);
    const unsigned lo = (unsigned)__builtin_amdgcn_ds_bpermute(src_lane << 2, (int)(unsigned)u), hi = (unsigned)__builtin_amdgcn_ds_bpermute(src_lane << 2, (int)(unsigned)(u >> 32));
    return __builtin_bit_cast(double, ((unsigned long long)hi << 32) | lo); }
__device__ __forceinline__ float wave_sum(float v, int lane) {
#pragma unroll
    for (int o = 1; o < 64; o <<= 1) v += lshfl(v, lane ^ o);
    return v;
}
namespace pg8 {
#define PG8_LAS __attribute__((address_space(3)))
typedef unsigned short bf16_t;
typedef short bf16x8 __attribute__((ext_vector_type(8)));
typedef float f32x4 __attribute__((ext_vector_type(4)));
typedef unsigned u32x4 __attribute__((ext_vector_type(4)));
constexpr int BM = 256, BK = 64, HALF = 128, HTB = HALF * BK * 2  , STAGE_BYTES = 8 * HTB, NXCD = 8, WGM = 8;

__host__ __device__ __forceinline__ int lds_byte(int r, int c) { const int st = (r >> 4) * 2 + (c >> 5), rr = r & 15, cc = c & 31, ob = rr * 64 + cc * 2; return st * 1024 + (ob ^ (((ob >> 9) & 1) << 5)); }
__host__ __device__ __forceinline__ void stage_rc(int b, int& R, int& C) { const int st = b / 1024, sb = b % 1024, swz = sb ^ (((sb >> 9) & 1) << 5); R = (st >> 1) * 16 + swz / 64; C = (st & 1) * 32 + (swz % 64) / 2; }
__host__ __device__ __forceinline__ int perm32(int rho) { const int n = rho >> 4, i = rho & 15; return 8 * (i >> 2) + 4 * n + (i & 3); }

struct Unit { int pm, pn, par; };
struct Gemm { const bf16_t* A; const bf16_t* Bt; int M, N, K; };

struct StaticOrder {
    int nM, nN, nwg, G, c;
    __host__ __device__ void init(int M, int N, int G_, int c_) { nM = M / BM; nN = N / BM; nwg = nM * nN; G = G_; c = c_; }
    __host__ __device__ bool next(int i, Unit& u) const {
        const long L = (long)i * G + c; if (L >= nwg) return false;
        int wgid = (int)L; { const int q = nwg / NXCD, r = nwg % NXCD, xcd = wgid % NXCD, off = wgid / NXCD; wgid = (xcd < r ? xcd * (q + 1) : r * (q + 1) + (xcd - r) * q) + off; }
        const int nig = WGM * nN, gid = wgid / nig, fm = gid * WGM, gsz = (nM - fm) < WGM ? (nM - fm) : WGM;
        u.pm = fm + ((wgid % nig) % gsz); u.pn = (wgid % nig) / gsz; u.par = i & 1; return true;
    }
    __device__ __forceinline__ void a_ready(const Unit&) const {}
    __device__ __forceinline__ void done(const Unit&) const {}
};
struct TailOrder : StaticOrder {
    int c0, u0, u1;
    __host__ __device__ bool next(int i, Unit& u) const {
        if (c < c0) return false;
        const int Lu = u0 + i * (G - c0) + (c - c0); if (Lu >= u1) return false;
        u.pm = Lu / nN; u.pn = Lu % nN; u.par = i & 1; return true;
    }
};
constexpr int RSTD_TBL_OFF = 131072 + 1024;
constexpr int CWT_TBL_OFF = RSTD_TBL_OFF + 2048;
struct StatOrder : StaticOrder {
    int ss_sel, row62, wave, cwt_layer;
    __device__ __forceinline__ void a_ready(const Unit& u) const {
        if (wave < 4) { const int t = wave * 64 + lane_id();
            int row = row62 ? 248 * u.pm + 62 * (t >> 6) + (4 * (t & 15) + ((t >> 4) & 3)) - 2 : BM * u.pm + t; row = row < 0 ? 0 : (row > 32767 ? 32767 : row);
            const f32x4* p = (const f32x4*)((const float*)(kargs()->ws + (ss_sel ? WS_SSB : WS_SSA)) + (size_t)row * 16);
            const f32x4 a = p[0], b = p[1], c = p[2], d = p[3];
            const float s = (((a[0] + a[1]) + (a[2] + a[3])) + ((b[0] + b[1]) + (b[2] + b[3]))) + (((c[0] + c[1]) + (c[2] + c[3])) + ((d[0] + d[1]) + (d[2] + d[3])));
            ((PG8_LAS float*)(uintptr_t)RSTD_TBL_OFF)[u.par * 256 + t] = rsqrtf(s * (1.0f / 1024.0f) + 1e-6f); }
        else if (row62) { const int t = (wave - 4) * 64 + lane_id();
            const u32x4 v = *(const u32x4*)(kargs()->ws + WS_CWT + (size_t)cwt_layer * 90112 + (size_t)u.pn * 4096 + t * 16);
            *(PG8_LAS u32x4*)(uintptr_t)(CWT_TBL_OFF + u.par * 4096 + t * 16) = v; }
    }
};
__device__ __forceinline__ float rstd_tbl(const Unit& u, int row_in_tile) { return ((const PG8_LAS float*)(uintptr_t)RSTD_TBL_OFF)[u.par * 256 + row_in_tile]; }
typedef __bf16 bf2_t __attribute__((ext_vector_type(2)));
typedef float fl2_t __attribute__((ext_vector_type(2)));
__device__ __forceinline__ unsigned cvt_pk_bf16(float lo, float hi) { const fl2_t v = {lo, hi}; return __builtin_bit_cast(unsigned, __builtin_convertvector(v, bf2_t)); }
typedef float f32x2 __attribute__((ext_vector_type(2)));
__device__ __forceinline__ f32x2 gelu_pk(f32x2 v) {
    const f32x2 av = __builtin_elementwise_abs(v), d = av * 0.2316418882f + 1.0f;
    f32x2 t; t.x = __builtin_amdgcn_rcpf(d.x); t.y = __builtin_amdgcn_rcpf(d.y);
    f32x2 q = t * 0.5307027145f + (-0.7265760135f); q = q * t + 0.7107068705f; q = q * t + (-0.142248368f); q = q * t + 0.127414796f; q = q * t;
    const f32x2 s = (v * v) * (-0.72134752044f);
    f32x2 e; e.x = __builtin_amdgcn_exp2f(s.x); e.y = __builtin_amdgcn_exp2f(s.y);
    const f32x2 m = v * (q * e), r = v - m;
    f32x2 o; o.x = v.x < 0.f ? m.x : r.x; o.y = v.y < 0.f ? m.y : r.y; return o;
}
template <int ACT  > struct EpiBf16 {
    static constexpr bool PERM = true, AFTER_DRAIN = false; static_assert(ACT == 0 || ACT == 1, "EpiBf16: ACT is 0 (none) or 1 (gelu_pk)");
    bf16_t* O; int ldc; const float* bias; int split_cols; size_t split_stride; float scale0;
    __device__ __forceinline__ void operator()(const f32x4 (&acc)[2][2][4][2], const Unit& u, int wr, int wc, int fr, int fq) const {
        const int row0 = u.pm * BM + wr * 64 + fr; int colt = u.pn * BM; bf16_t* base = O;
        float sc = 1.f; if (split_cols) { const int t = colt / split_cols; base += (size_t)t * split_stride; colt -= t * split_cols; if (t == 0) sc = scale0; }
        const int col0 = colt + wc * 32 + 8 * fq, bcol0 = u.pn * BM + wc * 32 + 8 * fq;
        f32x4 bv[2][2];
#pragma unroll
        for (int bj = 0; bj < 2; ++bj)
#pragma unroll
            for (int n = 0; n < 2; ++n) bv[bj][n] = bias ? *(const f32x4*)(bias + bcol0 + bj * HALF + 4 * n) : (f32x4){0.f, 0.f, 0.f, 0.f};
#pragma unroll
        for (int ai = 0; ai < 2; ++ai)
#pragma unroll
            for (int m = 0; m < 4; ++m) { bf16_t* rowp = base + (size_t)(row0 + ai * HALF + m * 16) * ldc + col0;
#pragma unroll
                for (int bj = 0; bj < 2; ++bj) { f32x4 v0 = acc[ai][bj][m][0] + bv[bj][0], v1 = acc[ai][bj][m][1] + bv[bj][1];
                    if (ACT == 1) { f32x2 a = gelu_pk((f32x2){v0[0], v0[1]}), b = gelu_pk((f32x2){v0[2], v0[3]}), c = gelu_pk((f32x2){v1[0], v1[1]}), d = gelu_pk((f32x2){v1[2], v1[3]});
                        v0 = (f32x4){a.x, a.y, b.x, b.y}; v1 = (f32x4){c.x, c.y, d.x, d.y}; }
                    v0 = v0 * sc; v1 = v1 * sc; u32x4 w; w.x = cvt_pk_bf16(v0[0], v0[1]); w.y = cvt_pk_bf16(v0[2], v0[3]); w.z = cvt_pk_bf16(v1[0], v1[1]); w.w = cvt_pk_bf16(v1[2], v1[3]);
                    *(u32x4*)(rowp + bj * HALF) = w; } }
    }
};


constexpr float RMS_EPS = 1e-6f;
constexpr int TOK = 32768;
typedef unsigned u32x2 __attribute__((ext_vector_type(2)));
__device__ __forceinline__ float rstd16(const float* SS, int row) {
    const f32x4* p = (const f32x4*)(SS + (size_t)row * 16);
    const f32x4 a = p[0], b = p[1], c = p[2], d = p[3];
    const float s = (((a[0] + a[1]) + (a[2] + a[3])) + ((b[0] + b[1]) + (b[2] + b[3]))) + (((c[0] + c[1]) + (c[2] + c[3])) + ((d[0] + d[1]) + (d[2] + d[3])));
    return rsqrtf(s * (1.0f / 1024.0f) + RMS_EPS);
}
__device__ __forceinline__ float bf_lo(unsigned w) { return __uint_as_float(w << 16); }
__device__ __forceinline__ float bf_hi(unsigned w) { return __uint_as_float(w & 0xffff0000u); }
struct EpiPlain {
    static constexpr bool PERM = true, AFTER_DRAIN = false;
    size_t ws_off; int ldc;
    __device__ __forceinline__ void operator()(const f32x4 (&acc)[2][2][4][2], const Unit& u, int wr, int wc, int fr_, int fq_) const {
        int lane_ = lane_id(); asm volatile("" : "+v"(lane_)); const int fr = lane_ & 15, fq = lane_ >> 4;
        const KArgs ka = kargs(); bf16_t* O = (bf16_t*)(ka->ws + ws_off);
        const int row0 = u.pm * BM + wr * 64 + fr, col0 = u.pn * BM + wc * 32 + 8 * fq;
#pragma unroll
        for (int ai = 0; ai < 2; ++ai)
#pragma unroll
            for (int m = 0; m < 4; ++m) { bf16_t* rowp = O + (size_t)(row0 + ai * HALF + m * 16) * ldc + col0;
#pragma unroll
                for (int bj = 0; bj < 2; ++bj) { const f32x4 v0 = acc[ai][bj][m][0], v1 = acc[ai][bj][m][1];
                    u32x4 w; w.x = cvt_pk_bf16(v0[0], v0[1]); w.y = cvt_pk_bf16(v0[2], v0[3]); w.z = cvt_pk_bf16(v1[0], v1[1]); w.w = cvt_pk_bf16(v1[2], v1[3]);
                    *(u32x4*)(rowp + bj * HALF) = w; } }
    }
};
struct EpiPP {
    static constexpr bool PERM = true, AFTER_DRAIN = false;
    int pad;
    __device__ __forceinline__ void operator()(const f32x4 (&acc)[2][2][4][2], const Unit& u, int wr, int wc, int fr_, int fq_) const {
        int lane_ = lane_id(); asm volatile("" : "+v"(lane_)); const int fr = lane_ & 15, fq = lane_ >> 4;
        const KArgs ka = kargs(); bf16_t* O = (bf16_t*)ka->out + (size_t)32768 * 1024;
        const int row0 = u.pm * BM + wr * 64 + fr, col0 = u.pn * BM + wc * 32 + 8 * fq;
#pragma unroll
        for (int ai = 0; ai < 2; ++ai)
#pragma unroll
            for (int m = 0; m < 4; ++m) { bf16_t* rowp = O + (size_t)(row0 + ai * HALF + m * 16) * 1024 + col0;
#pragma unroll
                for (int bj = 0; bj < 2; ++bj) { const f32x4 v0 = acc[ai][bj][m][0], v1 = acc[ai][bj][m][1];
                    u32x4 w; w.x = cvt_pk_bf16(v0[0], v0[1]); w.y = cvt_pk_bf16(v0[2], v0[3]); w.z = cvt_pk_bf16(v1[0], v1[1]); w.w = cvt_pk_bf16(v1[2], v1[3]);
                    *(u32x4*)(rowp + bj * HALF) = w; } }
    }
};
struct EpiZ {
    static constexpr bool PERM = true, AFTER_DRAIN = false;
    int ss_sel;
    __device__ __forceinline__ void operator()(const f32x4 (&acc)[2][2][4][2], const Unit& u, int wr, int wc, int fr_, int fq_) const {
        int lane_ = lane_id(); asm volatile("" : "+v"(lane_)); const int fr = lane_ & 15, fq = lane_ >> 4;
        const KArgs ka = kargs(); unsigned char* ws = ka->ws;
        bf16_t* Z = (bf16_t*)(ws + WS_Z); const float* SS = (const float*)(ws + (ss_sel ? WS_SSB : WS_SSA)); float* FL = (float*)(ws + WS_FL);
        const int row0 = u.pm * BM + wr * 64 + fr, col0 = u.pn * BM + wc * 32 + 8 * fq;
        const bool fl = (u.pn == 8) && (wc == 3) && (fq == 0);
#pragma unroll
        for (int ai = 0; ai < 2; ++ai)
#pragma unroll
            for (int m = 0; m < 4; ++m) { const int row = row0 + ai * HALF + m * 16; const float rs = rstd_tbl(u, ai * HALF + wr * 64 + m * 16 + fr); bf16_t* rowp = Z + (size_t)row * 2304 + col0;
#pragma unroll
                for (int bj = 0; bj < 2; ++bj) { const int g32 = (u.pn * BM + bj * HALF + wc * 32) >> 5;
                    const float rq = (g32 >= 11 && g32 < 19) ? rs * 0.18033688011112042f : rs;
                    const f32x4 v0 = acc[ai][bj][m][0] * rq, v1 = acc[ai][bj][m][1] * rq;
                    u32x4 w; w.x = cvt_pk_bf16(v0[0], v0[1]); w.y = cvt_pk_bf16(v0[2], v0[3]); w.z = cvt_pk_bf16(v1[0], v1[1]); w.w = cvt_pk_bf16(v1[2], v1[3]);
                    *(u32x4*)(rowp + bj * HALF) = w; }
                if (fl) *(f32x4*)(FL + (size_t)row * 4) = acc[ai][0][m][0] * rs; asm volatile("" ::: "memory"); }
    }
};
__device__ __forceinline__ float quad16_sum(float x) {
    auto s = __builtin_amdgcn_permlane16_swap(__float_as_uint(x), __float_as_uint(x), false, false); x = __uint_as_float(s[0]) + __uint_as_float(s[1]);
    auto t = __builtin_amdgcn_permlane32_swap(__float_as_uint(x), __float_as_uint(x), false, false); return __uint_as_float(t[0]) + __uint_as_float(t[1]);
}
template <int MODE> struct EpiRes {
    static constexpr bool PERM = true, AFTER_DRAIN = false;
    int r_src;
    int o_dst;
    int sso_sel;
    __device__ __forceinline__ void operator()(const f32x4 (&acc)[2][2][4][2], const Unit& u, int wr, int wc, int fr_, int fq_) const {
        int lane_ = lane_id(); asm volatile("" : "+v"(lane_)); const int fr = lane_ & 15, fq = lane_ >> 4;
        const KArgs ka = kargs(); unsigned char* ws = ka->ws;
        const bf16_t* R = r_src ? (const bf16_t*)ka->out : (const bf16_t*)(ws + WS_HB);
        bf16_t* HBo = o_dst == 0 ? (bf16_t*)(ws + WS_HB) : (o_dst == 1 ? (bf16_t*)ka->out : (bf16_t*)(ws + WS_O)); float* SSo = (float*)(ws + (sso_sel ? WS_SSB : WS_SSA));
        const float* SSi = (const float*)(ws + (sso_sel ? WS_SSA : WS_SSB)); const bf16_t* PP = (const bf16_t*)ka->out + (size_t)32768 * 1024;
        const int row0 = u.pm * BM + wr * 64 + fr, col0 = u.pn * BM + wc * 32 + 8 * fq;
#pragma unroll
        for (int ai = 0; ai < 2; ++ai) {
            u32x4 rwv[4][2], pwv[4][2];
#pragma unroll
            for (int m = 0; m < 4; ++m)
#pragma unroll
                for (int bj = 0; bj < 2; ++bj) { const size_t off = (size_t)(row0 + ai * HALF + m * 16) * 1024 + col0 + bj * HALF; rwv[m][bj] = *(const u32x4*)(R + off); if (MODE == 1) pwv[m][bj] = *(const u32x4*)(PP + off); }
            asm volatile("" ::: "memory");
#pragma unroll
            for (int m = 0; m < 4; ++m) { const int row = row0 + ai * HALF + m * 16; const size_t off = (size_t)row * 1024 + col0; float q = 0.f;
                float rs = 1.f; if (MODE == 1) rs = rstd_tbl(u, ai * HALF + wr * 64 + m * 16 + fr);
#pragma unroll
                for (int bj = 0; bj < 2; ++bj) { const u32x4 rw = rwv[m][bj]; f32x4 o0 = {bf_lo(rw.x), bf_hi(rw.x), bf_lo(rw.y), bf_hi(rw.y)}, o1 = {bf_lo(rw.z), bf_hi(rw.z), bf_lo(rw.w), bf_hi(rw.w)};
                    if (MODE == 0) { o0 = o0 + acc[ai][bj][m][0]; o1 = o1 + acc[ai][bj][m][1]; }
                    else { const f32x4 g0 = acc[ai][bj][m][0] * rs, g1 = acc[ai][bj][m][1] * rs; const u32x4 pw = pwv[m][bj];
                        o0[0] += bf_lo(pw.x) * __builtin_amdgcn_rcpf(1.f + __expf(-g0[0])); o0[1] += bf_hi(pw.x) * __builtin_amdgcn_rcpf(1.f + __expf(-g0[1])); o0[2] += bf_lo(pw.y) * __builtin_amdgcn_rcpf(1.f + __expf(-g0[2])); o0[3] += bf_hi(pw.y) * __builtin_amdgcn_rcpf(1.f + __expf(-g0[3]));
                        o1[0] += bf_lo(pw.z) * __builtin_amdgcn_rcpf(1.f + __expf(-g1[0])); o1[1] += bf_hi(pw.z) * __builtin_amdgcn_rcpf(1.f + __expf(-g1[1])); o1[2] += bf_lo(pw.w) * __builtin_amdgcn_rcpf(1.f + __expf(-g1[2])); o1[3] += bf_hi(pw.w) * __builtin_amdgcn_rcpf(1.f + __expf(-g1[3])); }
                    u32x4 w; w.x = cvt_pk_bf16(o0[0], o0[1]); w.y = cvt_pk_bf16(o0[2], o0[3]); w.z = cvt_pk_bf16(o1[0], o1[1]); w.w = cvt_pk_bf16(o1[2], o1[3]);
                    *(u32x4*)(HBo + off + bj * HALF) = w;
                    const float a0 = bf_lo(w.x), a1 = bf_hi(w.x), a2 = bf_lo(w.y), a3 = bf_hi(w.y), a4 = bf_lo(w.z), a5 = bf_hi(w.z), a6 = bf_lo(w.w), a7 = bf_hi(w.w);
                    q += ((a0 * a0 + a1 * a1) + (a2 * a2 + a3 * a3)) + ((a4 * a4 + a5 * a5) + (a6 * a6 + a7 * a7)); }
                q = quad16_sum(q);
                if (fq == 0) SSo[(size_t)row * 16 + u.pn * 4 + wc] = q; }
            asm volatile("" ::: "memory"); }
    }
};
template <int CTRL> __device__ __forceinline__ float dppf(float x) { return __builtin_bit_cast(float, __builtin_amdgcn_update_dpp(0, __builtin_bit_cast(int, x), CTRL, 0xf, 0xf, false)); }
struct EpiUp {
    static constexpr bool PERM = true, AFTER_DRAIN = false;
    int layer, ss_sel;
#define EPIUP_FMAC_DPP(y, x, w, CTRL) asm volatile("v_fmac_f32_dpp %0, %1, %2 " CTRL " row_mask:0xf bank_mask:0xf" : "+v"(y) : "v"(x), "v"(w))
    template <bool SEQ> __device__ __forceinline__ void conv(f32x4 (&x)[4][2], int n, int tb  , unsigned cwt  , bool silu) const {
        const f32x4 w0 = *(const PG8_LAS f32x4*)(uintptr_t)cwt, w1 = *(const PG8_LAS f32x4*)(uintptr_t)(cwt + 16), w2 = *(const PG8_LAS f32x4*)(uintptr_t)(cwt + 32), b = *(const PG8_LAS f32x4*)(uintptr_t)(cwt + 48);
        float k1[4] = {1.f, 1.f, 1.f, 1.f}, k2[4] = {1.f, 1.f, 1.f, 1.f};
        if (SEQ) {
#pragma unroll
            for (int m = 0; m < 4; ++m) { const int tpos = (tb + m) & 4095; k1[m] = tpos < 1 ? 0.f : 1.f; k2[m] = tpos < 2 ? 0.f : 1.f; } }
#pragma unroll
        for (int e = 0; e < 4; ++e) {
            const float x0 = x[0][n][e], x1 = x[1][n][e], x2 = x[2][n][e], x3 = x[3][n][e];
            float yv[4];
            { float y = b[e] + w2[e] * x0; const float a1 = SEQ ? w1[e] * k1[0] : w1[e], a0 = SEQ ? w0[e] * k2[0] : w0[e];
              EPIUP_FMAC_DPP(y, x3, a1, "row_shr:1"); EPIUP_FMAC_DPP(y, x2, a0, "row_shr:1"); yv[0] = y; }
            { float y = b[e] + w2[e] * x1; y += (SEQ ? w1[e] * k1[1] : w1[e]) * x0; const float a0 = SEQ ? w0[e] * k2[1] : w0[e];
              EPIUP_FMAC_DPP(y, x3, a0, "row_shr:1"); yv[1] = y; }
            yv[2] = b[e] + w2[e] * x2 + (SEQ ? w1[e] * k1[2] : w1[e]) * x1 + (SEQ ? w0[e] * k2[2] : w0[e]) * x0;
            yv[3] = b[e] + w2[e] * x3 + (SEQ ? w1[e] * k1[3] : w1[e]) * x2 + (SEQ ? w0[e] * k2[3] : w0[e]) * x1;
            if (silu) {
                float t[4];
#pragma unroll
                for (int m = 0; m < 4; ++m) t[m] = __builtin_amdgcn_exp2f(yv[m]);
#pragma unroll
                for (int m = 0; m < 4; ++m) t[m] = 1.f + t[m];
#pragma unroll
                for (int m = 0; m < 4; ++m) t[m] = __builtin_amdgcn_rcpf(t[m]);
#pragma unroll
                for (int m = 0; m < 4; ++m) yv[m] *= t[m]; }
#pragma unroll
            for (int m = 0; m < 4; ++m) x[m][n][e] = yv[m]; }
    }
    __device__ __forceinline__ void operator()(f32x4 (&acc)[2][2][4][2], const Unit& u, int wr, int wc, int fr_, int fq_) const {
        int lane_ = lane_id(); asm volatile("" : "+v"(lane_));
        const int fr = lane_ & 15, fq = lane_ >> 4;
        const KArgs ka = kargs(); unsigned char* ws = ka->ws;
        char* ACT = (char*)(ws + WS_ACT);
        const unsigned j0 = 128 * u.pn + 32 * wc + 8 * fq;
        const unsigned cw0 = CWT_TBL_OFF + u.par * 4096 + (8 * wc + 2 * fq) * 128;
#pragma unroll
        for (int ai = 0; ai < 2; ++ai) {
            asm volatile("" ::: "memory");
            const int tb0 = 248 * u.pm + 62 * (2 * ai + wr) - 2;
            const int tb = tb0 + 4 * fr;
#pragma unroll
            for (int m = 0; m < 4; ++m) { const float rs = rstd_tbl(u, ai * HALF + wr * 64 + m * 16 + fr);
#pragma unroll
                for (int bj = 0; bj < 2; ++bj)
#pragma unroll
                    for (int n = 0; n < 2; ++n) acc[ai][bj][m][n] = acc[ai][bj][m][n] * rs; }
            const bool seq = ((tb0 + 63) & 4095) < 65;
#pragma unroll
            for (int n = 0; n < 2; ++n) {
                __builtin_amdgcn_sched_barrier(0);
                if (seq) { conv<true>(acc[ai][0], n, tb, cw0 + n * 128, true); conv<true>(acc[ai][1], n, tb, cw0 + n * 128 + 64, false); }
                else { conv<false>(acc[ai][0], n, tb, cw0 + n * 128, true); __builtin_amdgcn_sched_barrier(0); conv<false>(acc[ai][1], n, tb, cw0 + n * 128 + 64, false); }
            }
#pragma unroll
            for (int m = 0; m < 4; ++m) { const int tok = tb + m; const f32x4 a0 = acc[ai][0][m][0] * acc[ai][1][m][0], a1 = acc[ai][0][m][1] * acc[ai][1][m][1];
                u32x4 w; w.x = cvt_pk_bf16(a0[0], a0[1]); w.y = cvt_pk_bf16(a0[2], a0[3]); w.z = cvt_pk_bf16(a1[0], a1[1]); w.w = cvt_pk_bf16(a1[2], a1[3]);
                if (4 * fr + m >= 2 && tok < TOK) *(u32x4*)(ACT + ((unsigned)tok * 5632u + j0 * 2u)) = w; }
            asm volatile("" ::: "memory");
        }
    }
#undef EPIUP_FMAC_DPP
};

template <class Epi, class Sched, bool ALIGN_EPI = false, bool SP2 = false, bool ROW62 = false, int KC = 0>
__device__ __forceinline__ void gemm_phase(PG8_LAS unsigned char* lds, const Gemm g, const Sched& S, const Epi& E, int wave_id) {
    int lane_ = lane_id(); asm volatile("" : "+v"(lane_));
    const int wid = wave_id, lane = lane_, tid = wid * 64 + lane, wr = wid >> 2, wc = wid & 3, fr = lane & 15, fq = lane >> 4;
    const int K = KC ? KC : g.K, nt = K / BK;
    unsigned voffA, voffB;
    { int R, C; stage_rc(tid * 16, R, C); const int Rb = Epi::PERM ? ((R & ~31) + perm32(R & 31)) : R; const int Ra = ROW62 ? 4 * (R & 15) + (R >> 4) : R;
      voffA = (unsigned)(Ra * K + C) * 2u; voffB = (unsigned)(Rb * K + C) * 2u; }
    const size_t dltA = (size_t)(ROW62 ? 62 : 64) * K * 2, dltB = (size_t)64 * K * 2;
    const size_t kstep = (size_t)(BK * 2);
    const size_t hstepB = (size_t)HALF * K * 2; const size_t hstepA = ROW62 ? (size_t)124 * K * 2 : hstepB;
    const size_t tstepB = 2 * hstepB, tstepA = 2 * hstepA;
    const unsigned ldsw = (unsigned)wid * 1024u;
    const int aoff = lds_byte(wr * 64 + fr, fq * 8), boff = lds_byte(wc * 32 + fr, fq * 8);
#define PG8_SA(b, h) (((b) * 2 + (h)) * HTB)
#define PG8_SB(b, h) ((4 + (b) * 2 + (h)) * HTB)
#define PG8_STAGE(bufoff, gbase, voff) do { _Pragma("unroll") for (int _i = 0; _i < 2; ++_i) \
        __builtin_amdgcn_global_load_lds((const unsigned*)((const char*)(gbase) + _i * dlt_##voff + voff), (PG8_LAS unsigned*)(lds + (bufoff) + ldsw + _i * 8192), 16, 0, 0); } while (0)
#define dlt_voffA dltA
#define dlt_voffB dltB
#define PG8_LDA(dst, b, h) do { _Pragma("unroll") for (int m = 0; m < 4; ++m) _Pragma("unroll") for (int k = 0; k < 2; ++k) dst[m][k] = *(const PG8_LAS bf16x8*)(lds + PG8_SA(b, h) + aoff + m * 2048 + k * 1024); } while (0)
#define PG8_LDB(dst, b, h) do { _Pragma("unroll") for (int n = 0; n < 2; ++n) _Pragma("unroll") for (int k = 0; k < 2; ++k) dst[n][k] = *(const PG8_LAS bf16x8*)(lds + PG8_SB(b, h) + boff + n * 2048 + k * 1024); } while (0)
#define PG8_MMA(ai, bj, At, Bt) do { __builtin_amdgcn_s_setprio(1); _Pragma("unroll") for (int m = 0; m < 4; ++m) _Pragma("unroll") for (int n = 0; n < 2; ++n) _Pragma("unroll") for (int k = 0; k < 2; ++k) \
        acc[ai][bj][m][n] = __builtin_amdgcn_mfma_f32_16x16x32_bf16(Bt[n][k], At[m][k], acc[ai][bj][m][n], 0, 0, 0); __builtin_amdgcn_s_setprio(0); } while (0)
#define PG8_WAIT_V(n) asm volatile("s_waitcnt vmcnt(" #n ")" ::: "memory")
#define PG8_WAIT_L(n) asm volatile("s_waitcnt lgkmcnt(" #n ")" ::: "memory")
#define PG8_BAR __builtin_amdgcn_s_barrier()
#define PG8_SCHED __builtin_amdgcn_sched_barrier(0)
    Unit cur, nxt; int ui = 0;
    if (!S.next(0, cur)) return;
    f32x4 acc[2][2][4][2];
#pragma unroll
    for (int a = 0; a < 2; ++a)
#pragma unroll
        for (int b = 0; b < 2; ++b)
#pragma unroll
            for (int m = 0; m < 4; ++m)
#pragma unroll
                for (int n = 0; n < 2; ++n) acc[a][b][m][n] = (f32x4){0.f, 0.f, 0.f, 0.f};
    bf16x8 At[4][2], B0[2][2], B1[2][2];
    const char* cA = (const char*)g.A + (size_t)cur.pm * tstepA; const char* cB = (const char*)g.Bt + (size_t)cur.pn * tstepB;
    S.a_ready(cur);
    if constexpr (SP2) {
        PG8_STAGE(PG8_SB(0, 0), cB, voffB); PG8_STAGE(PG8_SB(0, 1), cB + hstepB, voffB); PG8_STAGE(PG8_SA(0, 0), cA, voffA); PG8_STAGE(PG8_SA(0, 1), cA + hstepA, voffA);
        if (wr == 1) PG8_BAR;
        PG8_WAIT_V(2); PG8_BAR;
        PG8_STAGE(PG8_SB(1, 0), cB + kstep, voffB); PG8_STAGE(PG8_SA(1, 0), cA + kstep, voffA); PG8_STAGE(PG8_SB(1, 1), cB + hstepB + kstep, voffB);
        PG8_WAIT_V(6); PG8_BAR;
    } else {
        PG8_STAGE(PG8_SB(0, 0), cB, voffB); PG8_STAGE(PG8_SA(0, 0), cA, voffA); PG8_STAGE(PG8_SB(0, 1), cB + hstepB, voffB); PG8_STAGE(PG8_SA(0, 1), cA + hstepA, voffA);
        if (wr == 1) PG8_BAR;
        PG8_WAIT_V(4); PG8_BAR;
        PG8_STAGE(PG8_SB(1, 0), cB + kstep, voffB); PG8_STAGE(PG8_SA(1, 0), cA + kstep, voffA); PG8_STAGE(PG8_SB(1, 1), cB + hstepB + kstep, voffB);
        PG8_WAIT_V(6); PG8_BAR;
    }
    for (;;) {
        const bool has_next = S.next(ui + 1, nxt);
        const char* nA = has_next ? (const char*)g.A + (size_t)nxt.pm * tstepA : cA; const char* nB = has_next ? (const char*)g.Bt + (size_t)nxt.pn * tstepB : cB;
#pragma nounroll
        for (int t = 0; t < nt; t += 2) {
            const bool last = (t == nt - 2);
            const char* a1 = cA + (size_t)(t + 1) * kstep;
            const char* a2 = last ? nA : cA + (size_t)(t + 2) * kstep; const char* b2 = last ? nB : cB + (size_t)(t + 2) * kstep;
            const char* a3 = a2 + kstep; const char* b3 = b2 + kstep;
            if (last && has_next) S.a_ready(nxt);
            if constexpr (SP2) {
            PG8_LDB(B0, 0, 0); PG8_LDB(B1, 0, 1); PG8_SCHED; PG8_LDA(At, 0, 0); PG8_STAGE(PG8_SA(1, 1), a1 + hstepA, voffA);
            PG8_WAIT_V(8); PG8_WAIT_L(0); PG8_BAR; PG8_MMA(0, 0, At, B0); PG8_MMA(0, 1, At, B1); PG8_BAR; PG8_SCHED;
            PG8_LDA(At, 0, 1); PG8_STAGE(PG8_SB(0, 0), b2, voffB); PG8_STAGE(PG8_SB(0, 1), b2 + hstepB, voffB); PG8_STAGE(PG8_SA(0, 0), a2, voffA);
            PG8_WAIT_V(8); PG8_WAIT_L(0); PG8_BAR; PG8_MMA(1, 0, At, B0); PG8_MMA(1, 1, At, B1); PG8_BAR; PG8_SCHED;
            PG8_LDB(B0, 1, 0); PG8_LDB(B1, 1, 1); PG8_SCHED; PG8_LDA(At, 1, 0); PG8_STAGE(PG8_SA(0, 1), a2 + hstepA, voffA);
            PG8_WAIT_V(8); PG8_WAIT_L(0); PG8_BAR; PG8_MMA(0, 0, At, B0); PG8_MMA(0, 1, At, B1); PG8_BAR; PG8_SCHED;
            PG8_LDA(At, 1, 1); PG8_STAGE(PG8_SB(1, 0), b3, voffB); PG8_STAGE(PG8_SB(1, 1), b3 + hstepB, voffB); PG8_STAGE(PG8_SA(1, 0), a3, voffA);
            PG8_WAIT_V(8); PG8_WAIT_L(0); PG8_BAR; PG8_MMA(1, 0, At, B0); PG8_MMA(1, 1, At, B1); PG8_BAR; PG8_SCHED;
            } else {
            PG8_LDB(B0, 0, 0); PG8_SCHED; PG8_LDA(At, 0, 0); PG8_STAGE(PG8_SA(1, 1), a1 + hstepA, voffA);
            PG8_WAIT_L(8); PG8_BAR; PG8_WAIT_L(0); PG8_MMA(0, 0, At, B0); PG8_BAR; PG8_SCHED;
            PG8_LDB(B1, 0, 1); PG8_STAGE(PG8_SB(0, 0), b2, voffB);
            PG8_BAR; PG8_WAIT_L(0); PG8_MMA(0, 1, At, B1); PG8_BAR;
            PG8_LDA(At, 0, 1); PG8_STAGE(PG8_SA(0, 0), a2, voffA);
            PG8_BAR; PG8_WAIT_L(0); PG8_MMA(1, 0, At, B0); PG8_BAR; PG8_SCHED;
            PG8_STAGE(PG8_SB(0, 1), b2 + hstepB, voffB);
            PG8_WAIT_V(6); PG8_BAR; PG8_MMA(1, 1, At, B1); PG8_BAR;
            PG8_LDB(B0, 1, 0); PG8_SCHED; PG8_LDA(At, 1, 0); PG8_STAGE(PG8_SA(0, 1), a2 + hstepA, voffA);
            PG8_WAIT_L(8); PG8_BAR; PG8_WAIT_L(0); PG8_MMA(0, 0, At, B0); PG8_BAR; PG8_SCHED;
            PG8_LDB(B1, 1, 1); PG8_STAGE(PG8_SB(1, 0), b3, voffB);
            PG8_BAR; PG8_WAIT_L(0); PG8_MMA(0, 1, At, B1); PG8_BAR;
            PG8_LDA(At, 1, 1); PG8_STAGE(PG8_SA(1, 0), a3, voffA);
            PG8_BAR; PG8_WAIT_L(0); PG8_MMA(1, 0, At, B0); PG8_BAR; PG8_SCHED;
            PG8_STAGE(PG8_SB(1, 1), b3 + hstepB, voffB);
            PG8_WAIT_V(6); PG8_BAR; PG8_MMA(1, 1, At, B1); PG8_BAR;
            }
        }
        if constexpr (ALIGN_EPI) { if (wr == 0) PG8_BAR; }
        if constexpr (!Epi::AFTER_DRAIN) { E(acc, cur, wr, wc, fr, fq); S.done(cur); }
        if (!has_next) break;
#pragma unroll
        for (int a = 0; a < 2; ++a)
#pragma unroll
            for (int b = 0; b < 2; ++b)
#pragma unroll
                for (int m = 0; m < 4; ++m)
#pragma unroll
                    for (int n = 0; n < 2; ++n) acc[a][b][m][n] = (f32x4){0.f, 0.f, 0.f, 0.f};
        cur = nxt; cA = nA; cB = nB; ++ui;
        if constexpr (ALIGN_EPI) { if (wr == 1) PG8_BAR; }
    }
    PG8_WAIT_V(0);
    if constexpr (!ALIGN_EPI) { if (wr == 0) PG8_BAR; }
    PG8_BAR;
    if constexpr (Epi::AFTER_DRAIN) { E.fused(acc, cur, wr, wc, fr, fq, lds, wid, lane); S.done(cur); }
#undef PG8_SA
#undef PG8_SB
#undef PG8_STAGE
#undef dlt_voffA
#undef dlt_voffB
#undef PG8_LDA
#undef PG8_LDB
#undef PG8_MMA
#undef PG8_WAIT_V
#undef PG8_WAIT_L
#undef PG8_BAR
#undef PG8_SCHED
}
}
#define GAS __attribute__((address_space(1)))
#define LAS __attribute__((address_space(3)))
typedef unsigned short bf16;
typedef unsigned v4u __attribute__((ext_vector_type(4)));
typedef float f32x4 __attribute__((ext_vector_type(4)));
typedef short bf16x8 __attribute__((ext_vector_type(8)));
typedef GAS unsigned gu32;
typedef GAS unsigned long long gu64;
#define RLX_AGENT __ATOMIC_RELAXED, __HIP_MEMORY_SCOPE_AGENT
#define LDS_WAIT() asm volatile("s_waitcnt lgkmcnt(0)" ::: "memory")
#define VM_WAIT() asm volatile("s_waitcnt vmcnt(0)" ::: "memory")
__device__ __forceinline__ unsigned long long rt() { return __builtin_amdgcn_s_memrealtime(); }
__device__ __forceinline__ unsigned f2bf(float f) { unsigned u = __builtin_bit_cast(unsigned, f); return (u + 0x7fffu + ((u >> 16) & 1u)) >> 16; }
__device__ __forceinline__ unsigned pk2(float lo, float hi) { return f2bf(lo) | (f2bf(hi) << 16); }

#define XB_TMO      128
#define XB_XCNT(j)  (256  + 64 * (j))
#define XB_XSUB(j)  (1280 + 64 * (j))
#define XB_XGEN(j)  (2304 + 64 * (j))
#define XB_TOP      3328
#define XB_TOPGEN   3392
#define XCD_BAR_WORDS 3456
#define XB_SPIN_CAP (1u << 18)

__device__ __forceinline__ unsigned xb_ld(unsigned* p)              { return __hip_atomic_load(p, __ATOMIC_RELAXED, __HIP_MEMORY_SCOPE_AGENT); }
__device__ __forceinline__ unsigned xb_add(unsigned* p, unsigned v) { return __hip_atomic_fetch_add(p, v, __ATOMIC_RELAXED, __HIP_MEMORY_SCOPE_AGENT); }
__device__ __forceinline__ unsigned xb_xcc_id() { return (unsigned)__builtin_amdgcn_s_getreg((3 << 11) | 20) & 0xFu; }
#define XB_SPIN(cond, bar) do { unsigned _sp = 0; while (cond) { __builtin_amdgcn_s_sleep(1); \
    if ((++_sp & 255u) == 0u) { if (xb_ld(&(bar)[XB_TMO])) break; if (_sp > XB_SPIN_CAP) { atomicAdd(&(bar)[XB_TMO], 1u); break; } } } } while (0)

struct XcdBarrier {
    unsigned* bar; unsigned x;
    volatile LAS unsigned* st;
};

__device__ __forceinline__ XcdBarrier xcd_barrier_post(unsigned* bar, volatile LAS unsigned* st) {
    XcdBarrier b; b.bar = bar; b.x = xb_xcc_id(); b.st = st;
    if (threadIdx.x == 0) (void)xb_add(&bar[XB_XCNT(b.x)], 1u);
    return b;
}
__device__ __forceinline__ void xcd_barrier_complete(unsigned* bar, unsigned x, unsigned& nloc, unsigned& nx) {
    const unsigned G = gridDim.x * gridDim.y * gridDim.z;
    unsigned sum, cnt, mine, sp = 0u;
    for (;;) {
        sum = 0u; cnt = 0u; mine = 0u;
#pragma unroll
        for (unsigned j = 0; j < 16; ++j) { const unsigned c = xb_ld(&bar[XB_XCNT(j)]); sum += c; cnt += (c > 0u) ? 1u : 0u; mine = (j == x) ? c : mine; }
        if (sum == G) break;
        __builtin_amdgcn_s_sleep(1);
        if ((++sp & 255u) == 0u) { if (xb_ld(&bar[XB_TMO])) break; if (sp > XB_SPIN_CAP) { atomicAdd(&bar[XB_TMO], 1u); break; } }
    }
    nloc = mine > 0u ? mine : 1u; nx = cnt > 0u ? cnt : 1u;
}

__device__ __forceinline__ void xcd_barrier(const XcdBarrier& b) {
    asm volatile("s_waitcnt vmcnt(0)" ::: "memory");
    __syncthreads();
    if (threadIdx.x == 0) {
        unsigned* bar = b.bar;
        __builtin_amdgcn_s_waitcnt(0);
        unsigned nloc = b.st[0], nx = b.st[1];
        if (nloc == 0u) { xcd_barrier_complete(bar, b.x, nloc, nx); b.st[0] = nloc; b.st[1] = nx; }
        const unsigned old = xb_add(&bar[XB_XSUB(b.x)], 1u);
        const unsigned gen = old / nloc;
        if (old + 1u == (gen + 1u) * nloc) {
            __builtin_amdgcn_fence(__ATOMIC_RELEASE, "agent");
            asm volatile("s_waitcnt vmcnt(0)" ::: "memory");
            const unsigned og = xb_add(&bar[XB_TOP], 1u);
            const unsigned tg = og / nx;
            if (og + 1u == (tg + 1u) * nx) xb_add(&bar[XB_TOPGEN], 1u);
            else XB_SPIN(xb_ld(&bar[XB_TOPGEN]) == tg, bar);
            __builtin_amdgcn_fence(__ATOMIC_ACQUIRE, "agent");
            xb_add(&bar[XB_XGEN(b.x)], 1u);
            asm volatile("s_waitcnt vmcnt(0)" ::: "memory");
        } else {
            XB_SPIN(xb_ld(&bar[XB_XGEN(b.x)]) == gen, bar);
            __builtin_amdgcn_fence(__ATOMIC_ACQUIRE, "agent");
            asm volatile("s_waitcnt vmcnt(0)" ::: "memory");
        }
    }
    __syncthreads();
}
namespace att {
using bf16x8 = __attribute__((ext_vector_type(8))) short;
using s16x4 = __attribute__((ext_vector_type(4))) short;
using f32x16 = __attribute__((ext_vector_type(16))) float;
using u32x4 = __attribute__((ext_vector_type(4))) unsigned;
typedef short v4i16_t __attribute__((ext_vector_type(4)));
typedef __attribute__((address_space(3))) char* lptr;
typedef __attribute__((address_space(3))) const char* lcptr;
constexpr int KSLOT = 12288, VSLOT = 8192, BSLOT = 1024;
constexpr int NSLOT = 4;
constexpr int LDS_K = 0, LDS_V = NSLOT * KSLOT, LDS_B = LDS_V + NSLOT * VSLOT, LDS_WS = LDS_B + NSLOT * BSLOT, LDS_OST = LDS_WS + 8 * 512, LDS_BYTES = LDS_OST + 8 * 4096;
__device__ __forceinline__ int crow(int r, int hi) { return (r & 3) + 8 * (r >> 2) + 4 * hi; }
__device__ __forceinline__ void glds16(const void* g, unsigned lds_base) {
    unsigned sv; asm volatile("s_mov_b32 %0, m0\n\ts_mov_b32 m0, %2\n\ts_nop 0\n\tglobal_load_lds_dwordx4 %1, off\n\ts_mov_b32 m0, %0" : "=&s"(sv) : "v"(g), "s"(lds_base) : "memory"); }
typedef __bf16 bf2_t __attribute__((ext_vector_type(2)));
typedef float fl2_t __attribute__((ext_vector_type(2)));
__device__ __forceinline__ unsigned cvtpk(float lo, float hi) { const fl2_t v = {lo, hi}; return __builtin_bit_cast(unsigned, __builtin_convertvector(v, bf2_t)); }
__device__ __forceinline__ s16x4 vtr(lcptr p) { return __builtin_bit_cast(s16x4, __builtin_amdgcn_ds_read_tr16_b64_v4i16((__attribute__((address_space(3))) v4i16_t*)p)); }
#define ATT_MX3(a, b, c) __builtin_fmaxf(__builtin_fmaxf((a), (b)), (c))
__device__ __forceinline__ float rowmax(const f32x16& p0, const f32x16& p1) {
    float a = ATT_MX3(p0[0], p0[1], p1[0]), b = ATT_MX3(p0[2], p0[3], p1[1]); a = ATT_MX3(a, p1[2], p1[3]);
#pragma unroll
    for (int r = 4; r < 16; r += 4) { a = ATT_MX3(a, p0[r], p0[r + 1]); b = ATT_MX3(b, p0[r + 2], p0[r + 3]); a = ATT_MX3(a, p1[r], p1[r + 1]); b = ATT_MX3(b, p1[r + 2], p1[r + 3]); }
    float m = __builtin_fmaxf(a, b); auto rr = __builtin_amdgcn_permlane32_swap(__float_as_uint(m), __float_as_uint(m), false, false);
    return __builtin_fmaxf(__uint_as_float(rr[0]), __uint_as_float(rr[1])); }
__device__ __forceinline__ void cmask(f32x16& p0, f32x16& p1, int jb, int qrel, int hi) {
    const int kb = 64 * jb + 4 * hi;
#pragma unroll
    for (int r = 0; r < 16; ++r) { const int kv = kb + (r & 3) + 8 * (r >> 2); if (kv > qrel) p0[r] = -INFINITY; if (kv + 32 > qrel) p1[r] = -INFINITY; } }
#define ATT_WAIT_BAR(N) asm volatile("s_waitcnt vmcnt(" #N ") lgkmcnt(0)\n\ts_barrier" ::: "memory")
#define ATT_MFMA(a, b, c) __builtin_amdgcn_mfma_f32_32x32x16_bf16(a, b, c, 0, 0, 0)

template <int ND, bool BIAS>
__device__ __forceinline__ void attn_unit(const unsigned short* Qh, int pq, const unsigned short* Kh, int pk, const unsigned short* Vh, int pv, unsigned short* Oh, int po,
                                          const float* cbx, int hb, int qb, lptr lds, int wid) {
    const int lane = lane_id(), r32 = lane & 31, hi = lane >> 5;
    const int q0 = qb * 512, NT = 8 * qb + 8;
    constexpr int KSL = ND * 2048;
    const unsigned lds0 = (unsigned)(uintptr_t)lds;
    bf16x8 qa[ND], qc[ND];
    const int ra0 = 32 * wid, rb0 = 480 - 32 * wid;
    const int da_ = wid >> 1, db_ = 7 - (wid >> 1);
    const int oa_ = 32 * (wid & 1), ob_ = (wid & 1) ? 0 : 32;
    { const unsigned short* Qwa = Qh + (size_t)(q0 + ra0 + r32) * pq + hi * 8; const unsigned short* Qwb = Qh + (size_t)(q0 + rb0 + r32) * pq + hi * 8;
#pragma unroll
      for (int d0 = 0; d0 < ND; ++d0) { qa[d0] = *reinterpret_cast<const bf16x8*>(Qwa + d0 * 16); qc[d0] = *reinterpret_cast<const bf16x8*>(Qwb + d0 * 16); }
 }
    const unsigned short* ksrc0 = Kh + (size_t)lane * pk + wid * 8;
    const unsigned short* ksrc1 = Kh + (size_t)lane * pk + (8 + (wid & 3)) * 8;
    const unsigned short* vsrc = Vh + (size_t)(16 * (wid & 3) + (lane >> 2)) * pv + (wid >> 2) * 32 + (lane & 3) * 8;
    const float* bsrc = cbx + lane * 4;
    const unsigned kdst0 = lds0 + LDS_K + wid * 1024, kdst1 = lds0 + LDS_K + (8 + (wid & 3)) * 1024, vdst = lds0 + LDS_V + wid * 1024, bdst = lds0 + LDS_B;
#define ATT_DMA(t, s) do { glds16(ksrc0 + (size_t)(t) * 64 * pk, (unsigned)__builtin_amdgcn_readfirstlane(kdst0 + (s) * KSL)); \
        if (ND == 6) glds16(ksrc1 + (size_t)(t) * 64 * pk, (unsigned)__builtin_amdgcn_readfirstlane(kdst1 + (s) * KSL)); \
        glds16(vsrc + (size_t)(t) * 64 * pv, (unsigned)__builtin_amdgcn_readfirstlane(vdst + (s) * VSLOT)); \
        if (BIAS) glds16(bsrc + (size_t)(t) * 256, (unsigned)__builtin_amdgcn_readfirstlane(bdst + (s) * BSLOT)); } while (0)
    const lcptr kp0 = (lcptr)lds + LDS_K + hi * 1024 + r32 * 16;
    const lcptr vp0 = (lcptr)lds + LDS_V + ((lane >> 4) & 1) * 32 + (lane & 3) * 8 + (4 * hi + ((lane & 15) >> 2)) * 64;
    const lcptr bp0 = (lcptr)lds + LDS_B + hb * 256 + hi * 128;
    __attribute__((address_space(3))) float* wsf = (__attribute__((address_space(3))) float*)(lds + LDS_WS) + wid * 128;
    ATT_DMA(NT - 1, 0); ATT_DMA(NT - 2, 1); ATT_DMA(NT - 3, 2);
#pragma unroll
    for (int d0 = 0; d0 < ND; ++d0) { asm volatile("" : "+v"(qa[d0])); asm volatile("" : "+v"(qc[d0])); }
    float ma = -INFINITY, la = 0.f, mb = -INFINITY, lb = 0.f; f32x16 oa[2], ob[2];
    { float z0; asm volatile("v_mov_b32 %0, 0" : "=v"(z0));
#pragma unroll
      for (int r = 0; r < 16; ++r) { oa[0][r] = z0; oa[1][r] = z0; ob[0][r] = z0; ob[1][r] = z0; } }
    f32x16 pa, pb, pa2, pb2;
#define ATT_SKIP(t) ((t) < 8 && (7 - (t)) > db_)
#define ATT_AACT(t) ((t) >= 8 || (7 - (t)) <= da_)
#define ATT_CINIT(PA_, PB_, t, H) do { if (BIAS) { const lcptr bp = bp0 + ((t) & 3) * BSLOT + (H) * 64; \
            _Pragma("unroll") for (int g = 0; g < 4; ++g) { const f32x4 x_ = *(const __attribute__((address_space(3))) f32x4*)(bp + g * 16); \
                _Pragma("unroll") for (int e = 0; e < 4; ++e) { PA_[4 * g + e] = x_[e]; PB_[4 * g + e] = x_[e]; } } } \
        else { PA_ = f32x16{}; PB_ = f32x16{}; } } while (0)
#define ATT_QK(t, H) do { const lcptr kb_ = kp0 + ((t) & 3) * KSL + (H) * 512; ATT_CINIT(pa, pb, t, H); bf16x8 kf_[ND]; \
        _Pragma("unroll") for (int d0 = 0; d0 < ND; ++d0) kf_[d0] = *(const __attribute__((address_space(3))) bf16x8*)(kb_ + d0 * 2048); \
        __builtin_amdgcn_s_setprio(1); _Pragma("unroll") for (int d0 = 0; d0 < ND; ++d0) { pa = ATT_MFMA(kf_[d0], qa[d0], pa); pb = ATT_MFMA(kf_[d0], qc[d0], pb); } __builtin_amdgcn_s_setprio(0); } while (0)
#define ATT_VF(i) ({ const s16x4 lo_ = vtr(vp + (((i) >> 2) * 4096 + ((i) & 3) * 1024)), hi_ = vtr(vp + (((i) >> 2) * 4096 + ((i) & 3) * 1024 + 512)); (bf16x8){lo_[0], lo_[1], lo_[2], lo_[3], hi_[0], hi_[1], hi_[2], hi_[3]}; })
#define ATT_RMAX(P, RM) do { float a_ = ATT_MX3(P[0], P[1], P[2]), b_ = ATT_MX3(P[3], P[4], P[5]); a_ = ATT_MX3(a_, P[6], P[7]); b_ = ATT_MX3(b_, P[8], P[9]); a_ = ATT_MX3(a_, P[10], P[11]); b_ = ATT_MX3(b_, P[12], P[13]); a_ = ATT_MX3(a_, P[14], P[15]); \
        RM = __builtin_fmaxf(a_, b_); { auto rr_ = __builtin_amdgcn_permlane32_swap(__float_as_uint(RM), __float_as_uint(RM), false, false); RM = __builtin_fmaxf(__uint_as_float(rr_[0]), __uint_as_float(rr_[1])); } } while (0)
#define ATT_EXPS(P, MR, LR) do { float sum_ = 0.f; \
        _Pragma("unroll") for (int r = 0; r < 16; ++r) { P[r] = __builtin_amdgcn_exp2f(P[r] - MR); sum_ += P[r]; } \
        asm volatile("" : "+v"(sum_));            \
        LR += sum_; asm volatile("" : "+v"(LR)); } while (0)
#define ATT_PK(P, o) (u32x4){cvtpk(P[o], P[o + 1]), cvtpk(P[o + 2], P[o + 3]), cvtpk(P[o + 4], P[o + 5]), cvtpk(P[o + 6], P[o + 7])}
#define ATT_PV(WA, WB, i) do { const bf16x8 v0_ = ATT_VF(i), v1_ = ATT_VF((i) + 4); __builtin_amdgcn_s_setprio(1); \
        oa[0] = ATT_MFMA(__builtin_bit_cast(bf16x8, WA), v0_, oa[0]); ob[0] = ATT_MFMA(__builtin_bit_cast(bf16x8, WB), v0_, ob[0]); \
        oa[1] = ATT_MFMA(__builtin_bit_cast(bf16x8, WA), v1_, oa[1]); ob[1] = ATT_MFMA(__builtin_bit_cast(bf16x8, WB), v1_, ob[1]); __builtin_amdgcn_s_setprio(0); } while (0)
#define ATT_SMPV(t, H, MASKED_) do { const int s_ = (t) & 3; \
        if (MASKED_) { if (7 - (t) == da_) { const int l3_ = lane_id(), kb3_ = 32 * (H) + 4 * (l3_ >> 5), qa3_ = oa_ + (l3_ & 31); \
            _Pragma("unroll") for (int r = 0; r < 16; ++r) { const int kv = kb3_ + (r & 3) + 8 * (r >> 2); if (kv > qa3_) pa[r] = -INFINITY; } } } \
        float rma, rmb; ATT_RMAX(pa, rma); ATT_RMAX(pb, rmb); \
          \
        if (__any(rma > ma + 40.f || rmb > mb + 40.f)) { \
            const float na = __builtin_fmaxf(ma, rma), nb = __builtin_fmaxf(mb, rmb); const float ala = __builtin_amdgcn_exp2f(ma - na), alb = __builtin_amdgcn_exp2f(mb - nb); ma = na; mb = nb; la *= ala; lb *= alb; \
            if (hi == 0) { wsf[r32] = ala; wsf[32 + r32] = alb; } \
            asm volatile("s_waitcnt lgkmcnt(0)" ::: "memory"); \
            asm volatile("" : "+v"(oa[0]), "+v"(oa[1]));       \
            _Pragma("unroll") for (int r = 0; r < 16; ++r) { const float fa = wsf[crow(r, hi)]; oa[0][r] *= fa; oa[1][r] *= fa; if ((r & 3) == 3) asm volatile("" ::: "memory"); } \
            asm volatile("" : "+v"(oa[0]), "+v"(oa[1])); \
            asm volatile("" : "+v"(ob[0]), "+v"(ob[1])); \
            _Pragma("unroll") for (int r = 0; r < 16; ++r) { const float fb = wsf[32 + crow(r, hi)]; ob[0][r] *= fb; ob[1][r] *= fb; if ((r & 3) == 3) asm volatile("" ::: "memory"); } \
            asm volatile("" : "+v"(ob[0]), "+v"(ob[1])); } \
        ATT_EXPS(pa, ma, la); ATT_EXPS(pb, mb, lb); \
        const lcptr vp = vp0 + s_ * VSLOT; \
        { const u32x4 wa_ = ATT_PK(pa, 0), wb_ = ATT_PK(pb, 0); ATT_PV(wa_, wb_, 2 * (H)); } \
        { const u32x4 wa_ = ATT_PK(pa, 8), wb_ = ATT_PK(pb, 8); ATT_PV(wa_, wb_, 2 * (H) + 1); } } while (0)
#define ATT_QK_B(t, H) do { const lcptr kb_ = kp0 + ((t) & 3) * KSL + (H) * 512; \
        if (BIAS) { const lcptr bp = bp0 + ((t) & 3) * BSLOT + (H) * 64; \
            _Pragma("unroll") for (int g = 0; g < 4; ++g) { const f32x4 x_ = *(const __attribute__((address_space(3))) f32x4*)(bp + g * 16); \
                _Pragma("unroll") for (int e = 0; e < 4; ++e) pb[4 * g + e] = x_[e]; } } \
        else pb = f32x16{}; \
        bf16x8 kf_[ND]; _Pragma("unroll") for (int d0 = 0; d0 < ND; ++d0) kf_[d0] = *(const __attribute__((address_space(3))) bf16x8*)(kb_ + d0 * 2048); \
        _Pragma("unroll") for (int d0 = 0; d0 < ND; ++d0) pb = ATT_MFMA(kf_[d0], qc[d0], pb); } while (0)
#define ATT_SMPV_B(t, H) do { const int s_ = (t) & 3; \
        if (7 - (t) == db_) { const int l3_ = lane_id(), kb3_ = 32 * (H) + 4 * (l3_ >> 5), qb3_ = ob_ + (l3_ & 31); \
            _Pragma("unroll") for (int r = 0; r < 16; ++r) { const int kv = kb3_ + (r & 3) + 8 * (r >> 2); if (kv > qb3_) pb[r] = -INFINITY; } } \
        float rmb; ATT_RMAX(pb, rmb); \
        if (__any(rmb > mb + 40.f)) { \
            const float nb = __builtin_fmaxf(mb, rmb); const float alb = __builtin_amdgcn_exp2f(mb - nb); mb = nb; lb *= alb; \
            if (hi == 0) wsf[32 + r32] = alb; \
            asm volatile("s_waitcnt lgkmcnt(0)" ::: "memory"); \
            asm volatile("" : "+v"(ob[0]), "+v"(ob[1])); \
            _Pragma("unroll") for (int r = 0; r < 16; ++r) { const float fb = wsf[32 + crow(r, hi)]; ob[0][r] *= fb; ob[1][r] *= fb; if ((r & 3) == 3) asm volatile("" ::: "memory"); } \
            asm volatile("" : "+v"(ob[0]), "+v"(ob[1])); } \
        ATT_EXPS(pb, mb, lb); \
        const lcptr vp = vp0 + s_ * VSLOT; \
        { const u32x4 wb_ = ATT_PK(pb, 0); const bf16x8 v0_ = ATT_VF(2 * (H)), v1_ = ATT_VF(2 * (H) + 4); \
          ob[0] = ATT_MFMA(__builtin_bit_cast(bf16x8, wb_), v0_, ob[0]); ob[1] = ATT_MFMA(__builtin_bit_cast(bf16x8, wb_), v1_, ob[1]); } \
        { const u32x4 wb_ = ATT_PK(pb, 8); const bf16x8 v0_ = ATT_VF(2 * (H) + 1), v1_ = ATT_VF(2 * (H) + 5); \
          ob[0] = ATT_MFMA(__builtin_bit_cast(bf16x8, wb_), v0_, ob[0]); ob[1] = ATT_MFMA(__builtin_bit_cast(bf16x8, wb_), v1_, ob[1]); } } while (0)
#define ATT_HALF(CA, CB, NA, NB, t, H, tn, Hn, HASNEXT) do { const int s_ = (t) & 3; \
        bf16x8 kf_[ND]; if (HASNEXT) { const lcptr kb_ = kp0 + ((tn) & 3) * KSL + (Hn) * 512; \
            _Pragma("unroll") for (int d0 = 0; d0 < ND; ++d0) kf_[d0] = *(const __attribute__((address_space(3))) bf16x8*)(kb_ + d0 * 2048); } \
        float rma, rmb; ATT_RMAX(CA, rma); ATT_RMAX(CB, rmb); \
        if (__any(rma > ma + 40.f || rmb > mb + 40.f)) { \
            const float na = __builtin_fmaxf(ma, rma), nb = __builtin_fmaxf(mb, rmb); const float ala = __builtin_amdgcn_exp2f(ma - na), alb = __builtin_amdgcn_exp2f(mb - nb); ma = na; mb = nb; la *= ala; lb *= alb; \
            if (hi == 0) { wsf[r32] = ala; wsf[32 + r32] = alb; } \
            asm volatile("s_waitcnt lgkmcnt(0)" ::: "memory"); \
            asm volatile("" : "+v"(oa[0]), "+v"(oa[1])); \
            _Pragma("unroll") for (int r = 0; r < 16; ++r) { const float fa = wsf[crow(r, hi)]; oa[0][r] *= fa; oa[1][r] *= fa; if ((r & 3) == 3) asm volatile("" ::: "memory"); } \
            asm volatile("" : "+v"(oa[0]), "+v"(oa[1])); \
            asm volatile("" : "+v"(ob[0]), "+v"(ob[1])); \
            _Pragma("unroll") for (int r = 0; r < 16; ++r) { const float fb = wsf[32 + crow(r, hi)]; ob[0][r] *= fb; ob[1][r] *= fb; if ((r & 3) == 3) asm volatile("" ::: "memory"); } \
            asm volatile("" : "+v"(ob[0]), "+v"(ob[1])); } \
        float suma_ = 0.f, sumb_ = 0.f; if (HASNEXT) ATT_CINIT(NA, NB, tn, Hn); \
        __builtin_amdgcn_sched_barrier(0); \
        _Pragma("unroll") for (int d0 = 0; d0 < ND; ++d0) { \
            if (HASNEXT) { NA = ATT_MFMA(kf_[d0], qa[d0], NA); NB = ATT_MFMA(kf_[d0], qc[d0], NB); } \
            _Pragma("unroll") for (int r = (16 * d0) / ND; r < (16 * (d0 + 1)) / ND; ++r) { CA[r] = __builtin_amdgcn_exp2f(CA[r] - ma); suma_ += CA[r]; CB[r] = __builtin_amdgcn_exp2f(CB[r] - mb); sumb_ += CB[r]; } \
            asm volatile("" : "+v"(suma_), "+v"(sumb_)); \
            __builtin_amdgcn_sched_barrier(0); } \
        la += suma_; lb += sumb_; asm volatile("" : "+v"(la), "+v"(lb)); \
        const lcptr vp = vp0 + s_ * VSLOT; \
        { const u32x4 wa_ = ATT_PK(CA, 0), wb_ = ATT_PK(CB, 0); ATT_PV(wa_, wb_, 2 * (H)); } \
        { const u32x4 wa_ = ATT_PK(CA, 8), wb_ = ATT_PK(CB, 8); ATT_PV(wa_, wb_, 2 * (H) + 1); } } while (0)
    asm volatile("s_waitcnt vmcnt(6) lgkmcnt(0)\n\ts_barrier" ::: "memory");
    const int tb_ = 7 - db_, ta_ = 7 - da_;
    if (tb_ == 0) ATT_QK_B(0, 0);
    int t = 0;
    for (; t < tb_; ++t) {
        if (t + 2 < NT) { ATT_WAIT_BAR(3); } else { ATT_WAIT_BAR(0); }
        if (t + 3 < NT) ATT_DMA(NT - 4 - t, (t + 3) & 3);
        if (t + 1 == tb_) ATT_QK_B(t + 1, 0);
    }
    for (; t < ta_; ++t) {
        if (t + 2 < NT) { ATT_WAIT_BAR(3); } else { ATT_WAIT_BAR(0); }
        if (t + 3 < NT) ATT_DMA(NT - 4 - t, (t + 3) & 3);
        ATT_SMPV_B(t, 0); ATT_QK_B(t, 1); ATT_SMPV_B(t, 1);
        __builtin_amdgcn_sched_barrier(0);
        if (t + 1 < ta_) ATT_QK_B(t + 1, 0); else ATT_QK(t + 1, 0);
    }
    for (; t < 8; ++t) {
        if (t + 2 < NT) { ATT_WAIT_BAR(3); } else { ATT_WAIT_BAR(0); }
        if (t + 3 < NT) ATT_DMA(NT - 4 - t, (t + 3) & 3);
        ATT_SMPV(t, 0, true); ATT_QK(t, 1); ATT_SMPV(t, 1, true);
        __builtin_amdgcn_sched_barrier(0);
        if (t + 1 < NT) ATT_QK(t + 1, 0);
    }
    for (; t < NT; ++t) {
        if (t + 2 < NT) { ATT_WAIT_BAR(3); } else { ATT_WAIT_BAR(0); }
        if (t + 3 < NT) ATT_DMA(NT - 4 - t, (t + 3) & 3);
        ATT_HALF(pa, pb, pa2, pb2, t, 0, t, 1, true);
        ATT_HALF(pa2, pb2, pa, pb, t, 1, t + 1, 0, t + 1 < NT);
    }
#undef ATT_SKIP
#undef ATT_AACT
#undef ATT_QK_B
#undef ATT_SMPV_B
#undef ATT_HALF
#undef ATT_QK
#undef ATT_CINIT
#undef ATT_SMPV
#undef ATT_VF
#undef ATT_RMAX
#undef ATT_EXPS
#undef ATT_PK
#undef ATT_PV
    { auto rr = __builtin_amdgcn_permlane32_swap(__float_as_uint(la), __float_as_uint(la), false, false); la = __uint_as_float(rr[0]) + __uint_as_float(rr[1]); }
    { auto rr = __builtin_amdgcn_permlane32_swap(__float_as_uint(lb), __float_as_uint(lb), false, false); lb = __uint_as_float(rr[0]) + __uint_as_float(rr[1]); }
    if (hi == 0) { wsf[64 + r32] = la; wsf[96 + r32] = lb; }
    asm volatile("s_waitcnt lgkmcnt(0)" ::: "memory");
    { const int l2 = lane_id(), c2 = l2 & 31, h2 = l2 >> 5;
      __attribute__((address_space(3))) unsigned short* stg = (__attribute__((address_space(3))) unsigned short*)(lds + LDS_OST) + wid * 2048;
      __attribute__((address_space(3))) unsigned short* stw = stg + h2 * 256 + c2;
      const __attribute__((address_space(3))) float* wl = wsf + 64 + 4 * h2;
#pragma unroll
      for (int sb = 0; sb < 2; ++sb) {
#pragma unroll
        for (int r = 0; r < 16; ++r) { constexpr int dummy = 0; (void)dummy; const int cr = (r & 3) + 8 * (r >> 2); const float rl = __builtin_amdgcn_rcpf(wl[sb * 32 + cr]);
#pragma unroll
            for (int d0 = 0; d0 < 2; ++d0) stw[cr * 64 + d0 * 32] = (unsigned short)f2bf((sb ? ob[d0][r] : oa[d0][r]) * rl); }
        asm volatile("s_waitcnt lgkmcnt(0)" ::: "memory");
        unsigned short* Ow = Oh + (size_t)(q0 + (sb ? rb0 : ra0)) * po;
#pragma unroll
        for (int i = 0; i < 4; ++i) { const int row = i * 8 + (l2 >> 3), ch = l2 & 7; *(u32x4*)(Ow + (size_t)row * po + ch * 8) = *(const __attribute__((address_space(3))) u32x4*)(stg + row * 64 + ch * 8); }
        asm volatile("s_waitcnt lgkmcnt(0)" ::: "memory");
      } }
    asm volatile("s_waitcnt lgkmcnt(0)\n\ts_barrier" ::: "memory");
#undef ATT_DMA
}
}
namespace mid {
using bf16x8 = __attribute__((ext_vector_type(8))) short;
using f32x16 = __attribute__((ext_vector_type(16))) float;
using u32x4 = __attribute__((ext_vector_type(4))) unsigned;
typedef __attribute__((address_space(3))) char* lptr;
#define MID_MFMA(a, b, c) __builtin_amdgcn_mfma_f32_32x32x16_bf16(a, b, c, 0, 0, 0)
__device__ __forceinline__ int crow(int r, int hi) { return (r & 3) + 8 * (r >> 2) + 4 * hi; }
__device__ __forceinline__ float bf_lo(unsigned w) { return __uint_as_float(w << 16); }
__device__ __forceinline__ float bf_hi(unsigned w) { return __uint_as_float(w & 0xffff0000u); }
__device__ __forceinline__ float bfu(unsigned short v) { return __uint_as_float((unsigned)v << 16); }
__device__ __forceinline__ float xhalf_sum(float x) { auto t = __builtin_amdgcn_permlane32_swap(__float_as_uint(x), __float_as_uint(x), false, false); return __uint_as_float(t[0]) + __uint_as_float(t[1]); }
__device__ __forceinline__ float sumsq8(bf16x8 v) { float s = 0.f;
#pragma unroll
    for (int j = 0; j < 8; ++j) { const float f = bfu((unsigned short)v[j]); s += f * f; } return s; }

typedef __bf16 bf2_t __attribute__((ext_vector_type(2)));
typedef float fl2_t __attribute__((ext_vector_type(2)));
__device__ __forceinline__ unsigned cvtpk(float lo, float hi) { const fl2_t v = {lo, hi}; return __builtin_bit_cast(unsigned, __builtin_convertvector(v, bf2_t)); }
template <int KS, int NT>
__device__ __forceinline__ void latent_gemm(f32x16 (&acc)[NT], __attribute__((address_space(3))) const char* arow  , const unsigned short* wt  , float post) {
    float ss = 0.f;
#pragma unroll
    for (int nt = 0; nt < NT; ++nt) acc[nt] = f32x16{};
#pragma unroll
    for (int ks = 0; ks < KS; ++ks) { const bf16x8 a = *(const __attribute__((address_space(3))) bf16x8*)(arow + 32 * ks); ss += sumsq8(a);
#pragma unroll
        for (int nt = 0; nt < NT; ++nt) { const bf16x8 b = *reinterpret_cast<const bf16x8*>(wt + (size_t)(nt * KS + ks) * 512); acc[nt] = MID_MFMA(b, a, acc[nt]); }
        if ((ks & 3) == 3) asm volatile("" ::: "memory"); }
    ss = xhalf_sum(ss);
    const float rstd = rsqrtf(ss * (1.0f / (16 * KS)) + EPS) * post;
#pragma unroll
    for (int nt = 0; nt < NT; ++nt) acc[nt] = acc[nt] * rstd;
}
__device__ __forceinline__ void rope_tile(f32x16& x, const float* rp, int hi) {
#pragma unroll
    for (int g = 0; g < 2; ++g) { const f32x4 c0 = *(const f32x4*)(rp + (8 * g + 4 * hi) * 2), c1 = *(const f32x4*)(rp + (8 * g + 4 * hi) * 2 + 4);
        const float cs[4][2] = {{c0[0], c0[1]}, {c0[2], c0[3]}, {c1[0], c1[1]}, {c1[2], c1[3]}};
#pragma unroll
        for (int e = 0; e < 4; ++e) { const int r = 4 * g + e; const float x1 = x[r], x2 = x[r + 8]; x[r] = x1 * cs[e][0] - x2 * cs[e][1]; x[r + 8] = x2 * cs[e][0] + x1 * cs[e][1]; } }
}
__device__ __forceinline__ void stage_tiles(__attribute__((address_space(3))) char* stg, const f32x16& t0, const f32x16& t1, int r32, int hi) {
    typedef unsigned u32x2_ __attribute__((ext_vector_type(2)));
#pragma unroll
    for (int n2 = 0; n2 < 2; ++n2) { const f32x16& t = n2 ? t1 : t0;
#pragma unroll
        for (int g = 0; g < 4; ++g) { u32x2_ w; w.x = cvtpk(t[4 * g], t[4 * g + 1]); w.y = cvtpk(t[4 * g + 2], t[4 * g + 3]);
            *(__attribute__((address_space(3))) u32x2_*)(stg + r32 * 144 + (32 * n2 + 8 * g + 4 * hi) * 2) = w; } }
}

constexpr float QSCALE = 0.10206207261596577f * 1.4426950408889634f;
constexpr int STG_BYTES = 16384;
template <class F> __device__ __forceinline__ void stage_out(__attribute__((address_space(3))) const char* stg, int lane, F dst) {
#pragma unroll
    for (int it = 0; it < 4; ++it) { const int row = it * 8 + (lane >> 3), ch = lane & 7;
        *(u32x4*)dst(row, ch) = *(const __attribute__((address_space(3))) u32x4*)(stg + row * 144 + ch * 16); }
}

constexpr int ATILE_BYTES = 128 * 704, OSTG_OFF = ATILE_BYTES, OSTG_BYTES = 4608;
__device__ __forceinline__ void glds16(const void* g, unsigned lds_base) {
    unsigned sv; asm volatile("s_mov_b32 %0, m0\n\ts_mov_b32 m0, %2\n\ts_nop 0\n\tglobal_load_lds_dwordx4 %1, off\n\ts_mov_b32 m0, %0" : "=&s"(sv) : "v"(g), "s"(lds_base) : "memory"); }
constexpr int LAT_TBL = OSTG_OFF + 8 * OSTG_BYTES;
template <int KS> __device__ __forceinline__ void latent_tile(f32x16 (&acc)[4], __attribute__((address_space(3))) const char* a0, const unsigned short* wt) {
#pragma unroll
    for (int blk = 0; blk < 4; ++blk) acc[blk] = f32x16{};
#pragma unroll
    for (int ks = 0; ks < KS; ++ks) { const bf16x8 w = *reinterpret_cast<const bf16x8*>(wt + (size_t)ks * 512);
#pragma unroll
        for (int blk = 0; blk < 4; ++blk) { const bf16x8 a = *(const __attribute__((address_space(3))) bf16x8*)(a0 + blk * (32 * 704) + 32 * ks); acc[blk] = MID_MFMA(w, a, acc[blk]); } }
}
__device__ __forceinline__ void p2_latent(KArgs ka, int l, int tok0, lptr L, int wv) {
    unsigned char* ws = ka->ws; const int lane = lane_id(), r32 = lane & 31, hi = lane >> 5, tb = wv & 3, g = wv >> 2;
    const unsigned short* Z = (const unsigned short*)(ws + WS_Z); const size_t wl = WS_W + (size_t)l * W_LAYER;
    {
        const unsigned lds0 = (unsigned)(uintptr_t)L;
#pragma unroll
        for (int p = 0; p < 11; ++p) { const int id = (wv * 11 + p) * 64 + lane, row = id / 44, ch = id % 44;
            glds16(Z + (size_t)(tok0 + row) * DINP + ch * 8, (unsigned)__builtin_amdgcn_readfirstlane(lds0 + (wv * 11 + p) * 1024)); }
        asm volatile("s_waitcnt vmcnt(0)" ::: "memory"); __syncthreads();
    }
    __attribute__((address_space(3))) float* tbl = (__attribute__((address_space(3))) float*)(L + LAT_TBL);
    {   const int tid = wv * 64 + lane, tl = tid & 127, lat = (tid >> 7) & 1, half = tid >> 8;
        __attribute__((address_space(3))) const char* row = (__attribute__((address_space(3))) const char*)L + tl * 704 + (lat ? O_KVC * 2 + half * 128 : half * 192);
        float sq = 0.f;
#pragma unroll
        for (int c = 0; c < 12; ++c) if (c < 8 || lat == 0) sq += sumsq8(*(const __attribute__((address_space(3))) bf16x8*)(row + 16 * c));
        tbl[(half * 2 + lat) * 128 + tl] = sq;
        __syncthreads();
        if (tid < 256) { const int l2 = tid >> 7, t2 = tid & 127; const float ss = tbl[l2 * 128 + t2] + tbl[(2 + l2) * 128 + t2];
            tbl[512 + l2 * 128 + t2] = rsqrtf(ss * (l2 ? 1.0f / 128.0f : 1.0f / 192.0f) + EPS) * (l2 ? 1.0f : QSCALE); }
        __syncthreads();
    }
    __attribute__((address_space(3))) char* stg = (__attribute__((address_space(3))) char*)(L + OSTG_OFF + wv * OSTG_BYTES);
    for (int it = 0; it < 4; ++it) {
        int jt; bool isq;
        if (wv < 4) { if (it == 3) break; isq = it < 2; jt = it < 2 ? wv + 8 * it : wv; }
        else { isq = it == 0; jt = it == 0 ? wv : 4 + 3 * (wv - 4) + (it - 1); }
        f32x16 acc[4];
        __attribute__((address_space(3))) const char* a0 = (__attribute__((address_space(3))) const char*)L + r32 * 704 + 16 * hi + (isq ? 0 : O_KVC * 2);
        if (isq) latent_tile<12>(acc, a0, (const unsigned short*)(ws + wl + W_UQ) + (size_t)jt * 12 * 512 + lane * 8);
        else latent_tile<8>(acc, a0, (const unsigned short*)(ws + wl + W_UKV) + (size_t)jt * 8 * 512 + lane * 8);
        const bool rope = isq && (jt % 3) == 2;
#pragma unroll
        for (int blk = 0; blk < 4; ++blk) {
            const float rs = tbl[512 + (isq ? 0 : 128) + 32 * blk + r32];
            f32x16 t = acc[blk] * rs;
            if (rope) rope_tile(t, (const float*)(ws + WS_ROPE) + (size_t)(tok0 + 32 * blk + r32) * 32, hi);
            typedef unsigned u32x2_ __attribute__((ext_vector_type(2)));
#pragma unroll
            for (int g = 0; g < 4; ++g) { u32x2_ w; w.x = cvtpk(t[4 * g], t[4 * g + 1]); w.y = cvtpk(t[4 * g + 2], t[4 * g + 3]);
                *(__attribute__((address_space(3))) u32x2_*)(stg + r32 * 80 + (8 * g + 4 * hi) * 2) = w; }
            asm volatile("s_waitcnt lgkmcnt(0)" ::: "memory");
            unsigned short* dst; int pitch;
            if (isq) { dst = (unsigned short*)(ws + WS_Q) + (size_t)(tok0 + 32 * blk) * 384 + 32 * jt; pitch = 384; }
            else { const int head = jt >> 2, nt = jt & 3;
                if (nt < 2) { dst = (unsigned short*)(ws + WS_K) + (size_t)(tok0 + 32 * blk) * 384 + head * 96 + 32 * nt; pitch = 384; }
                else { dst = (unsigned short*)(ws + WS_V) + (size_t)(tok0 + 32 * blk) * 256 + head * 64 + 32 * (nt - 2); pitch = 256; } }
#pragma unroll
            for (int i2 = 0; i2 < 2; ++i2) { const int row = i2 * 16 + (lane >> 2), ch = lane & 3;
                *(u32x4*)(dst + (size_t)row * pitch + ch * 8) = *(const __attribute__((address_space(3))) u32x4*)(stg + row * 80 + ch * 16); }
            asm volatile("s_waitcnt lgkmcnt(0)" ::: "memory");
        }
    }
    {
        const int tid = wv * 64 + lane, tl = tid & 127, t = tok0 + tl, i0 = 4 * (tid >> 7);
        __attribute__((address_space(3))) const unsigned short* zr = (__attribute__((address_space(3))) const unsigned short*)(L + tl * 704 + O_KR * 2); const float* rk = (const float*)(ws + WS_ROPE) + (size_t)t * 32;
        __syncthreads();
        __attribute__((address_space(3))) unsigned short* rt = (__attribute__((address_space(3))) unsigned short*)(L + OSTG_OFF);
#pragma unroll
        for (int q = 0; q < 4; ++q) { const int i = i0 + q; const float x1 = bfu(zr[i]), x2 = bfu(zr[16 + i]), c = rk[2 * i], sn = rk[2 * i + 1];
            rt[tl * 32 + i] = (unsigned short)f2bf(x1 * c - x2 * sn); rt[tl * 32 + 16 + i] = (unsigned short)f2bf(x2 * c + x1 * sn); }
        __syncthreads();
        unsigned short* K = (unsigned short*)(ws + WS_K) + (size_t)tok0 * 384;
#pragma unroll
        for (int k = 0; k < 4; ++k) { const int cidx = tid + 512 * k, tok = cidx >> 4, hd = (cidx >> 2) & 3, part = cidx & 3;
            *(u32x4*)(K + (size_t)tok * 384 + hd * 96 + 64 + part * 8) = *(const __attribute__((address_space(3))) u32x4*)(rt + tok * 32 + part * 8); }
    }
    __syncthreads();
}

__device__ __forceinline__ float log_sigmoid(float x) { return fminf(x, 0.f) - 0.6931471805599453f * __builtin_amdgcn_logf(1.f + __builtin_amdgcn_exp2f(-1.4426950408889634f * fabsf(x))); }
__device__ __forceinline__ void p2_forget(KArgs ka, int l, int b, int tt, lptr L, int wv) {
    unsigned char* ws = ka->ws; const int lane = lane_id(), tid = wv * 64 + lane, h = tid & 3, j = tid >> 2;
    const float* FL = (const float*)(ws + WS_FL) + (size_t)b * S * 4; const float bf = ka->in[9][l * 4 + h];
    __attribute__((address_space(3))) double* red = (__attribute__((address_space(3))) double*)(L + 8 * STG_BYTES + 1024);
    __attribute__((address_space(3))) float* own = (__attribute__((address_space(3))) float*)(L + 8 * STG_BYTES + 1024 + 4096);
    double part = 0.0;
#pragma unroll 8
    for (int t = j; t < 128 * tt; t += 128) part += (double)log_sigmoid(FL[(size_t)t * 4 + h] + bf);
    red[h * 128 + j] = part; own[h * 128 + j] = log_sigmoid(FL[(size_t)(128 * tt + j) * 4 + h] + bf);
    __syncthreads();
    if (wv < 4) {
        const int hh = wv; double c = red[hh * 128 + 2 * lane] + red[hh * 128 + 2 * lane + 1];
#pragma unroll
        for (int o = 1; o < 64; o <<= 1) c += lshfl(c, lane ^ o);
        const float v0 = own[hh * 128 + 2 * lane], v1 = own[hh * 128 + 2 * lane + 1]; float s = v0 + v1, incl = s;
#pragma unroll
        for (int o = 1; o < 64; o <<= 1) { const float up = lshfl(incl, (lane - o) & 63); if (lane >= o) incl += up; }
        const double c0 = c + (double)(incl - s) + (double)v0, c1 = c0 + (double)v1;
        float* cbx = (float*)(ws + WS_CBX) + ((size_t)(b * 64 + 2 * tt) * 4 + hh) * 64;
#pragma unroll
        for (int q = 0; q < 2; ++q) { const int k128 = 2 * lane + q, tile = k128 >> 6, k = k128 & 63, khi = (k >> 2) & 1, n = k >> 5, r = (k & 3) + 4 * ((k & 31) >> 3);
            cbx[(size_t)tile * 256 + khi * 32 + n * 16 + r] = (float)(-(q ? c1 : c0) * 1.4426950408889634); }
    }
    __syncthreads();
}

__device__ __forceinline__ float gelu_tanh(float x) { const float u = 0.7978845608028654f * (x + 0.044715f * x * x * x); const float e = __expf(2.f * u); return x * (1.f - __builtin_amdgcn_rcpf(e + 1.f)); }
__device__ __forceinline__ void lru_load_table(KArgs ka, int l, lptr L, int wv) {
    const int tid = wv * 64 + lane_id(); __attribute__((address_space(3))) float* tab = (__attribute__((address_space(3))) float*)(L + LRU_TAB_OFF);
    const float* cw = ka->in[10] + (size_t)l * 4 * LRU_W; const float* cbias = ka->in[11] + (size_t)l * LRU_W;
    for (int i = tid; i < 5 * LRU_W; i += 512) tab[i] = i < 4 * LRU_W ? cw[i] : cbias[i - 4 * LRU_W];
    __syncthreads();
}
__device__ __forceinline__ void lru_pass1(KArgs ka, int l, int b, int tt, lptr L, int wv) {
    unsigned char* ws = ka->ws; const int lane = lane_id(), r32 = lane & 31, hi = lane >> 5;
    const int cb0 = 64 * wv, u = b * 32 + tt;
    const unsigned short* Z = (const unsigned short*)(ws + WS_Z); const size_t wl = WS_W + (size_t)l * W_LAYER;
    const __attribute__((address_space(3))) float* tab = (const __attribute__((address_space(3))) float*)(L + LRU_TAB_OFF) + cb0 + 8 * hi;
    bf16x8 idf[2];
#pragma unroll
    for (int q = 0; q < 2; ++q)
#pragma unroll
        for (int j = 0; j < 8; ++j) idf[q][j] = ((r32 >> 4) == q && (r32 & 15) == 8 * hi + j) ? (short)0x3f80 : (short)0;
    float A_run[2] = {1.f, 1.f}, H_run[2] = {0.f, 0.f};
    const unsigned short* zl = Z + (size_t)(b * S) * DINP + O_LX + cb0 + 8 * hi;
#define LRU_LOADZ(dst, sbi) do { const int t_ = 128 * tt + 32 * (sbi) + r32; const int tc_ = t_ < 0 ? 0 : t_; _Pragma("unroll") for (int ks = 0; ks < 4; ++ks) { \
        bf16x8 v_ = *reinterpret_cast<const bf16x8*>(zl + (size_t)tc_ * DINP + 16 * ks); if (t_ < 0) v_ = bf16x8{}; dst[ks] = v_; } } while (0)
    bf16x8 wrf[2][4], wif[2][4];
#pragma unroll
    for (int nt = 0; nt < 2; ++nt)
#pragma unroll
        for (int ks = 0; ks < 4; ++ks) { const size_t o = (size_t)wv * 4096 + (size_t)(nt * 4 + ks) * 512 + lane * 8;
            wrf[nt][ks] = *reinterpret_cast<const bf16x8*>((const unsigned short*)(ws + wl + W_R) + o); wif[nt][ks] = *reinterpret_cast<const bf16x8*>((const unsigned short*)(ws + wl + W_I) + o); }
    bf16x8 zprev[4], zcur[4], znext[4];
    LRU_LOADZ(zprev, -1); LRU_LOADZ(zcur, 0);
    for (int sb = 0; sb < 4; ++sb) {
        if (sb < 3) LRU_LOADZ(znext, sb + 1);
        bf16x8 af[4];
#pragma unroll
        for (int ks = 0; ks < 4; ++ks) {
            float xv[8];
            { const f32x4 b0 = *(const __attribute__((address_space(3))) f32x4*)(tab + 4 * LRU_W + 16 * ks), b1 = *(const __attribute__((address_space(3))) f32x4*)(tab + 4 * LRU_W + 16 * ks + 4);
              const f32x4 w0 = *(const __attribute__((address_space(3))) f32x4*)(tab + 3 * LRU_W + 16 * ks), w1 = *(const __attribute__((address_space(3))) f32x4*)(tab + 3 * LRU_W + 16 * ks + 4);
#pragma unroll
              for (int j = 0; j < 4; ++j) { xv[j] = b0[j] + w0[j] * bfu((unsigned short)zcur[ks][j]); xv[4 + j] = b1[j] + w1[j] * bfu((unsigned short)zcur[ks][4 + j]); } }
            const u32x4 cu = __builtin_bit_cast(u32x4, zcur[ks]), pu = __builtin_bit_cast(u32x4, zprev[ks]);
#pragma unroll
            for (int d = 1; d <= 3; ++d) {
                const int src = (((r32 - d) & 31) + 32 * hi) * 4; u32x4 sh;
#pragma unroll
                for (int q = 0; q < 4; ++q) { const unsigned c_ = (unsigned)__builtin_amdgcn_ds_bpermute(src, (int)cu[q]), p_ = (unsigned)__builtin_amdgcn_ds_bpermute(src, (int)pu[q]); sh[q] = r32 >= d ? c_ : p_; }
                const f32x4 w0 = *(const __attribute__((address_space(3))) f32x4*)(tab + (3 - d) * LRU_W + 16 * ks), w1 = *(const __attribute__((address_space(3))) f32x4*)(tab + (3 - d) * LRU_W + 16 * ks + 4);
                xv[0] += w0[0] * bf_lo(sh[0]); xv[1] += w0[1] * bf_hi(sh[0]); xv[2] += w0[2] * bf_lo(sh[1]); xv[3] += w0[3] * bf_hi(sh[1]);
                xv[4] += w1[0] * bf_lo(sh[2]); xv[5] += w1[1] * bf_hi(sh[2]); xv[6] += w1[2] * bf_lo(sh[3]); xv[7] += w1[3] * bf_hi(sh[3]); }
#pragma unroll
            for (int j = 0; j < 8; ++j) af[ks][j] = (short)f2bf(xv[j]);
        }
#pragma unroll
        for (int nt = 0; nt < 2; ++nt) {
            __builtin_amdgcn_sched_barrier(0);
            const int ch = cb0 + 32 * nt + r32;
            f32x16 rp = f32x16{}, ip = f32x16{}, xc = f32x16{};
#pragma unroll
            for (int ks = 0; ks < 4; ++ks) { rp = MID_MFMA(af[ks], wrf[nt][ks], rp); ip = MID_MFMA(af[ks], wif[nt][ks], ip); }
            xc = MID_MFMA(af[2 * nt], idf[0], xc); xc = MID_MFMA(af[2 * nt + 1], idf[1], xc);
            u32x4 pk[4];
            {   const float br = ka->in[13][l * LRU_W + ch], bi = ka->in[15][l * LRU_W + ch]; const float nl = -ka->in[16][l * LRU_W + ch]; const float la8 = -8.0f * (fmaxf(nl, 0.f) + 0.6931471805599453f * __builtin_amdgcn_logf(1.f + __builtin_amdgcn_exp2f(-1.4426950408889634f * fabsf(nl))));
#pragma unroll
                for (int r = 0; r < 16; ++r) { const float rg = __builtin_amdgcn_rcpf(1.f + __expf(-(rp[r] + br))), ig = __builtin_amdgcn_rcpf(1.f + __expf(-(ip[r] + bi)));
                    const float a = __expf(rg * la8); rp[r] = 1.f - a; ip[r] = __builtin_amdgcn_sqrtf(fmaxf(1.f - a * a, 0.f)) * (ig * xc[r]); }
#pragma unroll
                for (int r = 0; r < 16; r += 2) { const unsigned wa = pk2(rp[r], rp[r + 1]), wb = pk2(ip[r], ip[r + 1]); pk[r >> 3][(r >> 1) & 3] = wa; pk[2 + (r >> 3)][(r >> 1) & 3] = wb;
                    rp[r] = 1.f - bf_lo(wa); rp[r + 1] = 1.f - bf_hi(wa); ip[r] = bf_lo(wb); ip[r + 1] = bf_hi(wb); } }
            { u32x4* dst = (u32x4*)(ws + WS_PP) + ((((size_t)u * 8 + wv) * 4 + sb) * 2 + nt) * 256 + lane * 4;
#pragma unroll
              for (int q = 0; q < 4; ++q) dst[q] = pk[q]; }
            float st = H_run[nt], ap = A_run[nt];
#pragma unroll
            for (int g = 0; g < 4; ++g) { float A = 1.f, Bv = 0.f;
#pragma unroll
                for (int q = 0; q < 4; ++q) { const float a = rp[4 * g + q]; Bv = a * Bv + ip[4 * g + q]; A *= a; }
                auto ta = __builtin_amdgcn_permlane32_swap(__float_as_uint(A), __float_as_uint(A), false, false); auto tb = __builtin_amdgcn_permlane32_swap(__float_as_uint(Bv), __float_as_uint(Bv), false, false);
                const float oA = __uint_as_float(hi ? ta[0] : ta[1]), oB = __uint_as_float(hi ? tb[0] : tb[1]);
                const float pA = hi ? oA : A, pB = hi ? oB : Bv, qA = hi ? A : oA, qB = hi ? Bv : oB;
                st = pA * st + pB; st = qA * st + qB; ap *= pA * qA; }
            H_run[nt] = st; A_run[nt] = ap;
        }
#pragma unroll
        for (int ks = 0; ks < 4; ++ks) { zprev[ks] = zcur[ks]; zcur[ks] = znext[ks]; }
    }
#undef LRU_LOADZ
    if (hi == 0) {
#pragma unroll
        for (int nt = 0; nt < 2; ++nt) { float* sum = (float*)(ws + WS_LRUSUM) + (size_t)u * 1024 + cb0 + 32 * nt + r32; sum[0] = A_run[nt]; sum[512] = H_run[nt]; } }
}
__device__ __forceinline__ void lru_pass2(KArgs ka, int l, int b, int tt, lptr L, int wv) {
    unsigned char* ws = ka->ws; const int lane = lane_id(), r32 = lane & 31, hi = lane >> 5;
    const int tok0 = b * S + 128 * tt, cb0 = 64 * wv, u = b * 32 + tt;
    const unsigned short* Z = (const unsigned short*)(ws + WS_Z);
    bf16x8 idf[2];
#pragma unroll
    for (int q = 0; q < 2; ++q)
#pragma unroll
        for (int j = 0; j < 8; ++j) idf[q][j] = ((r32 >> 4) == q && (r32 & 15) == 8 * hi + j) ? (short)0x3f80 : (short)0;
    float H_run[2] = {0.f, 0.f};
    { const float* sum = (const float*)(ws + WS_LRUSUM) + (size_t)(b * 32) * 1024;
#pragma unroll 8
      for (int t2 = 0; t2 < tt; ++t2)
#pragma unroll
          for (int nt = 0; nt < 2; ++nt) { const int ch = cb0 + 32 * nt + r32; H_run[nt] = sum[(size_t)t2 * 1024 + ch] * H_run[nt] + sum[(size_t)t2 * 1024 + 512 + ch]; } }
    __attribute__((address_space(3))) float* otile = (__attribute__((address_space(3))) float*)L;
    const u32x4* ab = (const u32x4*)(ws + WS_PP) + (((size_t)u * 8 + wv) * 4) * 2 * 256 + lane * 4;
    u32x4 pk[2][4]; bf16x8 lg[4];
#define LRU_LOAD2(sbi) do { _Pragma("unroll") for (int nt = 0; nt < 2; ++nt) _Pragma("unroll") for (int q = 0; q < 4; ++q) pk[nt][q] = ab[((size_t)(sbi) * 2 + nt) * 256 + q]; \
        _Pragma("unroll") for (int ks = 0; ks < 4; ++ks) lg[ks] = *reinterpret_cast<const bf16x8*>(Z + (size_t)(tok0 + 32 * (sbi) + r32) * DINP + O_LG + cb0 + 16 * ks + 8 * hi); } while (0)
    LRU_LOAD2(0);
    for (int sb = 0; sb < 4; ++sb) {
        float av[2][16], bv[2][16]; f32x16 lgc[2];
#pragma unroll
        for (int nt = 0; nt < 2; ++nt) {
#pragma unroll
            for (int r = 0; r < 16; r += 2) { const unsigned wa = pk[nt][r >> 3][(r >> 1) & 3], wb = pk[nt][2 + (r >> 3)][(r >> 1) & 3];
                av[nt][r] = 1.f - bf_lo(wa); av[nt][r + 1] = 1.f - bf_hi(wa); bv[nt][r] = bf_lo(wb); bv[nt][r + 1] = bf_hi(wb); }
            lgc[nt] = f32x16{}; lgc[nt] = MID_MFMA(lg[2 * nt], idf[0], lgc[nt]); lgc[nt] = MID_MFMA(lg[2 * nt + 1], idf[1], lgc[nt]); }
        if (sb < 3) LRU_LOAD2(sb + 1);
#pragma unroll
        for (int nt = 0; nt < 2; ++nt) {
            const int ch = cb0 + 32 * nt + r32; float carry[4]; float st = H_run[nt];
#pragma unroll
            for (int g = 0; g < 4; ++g) { float A = 1.f, Bv = 0.f;
#pragma unroll
                for (int q = 0; q < 4; ++q) { const float a = av[nt][4 * g + q]; Bv = a * Bv + bv[nt][4 * g + q]; A *= a; }
                auto ta = __builtin_amdgcn_permlane32_swap(__float_as_uint(A), __float_as_uint(A), false, false); auto tb = __builtin_amdgcn_permlane32_swap(__float_as_uint(Bv), __float_as_uint(Bv), false, false);
                const float oA = __uint_as_float(hi ? ta[0] : ta[1]), oB = __uint_as_float(hi ? tb[0] : tb[1]);
                const float pA = hi ? oA : A, pB = hi ? oB : Bv, qA = hi ? A : oA, qB = hi ? Bv : oB;
                const float c0 = st; st = pA * st + pB; const float c1 = st; st = qA * st + qB; carry[g] = hi ? c1 : c0; }
            H_run[nt] = st;
#pragma unroll
            for (int g = 0; g < 4; ++g) { float hcur = carry[g];
#pragma unroll
                for (int q = 0; q < 4; ++q) { const int r = 4 * g + q; hcur = av[nt][r] * hcur + bv[nt][r]; otile[(sb & 1) * 16384 + crow(r, hi) * 512 + ch] = hcur * gelu_tanh(lgc[nt][r]); } }
        }
        __syncthreads();
#pragma unroll
        for (int q = 0; q < 4; ++q) { const int row = 4 * wv + q; const __attribute__((address_space(3))) float* src = otile + (sb & 1) * 16384 + row * 512 + 8 * lane;
            const f32x4 x0 = *(const __attribute__((address_space(3))) f32x4*)src, x1 = *(const __attribute__((address_space(3))) f32x4*)(src + 4);
            float s = (x0[0] * x0[0] + x0[1] * x0[1]) + (x0[2] * x0[2] + x0[3] * x0[3]) + (x1[0] * x1[0] + x1[1] * x1[1]) + (x1[2] * x1[2] + x1[3] * x1[3]);
            s = wave_sum(s, lane); const float rn = rsqrtf(s * (1.0f / 512.0f) + EPS);
            u32x4 o; o.x = pk2(x0[0] * rn, x0[1] * rn); o.y = pk2(x0[2] * rn, x0[3] * rn); o.z = pk2(x1[0] * rn, x1[1] * rn); o.w = pk2(x1[2] * rn, x1[3] * rn);
            *(u32x4*)((unsigned short*)(ws + WS_O) + (size_t)(tok0 + 32 * sb + row) * D + 512 + 8 * lane) = o; }
    }
#undef LRU_LOAD2
#pragma unroll
    for (int q0 = 0; q0 < 16; q0 += 8) { u32x4 v[8]; unsigned short* p0 = (unsigned short*)(ws + WS_O) + (size_t)(tok0 + 16 * wv + q0) * D + 8 * lane;
#pragma unroll
        for (int q = 0; q < 8; ++q) v[q] = *(const u32x4*)(p0 + (size_t)q * D);
#pragma unroll
        for (int q = 0; q < 8; ++q) {
            float f[8] = {bf_lo(v[q].x), bf_hi(v[q].x), bf_lo(v[q].y), bf_hi(v[q].y), bf_lo(v[q].z), bf_hi(v[q].z), bf_lo(v[q].w), bf_hi(v[q].w)};
            float s = 0.f;
#pragma unroll
            for (int j = 0; j < 8; ++j) s += f[j] * f[j];
#pragma unroll
            for (int o = 1; o < 32; o <<= 1) s += lshfl(s, lane ^ o);
            const float rn = rsqrtf(s * (1.0f / 256.0f) + EPS);
            u32x4 w; w.x = pk2(f[0] * rn, f[1] * rn); w.y = pk2(f[2] * rn, f[3] * rn); w.z = pk2(f[4] * rn, f[5] * rn); w.w = pk2(f[6] * rn, f[7] * rn); *(u32x4*)(p0 + (size_t)q * D) = w; } }
}
}
__device__ __forceinline__ int zcol_perm(int n) { return n < 1120 ? n : (n < 1124 ? 2144 + (n - 1120) : (n < DIN ? n - 4 : n)); }
__device__ __forceinline__ int up_perm(int n) { return n < DFF ? 256 * (n >> 7) + (n & 127) : 256 * ((n - DFF) >> 7) + 128 + ((n - DFF) & 127); }
__device__ __forceinline__ void tr_item(const float* W, int K, int N, const float* g, bf16* WT, int mode, LAS float* scr, int kb, int nb, int lane) {
    const int k0 = 64 * kb, n0 = 32 * nb;
#pragma unroll 8
    for (int i = 0; i < 32; ++i) { const int kk = 2 * i + (lane >> 5), n = n0 + (lane & 31); float v = (n < N) ? W[(size_t)(k0 + kk) * N + n] : 0.f; if (g) v *= g[k0 + kk]; scr[kk * 33 + (lane & 31)] = v; }
    LDS_WAIT(); asm volatile("" ::: "memory");
    const int c = lane & 7;
#pragma unroll
    for (int j = 0; j < 4; ++j) { const int nl = (lane >> 3) + 8 * j, n = n0 + nl; const int dest = mode == 1 ? up_perm(n) : (mode == 2 ? zcol_perm(n) : n); const LAS float* s = scr + (8 * c) * 33 + nl;
        v4u o; o.x = pk2(s[0 * 33], s[1 * 33]); o.y = pk2(s[2 * 33], s[3 * 33]); o.z = pk2(s[4 * 33], s[5 * 33]); o.w = pk2(s[6 * 33], s[7 * 33]);
        if (mode == 3) { const int c8 = (k0 >> 3) + c;
            *(GAS v4u*)(WT + ((size_t)((n >> 5) * (K >> 4) + (c8 >> 1)) * 64 + (c8 & 1) * 32 + (n & 31)) * 8) = o; }
        else *(GAS v4u*)(WT + (size_t)dest * K + k0 + 8 * c) = o; }
    LDS_WAIT(); asm volatile("" ::: "memory");
}
__global__ void __launch_bounds__(NWAVES * 64, 2) mega(Args args) {
    extern __shared__ __attribute__((aligned(16))) unsigned char lds[];
    LAS unsigned char* L = (LAS unsigned char*)lds;
    const int wave = __builtin_amdgcn_readfirstlane((int)threadIdx.x >> 6);
    {
        const int t0 = wave * 64 + lane_id();
        for (int u = t0; u < (LDS_BYTES - LDSCTL_OFF) / 4; u += NWAVES * 64) ((LAS unsigned*)(L + LDSCTL_OFF))[u] = 0u;
        __syncthreads();
        if (kargs()->ph_hi - kargs()->ph_lo > 1) (void)xcd_barrier_post((unsigned*)(kargs()->ws + WS_CTL) + CW_BAR, (volatile LAS unsigned*)(L + MISC_OFF) + 8);
    }
#define GRID_BAR(p) do { if (IN(p) && IN((p) + 1)) { XcdBarrier gb_; gb_.bar = (unsigned*)(kargs()->ws + WS_CTL) + CW_BAR; gb_.x = xb_xcc_id(); gb_.st = (volatile LAS unsigned*)(L + MISC_OFF) + 8; xcd_barrier(gb_); } } while (0)
#define GRID_IDS int G = gridDim.x, bx = blockIdx.x, wv = wave; asm volatile("" : "+s"(G), "+s"(bx), "+s"(wv)); const int vcu = (G % 8 == 0) ? (bx % 8) * (G / 8) + bx / 8 : bx; const int gw = vcu * NWAVES + wv, NGW = G * NWAVES; (void)gw; (void)NGW
#ifndef PH_MASK
#define PH_MASK 0xFFFFFF
#endif
#ifndef REPEAT_MASK
#define REPEAT_MASK 0
#endif
#define IN(p) (kargs()->ph_lo <= (p) && (p) < kargs()->ph_hi)
#define PHASE_PTRS const KArgs ka = kargs(); unsigned char* ws = ka->ws; (void)ws; GRID_IDS
#define LANE_IDS const int lane = lane_id(), tid = wv * 64 + lane; (void)tid
    if ((PH_MASK & 1) && IN(0)) {
            PHASE_PTRS; LANE_IDS; bf16* HB = (bf16*)(ws + WS_HB); float* SSA = (float*)(ws + WS_SSA);
            LAS float* scr = (LAS float*)(L + RING_OFF + wv * 16384);
            {
                constexpr int I_IN = (D / 64) * (DINP / 32), I_O = (D / 64) * (D / 32), I_UP = (D / 64) * (2 * DFF / 32), I_DN = (DFF / 64) * (D / 32), I_PG = I_O, I_PP = (PLE / 64) * (D / 32);
                constexpr int I_UQ = (192 / 64) * (384 / 32), I_UKV = (128 / 64) * (512 / 32), I_RI = 32;
                constexpr int I_LAYER = I_IN + I_O + I_UP + I_DN + I_PG + I_PP + I_UQ + I_UKV + I_RI;
                for (int it0 = gw; it0 < DEPTH * I_LAYER; it0 += NGW) {
                    const int ll = it0 / I_LAYER; int it = it0 % I_LAYER;
                    unsigned char* w2 = ws + WS_W + (size_t)ll * W_LAYER;
                    const float* W; const float* gs; bf16* WT; int K, N, Npad, mode = 0;
                    if (it < I_IN) { W = ka->in[4] + (size_t)ll * D * DIN; gs = ka->in[3] + ll * D; WT = (bf16*)(w2 + W_IN); K = D; N = DIN; Npad = DINP; mode = 2; }
                    else if ((it -= I_IN) < I_O) { W = ka->in[18] + (size_t)ll * D * D; gs = ka->in[17] + ll * D; WT = (bf16*)(w2 + W_O); K = D; N = D; Npad = D; }
                    else if ((it -= I_O) < I_UP) { W = ka->in[20] + (size_t)ll * D * 2 * DFF; gs = ka->in[19] + ll * D; WT = (bf16*)(w2 + W_UP); K = D; N = 2 * DFF; Npad = 2 * DFF; mode = 1; }
                    else if ((it -= I_UP) < I_DN) { W = ka->in[23] + (size_t)ll * DFF * D; gs = nullptr; WT = (bf16*)(w2 + W_DN); K = DFF; N = D; Npad = D; }
                    else if ((it -= I_DN) < I_PG) { W = ka->in[25] + (size_t)ll * D * D; gs = ka->in[24] + ll * D; WT = (bf16*)(w2 + W_PG); K = D; N = D; Npad = D; }
                    else if ((it -= I_PG) < I_PP) { W = ka->in[26] + (size_t)ll * PLE * D; gs = nullptr; WT = (bf16*)(w2 + W_PP); K = PLE; N = D; Npad = D; }
                    else if ((it -= I_PP) < I_UQ) { W = ka->in[6] + (size_t)ll * 192 * 384; gs = ka->in[5] + ll * 192; WT = (bf16*)(w2 + W_UQ); K = 192; N = 384; Npad = 384; mode = 3; }
                    else if ((it -= I_UQ) < I_UKV) { W = ka->in[8] + (size_t)ll * 128 * 512; gs = ka->in[7] + ll * 128; WT = (bf16*)(w2 + W_UKV); K = 128; N = 512; Npad = 512; mode = 3; }
                    else { it -= I_UKV; const int mi = it >> 1; it &= 1;
                        W = (mi < 8 ? ka->in[12] : ka->in[14]) + ((size_t)ll * 8 + (mi & 7)) * 4096; gs = nullptr; WT = (bf16*)(w2 + (mi < 8 ? W_R : W_I)) + (size_t)(mi & 7) * 4096; K = 64; N = 64; Npad = 64; mode = 3; }
                    const int nblk = Npad / 32;
                    tr_item(W, K, N, gs, WT, mode, scr, it / nblk, it % nblk, lane);
                }
            }
            const float* x = ka->in[0];
            for (int m = gw; m < M; m += NGW) {
                const GAS f32x4* xr = (const GAS f32x4*)(x + (size_t)m * D) + lane;
                f32x4 v[4]; float s = 0.f;
#pragma unroll
                for (int j = 0; j < 4; ++j) { v[j] = xr[64 * j]; s += (v[j].x * v[j].x + v[j].y * v[j].y) + (v[j].z * v[j].z + v[j].w * v[j].w); }
                s = wave_sum(s, lane);
                GAS unsigned long long* o8 = (GAS unsigned long long*)(HB + (size_t)m * D) + lane;
#pragma unroll
                for (int j = 0; j < 4; ++j) o8[64 * j] = (unsigned long long)pk2(v[j].x, v[j].y) | ((unsigned long long)pk2(v[j].z, v[j].w) << 32);
                if (lane < 4) { f32x4 z4 = {lane == 0 ? s : 0.f, 0.f, 0.f, 0.f}; *(f32x4*)(SSA + (size_t)m * 16 + lane * 4) = z4; }
            }
            {
                float* rope = (float*)(ws + WS_ROPE); const int* pos = (const int*)ka->in[2];
                for (int i = bx * 512 + tid; i < M * 16; i += G * 512) { const int t = i >> 4, f = i & 15;
                    const float ang = (float)pos[t] * __builtin_amdgcn_exp2f(-0.8304820237218406f * (float)f);
                    double rv = (double)ang * 0.15915494309189535; rv -= __builtin_floor(rv); const float fr = (float)rv;
                    rope[2 * i] = __builtin_amdgcn_cosf(fr); rope[2 * i + 1] = __builtin_amdgcn_sinf(fr); }
            }
            {
                float* cwt = (float*)(ws + WS_CWT);
                for (int i = bx * 512 + tid; i < DEPTH * 704 * 32; i += G * 512) {
                    const int e = i & 3, slot = (i >> 2) & 7, jg = (i >> 5) % 704, ll = i / (704 * 32);
                    const int col = (slot < 4 ? 0 : DFF) + 4 * jg + e, k = slot & 3;
                    cwt[i] = (slot < 4 ? -1.4426950408889634f : -0.6931471805599453f) * (k < 3 ? ka->in[21][(size_t)ll * 3 * 2 * DFF + (size_t)k * 2 * DFF + col] : ka->in[22][(size_t)ll * 2 * DFF + col]);
                }
            }
            const float* p = ka->in[1]; bf16* PB = (bf16*)(ws + WS_PB);
            const size_t n8 = (size_t)DEPTH * M * PLE / 8;
            for (size_t i = (size_t)bx * 512 + tid; i < n8; i += (size_t)G * 512) {
                const f32x4 a = *(const f32x4*)(p + i * 8), b = *(const f32x4*)(p + i * 8 + 4);
                v4u o; o.x = pk2(a.x, a.y); o.y = pk2(a.z, a.w); o.z = pk2(b.x, b.y); o.w = pk2(b.z, b.w);
                *(v4u*)(PB + i * 8) = o;
            }
        }
    GRID_BAR(0);
    for (int l = 0; l < DEPTH; ++l) {
        const size_t wl = WS_W + (size_t)l * W_LAYER;
        if ((PH_MASK & (1 << 1)) && IN(8 * l + 1)) { for (int rep_ = 0; rep_ < ((REPEAT_MASK >> 1) & 1) + 1; ++rep_) { if (rep_) { XcdBarrier gb_; gb_.bar = (unsigned*)(kargs()->ws + WS_CTL) + CW_BAR; gb_.x = xb_xcc_id(); gb_.st = (volatile LAS unsigned*)(L + MISC_OFF) + 8; xcd_barrier(gb_); }
            PHASE_PTRS;
            pg8::Gemm g{l == 0 ? (const bf16*)(ws + WS_HB) : (const bf16*)ka->out, (const bf16*)(ws + wl + W_IN), M, DINP, D}; pg8::StatOrder So; So.init(M, DINP, G, bx); So.ss_sel = l; So.row62 = 0; So.wave = wv; So.cwt_layer = 0;
            pg8::EpiZ E{l};
            pg8::gemm_phase<pg8::EpiZ, pg8::StatOrder, true, true, false, D>(L + RING_OFF, g, So, E, wv);
            {
                pg8::Gemm gp{(const bf16*)(ws + WS_PB) + (size_t)l * M * PLE, (const bf16*)(ws + wl + W_PP), M, D, PLE}; pg8::TailOrder To; To.init(M, D, G, bx);
                To.c0 = ((M / 256) * (DINP / 256)) % G; To.u0 = 0; To.u1 = 256; if (To.c0 == 0) To.u1 = 0;
                pg8::EpiPP Ep{0};
                pg8::gemm_phase<pg8::EpiPP, pg8::TailOrder, true, true, false, PLE>(L + RING_OFF, gp, To, Ep, wv); }
        } }
        GRID_BAR(8 * l + 1);
        if ((PH_MASK & (1 << 2)) && IN(8 * l + 2)) { for (int rep_ = 0; rep_ < ((REPEAT_MASK >> 2) & 1) + 1; ++rep_) { if (rep_) { XcdBarrier gb_; gb_.bar = (unsigned*)(kargs()->ws + WS_CTL) + CW_BAR; gb_.x = xb_xcc_id(); gb_.st = (volatile LAS unsigned*)(L + MISC_OFF) + 8; xcd_barrier(gb_); }
            PHASE_PTRS;
            mid::lru_load_table(ka, l, (mid::lptr)L, wv);
            for (int u = vcu; u < 256; ) {
                const KArgs k2 = kargs(); const int b = u >> 5, tt = u & 31;
                int w2 = wv;
                asm volatile("" : "+s"(w2)); mid::p2_latent(k2, l, b * S + 128 * tt, (mid::lptr)(L + RING_OFF), w2);
                asm volatile("" : "+s"(w2)); mid::p2_forget(kargs(), l, b, tt, (mid::lptr)(L + RING_OFF), w2);
                asm volatile("" : "+s"(w2)); mid::lru_pass1(kargs(), l, b, tt, (mid::lptr)(L + RING_OFF), w2);
                int g2 = gridDim.x; asm volatile("" : "+s"(g2)); u += g2;
            }
        } }
        GRID_BAR(8 * l + 2);
        if ((PH_MASK & (1 << 3)) && IN(8 * l + 3)) { for (int rep_ = 0; rep_ < ((REPEAT_MASK >> 3) & 1) + 1; ++rep_) { if (rep_) { XcdBarrier gb_; gb_.bar = (unsigned*)(kargs()->ws + WS_CTL) + CW_BAR; gb_.x = xb_xcc_id(); gb_.st = (volatile LAS unsigned*)(L + MISC_OFF) + 8; xcd_barrier(gb_); }
            PHASE_PTRS;
            for (int v = vcu; v < 256; ) {
                const int stream = v >> 2, s4 = v & 3, mixer = stream & 1, bh = stream >> 1, b = bh >> 2, h = bh & 3;
                if (mixer == 0) {
                    for (int i = 0; i < 2; ++i) {
                        const int qb = (i == 0) ? s4 : 7 - s4;
                        unsigned char* ws = kargs()->ws;
                        att::attn_unit<6, false>((const bf16*)(ws + WS_Q) + (size_t)b * S * 384 + h * 96, 384, (const bf16*)(ws + WS_K) + (size_t)b * S * 384 + h * 96, 384,
                                                 (const bf16*)(ws + WS_V) + (size_t)b * S * 256 + h * 64, 256, (bf16*)(ws + WS_O) + (size_t)b * S * D + h * 64, D, nullptr, 0, qb, (att::lptr)(L + RING_OFF), wv);
                    }
                } else {
                    for (int i = 0; i < 2; ++i) {
                        const int qb = (i == 0) ? s4 : 7 - s4;
                        unsigned char* ws = kargs()->ws;
                        att::attn_unit<4, true>((const bf16*)(ws + WS_Z) + (size_t)b * S * DINP + O_FQ + h * 64, DINP, (const bf16*)(ws + WS_Z) + (size_t)b * S * DINP + O_FK + h * 64, DINP,
                                                (const bf16*)(ws + WS_Z) + (size_t)b * S * DINP + O_FV + h * 64, DINP, (bf16*)(ws + WS_O) + (size_t)b * S * D + 256 + h * 64, D,
                                                (const float*)(ws + WS_CBX) + (size_t)b * 64 * 256, h, qb, (att::lptr)(L + RING_OFF), wv);
                    }
                }
                int g2 = gridDim.x; asm volatile("" : "+s"(g2)); v += g2;
            }
        } }
        GRID_BAR(8 * l + 3);
        if ((PH_MASK & (1 << 4)) && IN(8 * l + 4)) { for (int rep_ = 0; rep_ < ((REPEAT_MASK >> 4) & 1) + 1; ++rep_) { if (rep_) { XcdBarrier gb_; gb_.bar = (unsigned*)(kargs()->ws + WS_CTL) + CW_BAR; gb_.x = xb_xcc_id(); gb_.st = (volatile LAS unsigned*)(L + MISC_OFF) + 8; xcd_barrier(gb_); }
            PHASE_PTRS;
            for (int u = vcu; u < 256; ) {
                const KArgs k2 = kargs(); const int b = u >> 5, tt = u & 31;
                int w2 = wv; asm volatile("" : "+s"(w2)); mid::lru_pass2(k2, l, b, tt, (mid::lptr)(L + RING_OFF), w2);
                __syncthreads();
                int g2 = gridDim.x; asm volatile("" : "+s"(g2)); u += g2;
            }
        } }
        GRID_BAR(8 * l + 4);
        if ((PH_MASK & (1 << 5)) && IN(8 * l + 5)) {
            PHASE_PTRS;
            pg8::Gemm g{(const bf16*)(ws + WS_O), (const bf16*)(ws + wl + W_O), M, D, D}; pg8::StaticOrder So; So.init(M, D, G, bx);
            pg8::EpiRes<0> E{l == 0 ? 0 : 1, 0, l == 0 ? 1 : 0};
            pg8::gemm_phase<pg8::EpiRes<0>, pg8::StaticOrder, true, true, false, D>(L + RING_OFF, g, So, E, wv);
        }
        GRID_BAR(8 * l + 5);
        if ((PH_MASK & (1 << 6)) && IN(8 * l + 6)) { for (int rep_ = 0; rep_ < ((REPEAT_MASK >> 6) & 1) + 1; ++rep_) { if (rep_) { XcdBarrier gb_; gb_.bar = (unsigned*)(kargs()->ws + WS_CTL) + CW_BAR; gb_.x = xb_xcc_id(); gb_.st = (volatile LAS unsigned*)(L + MISC_OFF) + 8; xcd_barrier(gb_); }
            PHASE_PTRS;
            pg8::Gemm g{(const bf16*)(ws + WS_HB) - 2 * D, (const bf16*)(ws + wl + W_UP), 133 * 256, 2 * DFF, D}; pg8::StatOrder So; So.init(133 * 256, 2 * DFF, G, bx); So.ss_sel = l == 0 ? 1 : 0; So.row62 = 1; So.wave = wv; So.cwt_layer = l;
            pg8::EpiUp E{l, l == 0 ? 1 : 0};
            pg8::gemm_phase<pg8::EpiUp, pg8::StatOrder, true, true, true, D>(L + RING_OFF, g, So, E, wv);
            {   pg8::Gemm gp{(const bf16*)(ws + WS_PB) + (size_t)l * M * PLE, (const bf16*)(ws + wl + W_PP), M, D, PLE}; pg8::TailOrder To; To.init(M, D, G, bx);
                To.c0 = (133 * (2 * DFF / 256)) % G; To.u0 = (((M / 256) * (DINP / 256)) % G) ? 256 : 0; To.u1 = 512;
                pg8::EpiPP Ep{0};
                pg8::gemm_phase<pg8::EpiPP, pg8::TailOrder, true, true, false, PLE>(L + RING_OFF, gp, To, Ep, wv); }
        } }
        GRID_BAR(8 * l + 6);
        if ((PH_MASK & (1 << 7)) && IN(8 * l + 7)) {
            PHASE_PTRS;
            pg8::Gemm g{(const bf16*)(ws + WS_ACT), (const bf16*)(ws + wl + W_DN), M, D, DFF}; pg8::StaticOrder So; So.init(M, D, G, bx);
            pg8::EpiRes<0> E{0, 0, l == 0 ? 0 : 1};
            pg8::gemm_phase<pg8::EpiRes<0>, pg8::StaticOrder, true, true, false, DFF>(L + RING_OFF, g, So, E, wv);
        }
        GRID_BAR(8 * l + 7);
        if ((PH_MASK & (1 << 8)) && IN(8 * l + 8)) {
            PHASE_PTRS;
            {   pg8::Gemm g{(const bf16*)(ws + WS_HB), (const bf16*)(ws + wl + W_PG), M, D, D}; pg8::StatOrder So; So.init(M, D, G, bx); So.ss_sel = l == 0 ? 0 : 1; So.row62 = 0; So.wave = wv; So.cwt_layer = 0;
                pg8::EpiRes<1> E{0, l == 0 ? 1 : 2, l == 0 ? 1 : 0};
                pg8::gemm_phase<pg8::EpiRes<1>, pg8::StatOrder, true, true, false, D>(L + RING_OFF, g, So, E, wv); }
        }
        GRID_BAR(8 * l + 8);
    }
    if ((PH_MASK & (1 << 17)) && IN(17)) {
            PHASE_PTRS; LANE_IDS; const float* gf = ka->in[27]; const float* ss = (const float*)(ws + WS_SSA); float* H = ka->out;
            const bf16* hb = (const bf16*)(ws + WS_O);
            for (int m = gw; m < M; m += NGW) {
                const float rs = pg8::rstd16(ss, m);
#pragma unroll
                for (int j = 0; j < 2; ++j) { const v4u w = *((const GAS v4u*)(hb + (size_t)m * D) + lane + 64 * j); const int c0 = (lane + 64 * j) * 8;
                    const f32x4 g0 = *(const GAS f32x4*)(gf + c0), g1 = *(const GAS f32x4*)(gf + c0 + 4);
                    f32x4 o0 = {pg8::bf_lo(w.x), pg8::bf_hi(w.x), pg8::bf_lo(w.y), pg8::bf_hi(w.y)}, o1 = {pg8::bf_lo(w.z), pg8::bf_hi(w.z), pg8::bf_lo(w.w), pg8::bf_hi(w.w)};
                    o0 = o0 * rs * g0; o1 = o1 * rs * g1;
                    *(GAS f32x4*)(H + (size_t)m * D + c0) = o0; *(GAS f32x4*)(H + (size_t)m * D + c0 + 4) = o1; }
            }
    }
}

extern "C" void kernel_launch(void* const* d_in, const int* in_sizes, int n_in, void* d_out, int out_size, void* d_ws, size_t ws_size, hipStream_t stream) {
    static int grid = 0;
    if (grid == 0) {
        int dev = 0, cus = 0;
        if (hipGetDevice(&dev) != hipSuccess || hipDeviceGetAttribute(&cus, hipDeviceAttributeMultiprocessorCount, dev) != hipSuccess) { grid = -1; return; }
        if (hipFuncSetAttribute((const void*)mega, hipFuncAttributeMaxDynamicSharedMemorySize, LDS_BYTES) != hipSuccess) { fprintf(stderr, "hipFuncSetAttribute failed\n"); grid = -1; return; }
        grid = cus;
        if (ws_size < WS_END) { fprintf(stderr, "workspace too small: %zu < %zu\n", ws_size, (size_t)WS_END); grid = -1; return; }
    }
    if (grid < 0) return;
    (void)hipMemsetAsync((char*)d_ws + WS_CTL, 0, CTL_ZERO_BYTES, stream);
    Args a{};
    for (int i = 0; i < 28; ++i) a.in[i] = (const float*)d_in[i];
    a.out = (float*)d_out; a.ws = (unsigned char*)d_ws;
#ifndef N_LAUNCH_MODE
#define N_LAUNCH_MODE 1
#endif
    auto run = [&](int lo, int hi) { a.ph_lo = lo; a.ph_hi = hi; hipLaunchKernelGGL(mega, dim3(grid), dim3(NWAVES * 64), LDS_BYTES, stream, a); };
    if (N_LAUNCH_MODE == 1) run(0, 18);
    else for (int ph = 0; ph < 18; ++ph) run(ph, ph + 1);
}
```

```cpp
#include <hip/hip_runtime.h>
#include <cstdio>
#include <cstdint>
#include <math.h>
constexpr int D = 1024, NB = 8, S = 4096, DEPTH = 2, PLE = 256, M = NB * S;
constexpr int DIN = 2148, DINP = 2304;
constexpr int O_QC = 0, O_KVC = 192, O_KR = 320, O_FQ = 352, O_FK = 608, O_FV = 864, O_LX = 1120, O_LG = 1632, O_FL = 2144;
constexpr int DFF = 2816, LRU_W = 512;
constexpr float EPS = 1e-6f;
constexpr int NWAVES = 8;
constexpr size_t MiB = 1u << 20;
constexpr size_t WS_CTL = 0, CTL_ZERO_BYTES = 1 * MiB;
constexpr size_t WS_SSA = 1 * MiB, WS_SSB = 3 * MiB, WS_FL = 5 * MiB, WS_CBX = 5632 * 1024, WS_CWT = 6 * MiB, WS_LRUSUM = 6656 * 1024, WS_ROPE = 7680 * 1024;
constexpr size_t WS_W = 12 * MiB, W_LAYER = 27 * MiB;
constexpr size_t W_IN = 0, W_UQ = 4608 * 1024, W_UKV = 4864 * 1024, W_R = 5120 * 1024, W_I = 5184 * 1024, W_O = 5632 * 1024, W_UP = 7680 * 1024, W_DN = 18944 * 1024, W_PG = 24576 * 1024, W_PP = 26624 * 1024;
constexpr size_t WS_HB = 68 * MiB;
constexpr size_t WS_PB = 133 * MiB;
constexpr size_t WS_PP = 165 * MiB;
constexpr size_t WS_Z = 229 * MiB;
constexpr size_t WS_Q = 373 * MiB, WS_K = 397 * MiB, WS_V = 421 * MiB;
constexpr size_t WS_O = 437 * MiB;
constexpr size_t WS_ACT = 229 * MiB;
constexpr size_t WS_END = 501 * MiB;
static_assert(WS_ACT + (size_t)M * DFF * 2 <= WS_O && WS_O + (size_t)M * D * 2 <= WS_END && WS_W + 2 * W_LAYER <= WS_HB - MiB && WS_HB + (size_t)(M + 256) * D * 2 <= WS_PB, "ws map");
constexpr int CW_BAR = 4096;
constexpr int RING_OFF = 0, RING_BYTES = 131072;
constexpr int LDSCTL_OFF = RING_BYTES, MISC_OFF = LDSCTL_OFF + 320;
constexpr int LDS_BYTES = 163840, LRU_TAB_OFF = 147456;

struct Args { const float* in[28]; float* out; unsigned char* ws; int ph_lo, ph_hi, pad0, pad1; };


typedef const __attribute__((address_space(4))) Args* KArgs;
__device__ __forceinline__ KArgs kargs() { KArgs p = (KArgs)__builtin_amdgcn_kernarg_segment_ptr(); asm volatile("" : "+s"(p)); return p; }
__device__ __forceinline__ int lane_id() { int r; asm volatile("v_mbcnt_lo_u32_b32 %0, -1, 0\n\tv_mbcnt_hi_u32_b32 %0, -1, %0" : "=v"(r)); return r; }
__device__ __forceinline__ float lshfl(float v, int src_lane) { return __builtin_bit_cast(float, __builtin_amdgcn_ds_bpermute(src_lane << 2, __builtin_bit_cast(int, v))); }
__device__ __forceinline__ double lshfl(double v, int src_lane) { const unsigned long long u = __builtin_bit_cast(unsigned long long, v);
    const unsigned lo = (unsigned)__builtin_amdgcn_ds_bpermute(src_lane << 2, (int)(unsigned)u), hi = (unsigned)__builtin_amdgcn_ds_bpermute(src_lane << 2, (int)(unsigned)(u >> 32));
    return __builtin_bit_cast(double, ((unsigned long long)hi << 32) | lo); }
__device__ __forceinline__ float wave_sum(float v, int lane) {
#pragma unroll
    for (int o = 1; o < 64; o <<= 1) v += lshfl(v, lane ^ o);
    return v;
}
namespace pg8 {
#define PG8_LAS __attribute__((address_space(3)))
typedef unsigned short bf16_t;
typedef short bf16x8 __attribute__((ext_vector_type(8)));
typedef float f32x4 __attribute__((ext_vector_type(4)));
typedef unsigned u32x4 __attribute__((ext_vector_type(4)));
constexpr int BM = 256, BK = 64, HALF = 128, HTB = HALF * BK * 2  , STAGE_BYTES = 8 * HTB, NXCD = 8, WGM = 8;

__host__ __device__ __forceinline__ int lds_byte(int r, int c) { const int st = (r >> 4) * 2 + (c >> 5), rr = r & 15, cc = c & 31, ob = rr * 64 + cc * 2; return st * 1024 + (ob ^ (((ob >> 9) & 1) << 5)); }
__host__ __device__ __forceinline__ void stage_rc(int b, int& R, int& C) { const int st = b / 1024, sb = b % 1024, swz = sb ^ (((sb >> 9) & 1) << 5); R = (st >> 1) * 16 + swz / 64; C = (st & 1) * 32 + (swz % 64) / 2; }
__host__ __device__ __forceinline__ int perm32(int rho) { const int n = rho >> 4, i = rho & 15; return 8 * (i >> 2) + 4 * n + (i & 3); }

struct Unit { int pm, pn, par; };
struct Gemm { const bf16_t* A; const bf16_t* Bt; int M, N, K; };

struct StaticOrder {
    int nM, nN, nwg, G, c;
    __host__ __device__ void init(int M, int N, int G_, int c_) { nM = M / BM; nN = N / BM; nwg = nM * nN; G = G_; c = c_; }
    __host__ __device__ bool next(int i, Unit& u) const {
        const long L = (long)i * G + c; if (L >= nwg) return false;
        int wgid = (int)L; { const int q = nwg / NXCD, r = nwg % NXCD, xcd = wgid % NXCD, off = wgid / NXCD; wgid = (xcd < r ? xcd * (q + 1) : r * (q + 1) + (xcd - r) * q) + off; }
        const int nig = WGM * nN, gid = wgid / nig, fm = gid * WGM, gsz = (nM - fm) < WGM ? (nM - fm) : WGM;
        u.pm = fm + ((wgid % nig) % gsz); u.pn = (wgid % nig) / gsz; u.par = i & 1; return true;
    }
    __device__ __forceinline__ void a_ready(const Unit&) const {}
    __device__ __forceinline__ void done(const Unit&) const {}
};
struct TailOrder : StaticOrder {
    int c0, u0, u1;
    __host__ __device__ bool next(int i, Unit& u) const {
        if (c < c0) return false;
        const int Lu = u0 + i * (G - c0) + (c - c0); if (Lu >= u1) return false;
        u.pm = Lu / nN; u.pn = Lu % nN; u.par = i & 1; return true;
    }
};
constexpr int RSTD_TBL_OFF = 131072 + 1024;
constexpr int CWT_TBL_OFF = RSTD_TBL_OFF + 2048;
struct StatOrder : StaticOrder {
    int ss_sel, row62, wave, cwt_layer;
    __device__ __forceinline__ void a_ready(const Unit& u) const {
        if (wave < 4) { const int t = wave * 64 + lane_id();
            int row = row62 ? 248 * u.pm + 62 * (t >> 6) + (4 * (t & 15) + ((t >> 4) & 3)) - 2 : BM * u.pm + t; row = row < 0 ? 0 : (row > 32767 ? 32767 : row);
            const f32x4* p = (const f32x4*)((const float*)(kargs()->ws + (ss_sel ? WS_SSB : WS_SSA)) + (size_t)row * 16);
            const f32x4 a = p[0], b = p[1], c = p[2], d = p[3];
            const float s = (((a[0] + a[1]) + (a[2] + a[3])) + ((b[0] + b[1]) + (b[2] + b[3]))) + (((c[0] + c[1]) + (c[2] + c[3])) + ((d[0] + d[1]) + (d[2] + d[3])));
            ((PG8_LAS float*)(uintptr_t)RSTD_TBL_OFF)[u.par * 256 + t] = rsqrtf(s * (1.0f / 1024.0f) + 1e-6f); }
        else if (row62) { const int t = (wave - 4) * 64 + lane_id();
            const u32x4 v = *(const u32x4*)(kargs()->ws + WS_CWT + (size_t)cwt_layer * 90112 + (size_t)u.pn * 4096 + t * 16);
            *(PG8_LAS u32x4*)(uintptr_t)(CWT_TBL_OFF + u.par * 4096 + t * 16) = v; }
    }
};
__device__ __forceinline__ float rstd_tbl(const Unit& u, int row_in_tile) { return ((const PG8_LAS float*)(uintptr_t)RSTD_TBL_OFF)[u.par * 256 + row_in_tile]; }
typedef __bf16 bf2_t __attribute__((ext_vector_type(2)));
typedef float fl2_t __attribute__((ext_vector_type(2)));
__device__ __forceinline__ unsigned cvt_pk_bf16(float lo, float hi) { const fl2_t v = {lo, hi}; return __builtin_bit_cast(unsigned, __builtin_convertvector(v, bf2_t)); }
typedef float f32x2 __attribute__((ext_vector_type(2)));
__device__ __forceinline__ f32x2 gelu_pk(f32x2 v) {
    const f32x2 av = __builtin_elementwise_abs(v), d = av * 0.2316418882f + 1.0f;
    f32x2 t; t.x = __builtin_amdgcn_rcpf(d.x); t.y = __builtin_amdgcn_rcpf(d.y);
    f32x2 q = t * 0.5307027145f + (-0.7265760135f); q = q * t + 0.7107068705f; q = q * t + (-0.142248368f); q = q * t + 0.127414796f; q = q * t;
    const f32x2 s = (v * v) * (-0.72134752044f);
    f32x2 e; e.x = __builtin_amdgcn_exp2f(s.x); e.y = __builtin_amdgcn_exp2f(s.y);
    const f32x2 m = v * (q * e), r = v - m;
    f32x2 o; o.x = v.x < 0.f ? m.x : r.x; o.y = v.y < 0.f ? m.y : r.y; return o;
}
template <int ACT  > struct EpiBf16 {
    static constexpr bool PERM = true, AFTER_DRAIN = false; static_assert(ACT == 0 || ACT == 1, "EpiBf16: ACT is 0 (none) or 1 (gelu_pk)");
    bf16_t* O; int ldc; const float* bias; int split_cols; size_t split_stride; float scale0;
    __device__ __forceinline__ void operator()(const f32x4 (&acc)[2][2][4][2], const Unit& u, int wr, int wc, int fr, int fq) const {
        const int row0 = u.pm * BM + wr * 64 + fr; int colt = u.pn * BM; bf16_t* base = O;
        float sc = 1.f; if (split_cols) { const int t = colt / split_cols; base += (size_t)t * split_stride; colt -= t * split_cols; if (t == 0) sc = scale0; }
        const int col0 = colt + wc * 32 + 8 * fq, bcol0 = u.pn * BM + wc * 32 + 8 * fq;
        f32x4 bv[2][2];
#pragma unroll
        for (int bj = 0; bj < 2; ++bj)
#pragma unroll
            for (int n = 0; n < 2; ++n) bv[bj][n] = bias ? *(const f32x4*)(bias + bcol0 + bj * HALF + 4 * n) : (f32x4){0.f, 0.f, 0.f, 0.f};
#pragma unroll
        for (int ai = 0; ai < 2; ++ai)
#pragma unroll
            for (int m = 0; m < 4; ++m) { bf16_t* rowp = base + (size_t)(row0 + ai * HALF + m * 16) * ldc + col0;
#pragma unroll
                for (int bj = 0; bj < 2; ++bj) { f32x4 v0 = acc[ai][bj][m][0] + bv[bj][0], v1 = acc[ai][bj][m][1] + bv[bj][1];
                    if (ACT == 1) { f32x2 a = gelu_pk((f32x2){v0[0], v0[1]}), b = gelu_pk((f32x2){v0[2], v0[3]}), c = gelu_pk((f32x2){v1[0], v1[1]}), d = gelu_pk((f32x2){v1[2], v1[3]});
                        v0 = (f32x4){a.x, a.y, b.x, b.y}; v1 = (f32x4){c.x, c.y, d.x, d.y}; }
                    v0 = v0 * sc; v1 = v1 * sc; u32x4 w; w.x = cvt_pk_bf16(v0[0], v0[1]); w.y = cvt_pk_bf16(v0[2], v0[3]); w.z = cvt_pk_bf16(v1[0], v1[1]); w.w = cvt_pk_bf16(v1[2], v1[3]);
                    *(u32x4*)(rowp + bj * HALF) = w; } }
    }
};


constexpr float RMS_EPS = 1e-6f;
constexpr int TOK = 32768;
typedef unsigned u32x2 __attribute__((ext_vector_type(2)));
__device__ __forceinline__ float rstd16(const float* SS, int row) {
    const f32x4* p = (const f32x4*)(SS + (size_t)row * 16);
    const f32x4 a = p[0], b = p[1], c = p[2], d = p[3];
    const float s = (((a[0] + a[1]) + (a[2] + a[3])) + ((b[0] + b[1]) + (b[2] + b[3]))) + (((c[0] + c[1]) + (c[2] + c[3])) + ((d[0] + d[1]) + (d[2] + d[3])));
    return rsqrtf(s * (1.0f / 1024.0f) + RMS_EPS);
}
__device__ __forceinline__ float bf_lo(unsigned w) { return __uint_as_float(w << 16); }
__device__ __forceinline__ float bf_hi(unsigned w) { return __uint_as_float(w & 0xffff0000u); }
struct EpiPlain {
    static constexpr bool PERM = true, AFTER_DRAIN = false;
    size_t ws_off; int ldc;
    __device__ __forceinline__ void operator()(const f32x4 (&acc)[2][2][4][2], const Unit& u, int wr, int wc, int fr_, int fq_) const {
        int lane_ = lane_id(); asm volatile("" : "+v"(lane_)); const int fr = lane_ & 15, fq = lane_ >> 4;
        const KArgs ka = kargs(); bf16_t* O = (bf16_t*)(ka->ws + ws_off);
        const int row0 = u.pm * BM + wr * 64 + fr, col0 = u.pn * BM + wc * 32 + 8 * fq;
#pragma unroll
        for (int ai = 0; ai < 2; ++ai)
#pragma unroll
            for (int m = 0; m < 4; ++m) { bf16_t* rowp = O + (size_t)(row0 + ai * HALF + m * 16) * ldc + col0;
#pragma unroll
                for (int bj = 0; bj < 2; ++bj) { const f32x4 v0 = acc[ai][bj][m][0], v1 = acc[ai][bj][m][1];
                    u32x4 w; w.x = cvt_pk_bf16(v0[0], v0[1]); w.y = cvt_pk_bf16(v0[2], v0[3]); w.z = cvt_pk_bf16(v1[0], v1[1]); w.w = cvt_pk_bf16(v1[2], v1[3]);
                    *(u32x4*)(rowp + bj * HALF) = w; } }
    }
};
struct EpiPP {
    static constexpr bool PERM = true, AFTER_DRAIN = false;
    int pad;
    __device__ __forceinline__ void operator()(const f32x4 (&acc)[2][2][4][2], const Unit& u, int wr, int wc, int fr_, int fq_) const {
        int lane_ = lane_id(); asm volatile("" : "+v"(lane_)); const int fr = lane_ & 15, fq = lane_ >> 4;
        const KArgs ka = kargs(); bf16_t* O = (bf16_t*)ka->out + (size_t)32768 * 1024;
        const int row0 = u.pm * BM + wr * 64 + fr, col0 = u.pn * BM + wc * 32 + 8 * fq;
#pragma unroll
        for (int ai = 0; ai < 2; ++ai)
#pragma unroll
            for (int m = 0; m < 4; ++m) { bf16_t* rowp = O + (size_t)(row0 + ai * HALF + m * 16) * 1024 + col0;
#pragma unroll
                for (int bj = 0; bj < 2; ++bj) { const f32x4 v0 = acc[ai][bj][m][0], v1 = acc[ai][bj][m][1];
                    u32x4 w; w.x = cvt_pk_bf16(v0[0], v0[1]); w.y = cvt_pk_bf16(v0[2], v0[3]); w.z = cvt_pk_bf16(v1[0], v1[1]); w.w = cvt_pk_bf16(v1[2], v1[3]);
                    *(u32x4*)(rowp + bj * HALF) = w; } }
    }
};
struct EpiZ {
    static constexpr bool PERM = true, AFTER_DRAIN = false;
    int ss_sel;
    __device__ __forceinline__ void operator()(const f32x4 (&acc)[2][2][4][2], const Unit& u, int wr, int wc, int fr_, int fq_) const {
        int lane_ = lane_id(); asm volatile("" : "+v"(lane_)); const int fr = lane_ & 15, fq = lane_ >> 4;
        const KArgs ka = kargs(); unsigned char* ws = ka->ws;
        bf16_t* Z = (bf16_t*)(ws + WS_Z); const float* SS = (const float*)(ws + (ss_sel ? WS_SSB : WS_SSA)); float* FL = (float*)(ws + WS_FL);
        const int row0 = u.pm * BM + wr * 64 + fr, col0 = u.pn * BM + wc * 32 + 8 * fq;
        const bool fl = (u.pn == 8) && (wc == 3) && (fq == 0);
#pragma unroll
        for (int ai = 0; ai < 2; ++ai)
#pragma unroll
            for (int m = 0; m < 4; ++m) { const int row = row0 + ai * HALF + m * 16; const float rs = rstd_tbl(u, ai * HALF + wr * 64 + m * 16 + fr); bf16_t* rowp = Z + (size_t)row * 2304 + col0;
#pragma unroll
                for (int bj = 0; bj < 2; ++bj) { const int g32 = (u.pn * BM + bj * HALF + wc * 32) >> 5;
                    const float rq = (g32 >= 11 && g32 < 19) ? rs * 0.18033688011112042f : rs;
                    const f32x4 v0 = acc[ai][bj][m][0] * rq, v1 = acc[ai][bj][m][1] * rq;
                    u32x4 w; w.x = cvt_pk_bf16(v0[0], v0[1]); w.y = cvt_pk_bf16(v0[2], v0[3]); w.z = cvt_pk_bf16(v1[0], v1[1]); w.w = cvt_pk_bf16(v1[2], v1[3]);
                    *(u32x4*)(rowp + bj * HALF) = w; }
                if (fl) *(f32x4*)(FL + (size_t)row * 4) = acc[ai][0][m][0] * rs; asm volatile("" ::: "memory"); }
    }
};
__device__ __forceinline__ float quad16_sum(float x) {
    auto s = __builtin_amdgcn_permlane16_swap(__float_as_uint(x), __float_as_uint(x), false, false); x = __uint_as_float(s[0]) + __uint_as_float(s[1]);
    auto t = __builtin_amdgcn_permlane32_swap(__float_as_uint(x), __float_as_uint(x), false, false); return __uint_as_float(t[0]) + __uint_as_float(t[1]);
}
template <int MODE> struct EpiRes {
    static constexpr bool PERM = true, AFTER_DRAIN = false;
    int r_src;
    int o_dst;
    int sso_sel;
    __device__ __forceinline__ void operator()(const f32x4 (&acc)[2][2][4][2], const Unit& u, int wr, int wc, int fr_, int fq_) const {
        int lane_ = lane_id(); asm volatile("" : "+v"(lane_)); const int fr = lane_ & 15, fq = lane_ >> 4;
        const KArgs ka = kargs(); unsigned char* ws = ka->ws;
        const bf16_t* R = r_src ? (const bf16_t*)ka->out : (const bf16_t*)(ws + WS_HB);
        bf16_t* HBo = o_dst == 0 ? (bf16_t*)(ws + WS_HB) : (o_dst == 1 ? (bf16_t*)ka->out : (bf16_t*)(ws + WS_O)); float* SSo = (float*)(ws + (sso_sel ? WS_SSB : WS_SSA));
        const float* SSi = (const float*)(ws + (sso_sel ? WS_SSA : WS_SSB)); const bf16_t* PP = (const bf16_t*)ka->out + (size_t)32768 * 1024;
        const int row0 = u.pm * BM + wr * 64 + fr, col0 = u.pn * BM + wc * 32 + 8 * fq;
#pragma unroll
        for (int ai = 0; ai < 2; ++ai) {
            u32x4 rwv[4][2], pwv[4][2];
#pragma unroll
            for (int m = 0; m < 4; ++m)
#pragma unroll
                for (int bj = 0; bj < 2; ++bj) { const size_t off = (size_t)(row0 + ai * HALF + m * 16) * 1024 + col0 + bj * HALF; rwv[m][bj] = *(const u32x4*)(R + off); if (MODE == 1) pwv[m][bj] = *(const u32x4*)(PP + off); }
            asm volatile("" ::: "memory");
#pragma unroll
            for (int m = 0; m < 4; ++m) { const int row = row0 + ai * HALF + m * 16; const size_t off = (size_t)row * 1024 + col0; float q = 0.f;
                float rs = 1.f; if (MODE == 1) rs = rstd_tbl(u, ai * HALF + wr * 64 + m * 16 + fr);
#pragma unroll
                for (int bj = 0; bj < 2; ++bj) { const u32x4 rw = rwv[m][bj]; f32x4 o0 = {bf_lo(rw.x), bf_hi(rw.x), bf_lo(rw.y), bf_hi(rw.y)}, o1 = {bf_lo(rw.z), bf_hi(rw.z), bf_lo(rw.w), bf_hi(rw.w)};
                    if (MODE == 0) { o0 = o0 + acc[ai][bj][m][0]; o1 = o1 + acc[ai][bj][m][1]; }
                    else { const f32x4 g0 = acc[ai][bj][m][0] * rs, g1 = acc[ai][bj][m][1] * rs; const u32x4 pw = pwv[m][bj];
                        o0[0] += bf_lo(pw.x) * __builtin_amdgcn_rcpf(1.f + __expf(-g0[0])); o0[1] += bf_hi(pw.x) * __builtin_amdgcn_rcpf(1.f + __expf(-g0[1])); o0[2] += bf_lo(pw.y) * __builtin_amdgcn_rcpf(1.f + __expf(-g0[2])); o0[3] += bf_hi(pw.y) * __builtin_amdgcn_rcpf(1.f + __expf(-g0[3]));
                        o1[0] += bf_lo(pw.z) * __builtin_amdgcn_rcpf(1.f + __expf(-g1[0])); o1[1] += bf_hi(pw.z) * __builtin_amdgcn_rcpf(1.f + __expf(-g1[1])); o1[2] += bf_lo(pw.w) * __builtin_amdgcn_rcpf(1.f + __expf(-g1[2])); o1[3] += bf_hi(pw.w) * __builtin_amdgcn_rcpf(1.f + __expf(-g1[3])); }
                    u32x4 w; w.x = cvt_pk_bf16(o0[0], o0[1]); w.y = cvt_pk_bf16(o0[2], o0[3]); w.z = cvt_pk_bf16(o1[0], o1[1]); w.w = cvt_pk_bf16(o1[2], o1[3]);
                    *(u32x4*)(HBo + off + bj * HALF) = w;
                    const float a0 = bf_lo(w.x), a1 = bf_hi(w.x), a2 = bf_lo(w.y), a3 = bf_hi(w.y), a4 = bf_lo(w.z), a5 = bf_hi(w.z), a6 = bf_lo(w.w), a7 = bf_hi(w.w);
                    q += ((a0 * a0 + a1 * a1) + (a2 * a2 + a3 * a3)) + ((a4 * a4 + a5 * a5) + (a6 * a6 + a7 * a7)); }
                q = quad16_sum(q);
                if (fq == 0) SSo[(size_t)row * 16 + u.pn * 4 + wc] = q; }
            asm volatile("" ::: "memory"); }
    }
};
template <int CTRL> __device__ __forceinline__ float dppf(float x) { return __builtin_bit_cast(float, __builtin_amdgcn_update_dpp(0, __builtin_bit_cast(int, x), CTRL, 0xf, 0xf, false)); }
struct EpiUp {
    static constexpr bool PERM = true, AFTER_DRAIN = false;
    int layer, ss_sel;
#define EPIUP_FMAC_DPP(y, x, w, CTRL) asm volatile("v_fmac_f32_dpp %0, %1, %2 " CTRL " row_mask:0xf bank_mask:0xf" : "+v"(y) : "v"(x), "v"(w))
    template <bool SEQ> __device__ __forceinline__ void conv(f32x4 (&x)[4][2], int n, int tb  , unsigned cwt  , bool silu) const {
        const f32x4 w0 = *(const PG8_LAS f32x4*)(uintptr_t)cwt, w1 = *(const PG8_LAS f32x4*)(uintptr_t)(cwt + 16), w2 = *(const PG8_LAS f32x4*)(uintptr_t)(cwt + 32), b = *(const PG8_LAS f32x4*)(uintptr_t)(cwt + 48);
        float k1[4] = {1.f, 1.f, 1.f, 1.f}, k2[4] = {1.f, 1.f, 1.f, 1.f};
        if (SEQ) {
#pragma unroll
            for (int m = 0; m < 4; ++m) { const int tpos = (tb + m) & 4095; k1[m] = tpos < 1 ? 0.f : 1.f; k2[m] = tpos < 2 ? 0.f : 1.f; } }
#pragma unroll
        for (int e = 0; e < 4; ++e) {
            const float x0 = x[0][n][e], x1 = x[1][n][e], x2 = x[2][n][e], x3 = x[3][n][e];
            float yv[4];
            { float y = b[e] + w2[e] * x0; const float a1 = SEQ ? w1[e] * k1[0] : w1[e], a0 = SEQ ? w0[e] * k2[0] : w0[e];
              EPIUP_FMAC_DPP(y, x3, a1, "row_shr:1"); EPIUP_FMAC_DPP(y, x2, a0, "row_shr:1"); yv[0] = y; }
            { float y = b[e] + w2[e] * x1; y += (SEQ ? w1[e] * k1[1] : w1[e]) * x0; const float a0 = SEQ ? w0[e] * k2[1] : w0[e];
              EPIUP_FMAC_DPP(y, x3, a0, "row_shr:1"); yv[1] = y; }
            yv[2] = b[e] + w2[e] * x2 + (SEQ ? w1[e] * k1[2] : w1[e]) * x1 + (SEQ ? w0[e] * k2[2] : w0[e]) * x0;
            yv[3] = b[e] + w2[e] * x3 + (SEQ ? w1[e] * k1[3] : w1[e]) * x2 + (SEQ ? w0[e] * k2[3] : w0[e]) * x1;
            if (silu) {
                float t[4];
#pragma unroll
                for (int m = 0; m < 4; ++m) t[m] = __builtin_amdgcn_exp2f(yv[m]);
#pragma unroll
                for (int m = 0; m < 4; ++m) t[m] = 1.f + t[m];
#pragma unroll
                for (int m = 0; m < 4; ++m) t[m] = __builtin_amdgcn_rcpf(t[m]);
#pragma unroll
                for (int m = 0; m < 4; ++m) yv[m] *= t[m]; }
#pragma unroll
            for (int m = 0; m < 4; ++m) x[m][n][e] = yv[m]; }
    }
    __device__ __forceinline__ void operator()(f32x4 (&acc)[2][2][4][2], const Unit& u, int wr, int wc, int fr_, int fq_) const {
        int lane_ = lane_id(); asm volatile("" : "+v"(lane_));
        const int fr = lane_ & 15, fq = lane_ >> 4;
        const KArgs ka = kargs(); unsigned char* ws = ka->ws;
        char* ACT = (char*)(ws + WS_ACT);
        const unsigned j0 = 128 * u.pn + 32 * wc + 8 * fq;
        const unsigned cw0 = CWT_TBL_OFF + u.par * 4096 + (8 * wc + 2 * fq) * 128;
#pragma unroll
        for (int ai = 0; ai < 2; ++ai) {
            asm volatile("" ::: "memory");
            const int tb0 = 248 * u.pm + 62 * (2 * ai + wr) - 2;
            const int tb = tb0 + 4 * fr;
#pragma unroll
            for (int m = 0; m < 4; ++m) { const float rs = rstd_tbl(u, ai * HALF + wr * 64 + m * 16 + fr);
#pragma unroll
                for (int bj = 0; bj < 2; ++bj)
#pragma unroll
                    for (int n = 0; n < 2; ++n) acc[ai][bj][m][n] = acc[ai][bj][m][n] * rs; }
            const bool seq = ((tb0 + 63) & 4095) < 65;
#pragma unroll
            for (int n = 0; n < 2; ++n) {
                __builtin_amdgcn_sched_barrier(0);
                if (seq) { conv<true>(acc[ai][0], n, tb, cw0 + n * 128, true); conv<true>(acc[ai][1], n, tb, cw0 + n * 128 + 64, false); }
                else { conv<false>(acc[ai][0], n, tb, cw0 + n * 128, true); __builtin_amdgcn_sched_barrier(0); conv<false>(acc[ai][1], n, tb, cw0 + n * 128 + 64, false); }
            }
#pragma unroll
            for (int m = 0; m < 4; ++m) { const int tok = tb + m; const f32x4 a0 = acc[ai][0][m][0] * acc[ai][1][m][0], a1 = acc[ai][0][m][1] * acc[ai][1][m][1];
                u32x4 w; w.x = cvt_pk_bf16(a0[0], a0[1]); w.y = cvt_pk_bf16(a0[2], a0[3]); w.z = cvt_pk_bf16(a1[0], a1[1]); w.w = cvt_pk_bf16(a1[2], a1[3]);
                if (4 * fr + m >= 2 && tok < TOK) *(u32x4*)(ACT + ((unsigned)tok * 5632u + j0 * 2u)) = w; }
            asm volatile("" ::: "memory");
        }
    }
#undef EPIUP_FMAC_DPP
};

template <class Epi, class Sched, bool ALIGN_EPI = false, bool SP2 = false, bool ROW62 = false, int KC = 0>
__device__ __forceinline__ void gemm_phase(PG8_LAS unsigned char* lds, const Gemm g, const Sched& S, const Epi& E, int wave_id) {
    int lane_ = lane_id(); asm volatile("" : "+v"(lane_));
    const int wid = wave_id, lane = lane_, tid = wid * 64 + lane, wr = wid >> 2, wc = wid & 3, fr = lane & 15, fq = lane >> 4;
    const int K = KC ? KC : g.K, nt = K / BK;
    unsigned voffA, voffB;
    { int R, C; stage_rc(tid * 16, R, C); const int Rb = Epi::PERM ? ((R & ~31) + perm32(R & 31)) : R; const int Ra = ROW62 ? 4 * (R & 15) + (R >> 4) : R;
      voffA = (unsigned)(Ra * K + C) * 2u; voffB = (unsigned)(Rb * K + C) * 2u; }
    const size_t dltA = (size_t)(ROW62 ? 62 : 64) * K * 2, dltB = (size_t)64 * K * 2;
    const size_t kstep = (size_t)(BK * 2);
    const size_t hstepB = (size_t)HALF * K * 2; const size_t hstepA = ROW62 ? (size_t)124 * K * 2 : hstepB;
    const size_t tstepB = 2 * hstepB, tstepA = 2 * hstepA;
    const unsigned ldsw = (unsigned)wid * 1024u;
    const int aoff = lds_byte(wr * 64 + fr, fq * 8), boff = lds_byte(wc * 32 + fr, fq * 8);
#define PG8_SA(b, h) (((b) * 2 + (h)) * HTB)
#define PG8_SB(b, h) ((4 + (b) * 2 + (h)) * HTB)
#define PG8_STAGE(bufoff, gbase, voff) do { _Pragma("unroll") for (int _i = 0; _i < 2; ++_i) \
        __builtin_amdgcn_global_load_lds((const unsigned*)((const char*)(gbase) + _i * dlt_##voff + voff), (PG8_LAS unsigned*)(lds + (bufoff) + ldsw + _i * 8192), 16, 0, 0); } while (0)
#define dlt_voffA dltA
#define dlt_voffB dltB
#define PG8_LDA(dst, b, h) do { _Pragma("unroll") for (int m = 0; m < 4; ++m) _Pragma("unroll") for (int k = 0; k < 2; ++k) dst[m][k] = *(const PG8_LAS bf16x8*)(lds + PG8_SA(b, h) + aoff + m * 2048 + k * 1024); } while (0)
#define PG8_LDB(dst, b, h) do { _Pragma("unroll") for (int n = 0; n < 2; ++n) _Pragma("unroll") for (int k = 0; k < 2; ++k) dst[n][k] = *(const PG8_LAS bf16x8*)(lds + PG8_SB(b, h) + boff + n * 2048 + k * 1024); } while (0)
#define PG8_MMA(ai, bj, At, Bt) do { __builtin_amdgcn_s_setprio(1); _Pragma("unroll") for (int m = 0; m < 4; ++m) _Pragma("unroll") for (int n = 0; n < 2; ++n) _Pragma("unroll") for (int k = 0; k < 2; ++k) \
        acc[ai][bj][m][n] = __builtin_amdgcn_mfma_f32_16x16x32_bf16(Bt[n][k], At[m][k], acc[ai][bj][m][n], 0, 0, 0); __builtin_amdgcn_s_setprio(0); } while (0)
#define PG8_WAIT_V(n) asm volatile("s_waitcnt vmcnt(" #n ")" ::: "memory")
#define PG8_WAIT_L(n) asm volatile("s_waitcnt lgkmcnt(" #n ")" ::: "memory")
#define PG8_BAR __builtin_amdgcn_s_barrier()
#define PG8_SCHED __builtin_amdgcn_sched_barrier(0)
    Unit cur, nxt; int ui = 0;
    if (!S.next(0, cur)) return;
    f32x4 acc[2][2][4][2];
#pragma unroll
    for (int a = 0; a < 2; ++a)
#pragma unroll
        for (int b = 0; b < 2; ++b)
#pragma unroll
            for (int m = 0; m < 4; ++m)
#pragma unroll
                for (int n = 0; n < 2; ++n) acc[a][b][m][n] = (f32x4){0.f, 0.f, 0.f, 0.f};
    bf16x8 At[4][2], B0[2][2], B1[2][2];
    const char* cA = (const char*)g.A + (size_t)cur.pm * tstepA; const char* cB = (const char*)g.Bt + (size_t)cur.pn * tstepB;
    S.a_ready(cur);
    if constexpr (SP2) {
        PG8_STAGE(PG8_SB(0, 0), cB, voffB); PG8_STAGE(PG8_SB(0, 1), cB + hstepB, voffB); PG8_STAGE(PG8_SA(0, 0), cA, voffA); PG8_STAGE(PG8_SA(0, 1), cA + hstepA, voffA);
        if (wr == 1) PG8_BAR;
        PG8_WAIT_V(2); PG8_BAR;
        PG8_STAGE(PG8_SB(1, 0), cB + kstep, voffB); PG8_STAGE(PG8_SA(1, 0), cA + kstep, voffA); PG8_STAGE(PG8_SB(1, 1), cB + hstepB + kstep, voffB);
        PG8_WAIT_V(6); PG8_BAR;
    } else {
        PG8_STAGE(PG8_SB(0, 0), cB, voffB); PG8_STAGE(PG8_SA(0, 0), cA, voffA); PG8_STAGE(PG8_SB(0, 1), cB + hstepB, voffB); PG8_STAGE(PG8_SA(0, 1), cA + hstepA, voffA);
        if (wr == 1) PG8_BAR;
        PG8_WAIT_V(4); PG8_BAR;
        PG8_STAGE(PG8_SB(1, 0), cB + kstep, voffB); PG8_STAGE(PG8_SA(1, 0), cA + kstep, voffA); PG8_STAGE(PG8_SB(1, 1), cB + hstepB + kstep, voffB);
        PG8_WAIT_V(6); PG8_BAR;
    }
    for (;;) {
        const bool has_next = S.next(ui + 1, nxt);
        const char* nA = has_next ? (const char*)g.A + (size_t)nxt.pm * tstepA : cA; const char* nB = has_next ? (const char*)g.Bt + (size_t)nxt.pn * tstepB : cB;
#pragma nounroll
        for (int t = 0; t < nt; t += 2) {
            const bool last = (t == nt - 2);
            const char* a1 = cA + (size_t)(t + 1) * kstep;
            const char* a2 = last ? nA : cA + (size_t)(t + 2) * kstep; const char* b2 = last ? nB : cB + (size_t)(t + 2) * kstep;
            const char* a3 = a2 + kstep; const char* b3 = b2 + kstep;
            if (last && has_next) S.a_ready(nxt);
            if constexpr (SP2) {
            PG8_LDB(B0, 0, 0); PG8_LDB(B1, 0, 1); PG8_SCHED; PG8_LDA(At, 0, 0); PG8_STAGE(PG8_SA(1, 1), a1 + hstepA, voffA);
            PG8_WAIT_V(8); PG8_WAIT_L(0); PG8_BAR; PG8_MMA(0, 0, At, B0); PG8_MMA(0, 1, At, B1); PG8_BAR; PG8_SCHED;
            PG8_LDA(At, 0, 1); PG8_STAGE(PG8_SB(0, 0), b2, voffB); PG8_STAGE(PG8_SB(0, 1), b2 + hstepB, voffB); PG8_STAGE(PG8_SA(0, 0), a2, voffA);
            PG8_WAIT_V(8); PG8_WAIT_L(0); PG8_BAR; PG8_MMA(1, 0, At, B0); PG8_MMA(1, 1, At, B1); PG8_BAR; PG8_SCHED;
            PG8_LDB(B0, 1, 0); PG8_LDB(B1, 1, 1); PG8_SCHED; PG8_LDA(At, 1, 0); PG8_STAGE(PG8_SA(0, 1), a2 + hstepA, voffA);
            PG8_WAIT_V(8); PG8_WAIT_L(0); PG8_BAR; PG8_MMA(0, 0, At, B0); PG8_MMA(0, 1, At, B1); PG8_BAR; PG8_SCHED;
            PG8_LDA(At, 1, 1); PG8_STAGE(PG8_SB(1, 0), b3, voffB); PG8_STAGE(PG8_SB(1, 1), b3 + hstepB, voffB); PG8_STAGE(PG8_SA(1, 0), a3, voffA);
            PG8_WAIT_V(8); PG8_WAIT_L(0); PG8_BAR; PG8_MMA(1, 0, At, B0); PG8_MMA(1, 1, At, B1); PG8_BAR; PG8_SCHED;
            } else {
            PG8_LDB(B0, 0, 0); PG8_SCHED; PG8_LDA(At, 0, 0); PG8_STAGE(PG8_SA(1, 1), a1 + hstepA, voffA);
            PG8_WAIT_L(8); PG8_BAR; PG8_WAIT_L(0); PG8_MMA(0, 0, At, B0); PG8_BAR; PG8_SCHED;
            PG8_LDB(B1, 0, 1); PG8_STAGE(PG8_SB(0, 0), b2, voffB);
            PG8_BAR; PG8_WAIT_L(0); PG8_MMA(0, 1, At, B1); PG8_BAR;
            PG8_LDA(At, 0, 1); PG8_STAGE(PG8_SA(0, 0), a2, voffA);
            PG8_BAR; PG8_WAIT_L(0); PG8_MMA(1, 0, At, B0); PG8_BAR; PG8_SCHED;
            PG8_STAGE(PG8_SB(0, 1), b2 + hstepB, voffB);
            PG8_WAIT_V(6); PG8_BAR; PG8_MMA(1, 1, At, B1); PG8_BAR;
            PG8_LDB(B0, 1, 0); PG8_SCHED; PG8_LDA(At, 1, 0); PG8_STAGE(PG8_SA(0, 1), a2 + hstepA, voffA);
            PG8_WAIT_L(8); PG8_BAR; PG8_WAIT_L(0); PG8_MMA(0, 0, At, B0); PG8_BAR; PG8_SCHED;
            PG8_LDB(B1, 1, 1); PG8_STAGE(PG8_SB(1, 0), b3, voffB);
            PG8_BAR; PG8_WAIT_L(0); PG8_MMA(0, 1, At, B1); PG8_BAR;
            PG8_LDA(At, 1, 1); PG8_STAGE(PG8_SA(1, 0), a3, voffA);
            PG8_BAR; PG8_WAIT_L(0); PG8_MMA(1, 0, At, B0); PG8_BAR; PG8_SCHED;
            PG8_STAGE(PG8_SB(1, 1), b3 + hstepB, voffB);
            PG8_WAIT_V(6); PG8_BAR; PG8_MMA(1, 1, At, B1); PG8_BAR;
            }
        }
        if constexpr (ALIGN_EPI) { if (wr == 0) PG8_BAR; }
        if constexpr (!Epi::AFTER_DRAIN) { E(acc, cur, wr, wc, fr, fq); S.done(cur); }
        if (!has_next) break;
#pragma unroll
        for (int a = 0; a < 2; ++a)
#pragma unroll
            for (int b = 0; b < 2; ++b)
#pragma unroll
                for (int m = 0; m < 4; ++m)
#pragma unroll
                    for (int n = 0; n < 2; ++n) acc[a][b][m][n] = (f32x4){0.f, 0.f, 0.f, 0.f};
        cur = nxt; cA = nA; cB = nB; ++ui;
        if constexpr (ALIGN_EPI) { if (wr == 1) PG8_BAR; }
    }
    PG8_WAIT_V(0);
    if constexpr (!ALIGN_EPI) { if (wr == 0) PG8_BAR; }
    PG8_BAR;
    if constexpr (Epi::AFTER_DRAIN) { E.fused(acc, cur, wr, wc, fr, fq, lds, wid, lane); S.done(cur); }
#undef PG8_SA
#undef PG8_SB
#undef PG8_STAGE
#undef dlt_voffA
#undef dlt_voffB
#undef PG8_LDA
#undef PG8_LDB
#undef PG8_MMA
#undef PG8_WAIT_V
#undef PG8_WAIT_L
#undef PG8_BAR
#undef PG8_SCHED
}
}
#define GAS __attribute__((address_space(1)))
#define LAS __attribute__((address_space(3)))
typedef unsigned short bf16;
typedef unsigned v4u __attribute__((ext_vector_type(4)));
typedef float f32x4 __attribute__((ext_vector_type(4)));
typedef short bf16x8 __attribute__((ext_vector_type(8)));
typedef GAS unsigned gu32;
typedef GAS unsigned long long gu64;
#define RLX_AGENT __ATOMIC_RELAXED, __HIP_MEMORY_SCOPE_AGENT
#define LDS_WAIT() asm volatile("s_waitcnt lgkmcnt(0)" ::: "memory")
#define VM_WAIT() asm volatile("s_waitcnt vmcnt(0)" ::: "memory")
__device__ __forceinline__ unsigned long long rt() { return __builtin_amdgcn_s_memrealtime(); }
__device__ __forceinline__ unsigned f2bf(float f) { unsigned u = __builtin_bit_cast(unsigned, f); return (u + 0x7fffu + ((u >> 16) & 1u)) >> 16; }
__device__ __forceinline__ unsigned pk2(float lo, float hi) { return f2bf(lo) | (f2bf(hi) << 16); }

#define XB_TMO      128
#define XB_XCNT(j)  (256  + 64 * (j))
#define XB_XSUB(j)  (1280 + 64 * (j))
#define XB_XGEN(j)  (2304 + 64 * (j))
#define XB_TOP      3328
#define XB_TOPGEN   3392
#define XCD_BAR_WORDS 3456
#define XB_SPIN_CAP (1u << 18)

__device__ __forceinline__ unsigned xb_ld(unsigned* p)              { return __hip_atomic_load(p, __ATOMIC_RELAXED, __HIP_MEMORY_SCOPE_AGENT); }
__device__ __forceinline__ unsigned xb_add(unsigned* p, unsigned v) { return __hip_atomic_fetch_add(p, v, __ATOMIC_RELAXED, __HIP_MEMORY_SCOPE_AGENT); }
__device__ __forceinline__ unsigned xb_xcc_id() { return (unsigned)__builtin_amdgcn_s_getreg((3 << 11) | 20) & 0xFu; }
#define XB_SPIN(cond, bar) do { unsigned _sp = 0; while (cond) { __builtin_amdgcn_s_sleep(1); \
    if ((++_sp & 255u) == 0u) { if (xb_ld(&(bar)[XB_TMO])) break; if (_sp > XB_SPIN_CAP) { atomicAdd(&(bar)[XB_TMO], 1u); break; } } } } while (0)

struct XcdBarrier {
    unsigned* bar; unsigned x;
    volatile LAS unsigned* st;
};

__device__ __forceinline__ XcdBarrier xcd_barrier_post(unsigned* bar, volatile LAS unsigned* st) {
    XcdBarrier b; b.bar = bar; b.x = xb_xcc_id(); b.st = st;
    if (threadIdx.x == 0) (void)xb_add(&bar[XB_XCNT(b.x)], 1u);
    return b;
}
__device__ __forceinline__ void xcd_barrier_complete(unsigned* bar, unsigned x, unsigned& nloc, unsigned& nx) {
    const unsigned G = gridDim.x * gridDim.y * gridDim.z;
    unsigned sum, cnt, mine, sp = 0u;
    for (;;) {
        sum = 0u; cnt = 0u; mine = 0u;
#pragma unroll
        for (unsigned j = 0; j < 16; ++j) { const unsigned c = xb_ld(&bar[XB_XCNT(j)]); sum += c; cnt += (c > 0u) ? 1u : 0u; mine = (j == x) ? c : mine; }
        if (sum == G) break;
        __builtin_amdgcn_s_sleep(1);
        if ((++sp & 255u) == 0u) { if (xb_ld(&bar[XB_TMO])) break; if (sp > XB_SPIN_CAP) { atomicAdd(&bar[XB_TMO], 1u); break; } }
    }
    nloc = mine > 0u ? mine : 1u; nx = cnt > 0u ? cnt : 1u;
}

__device__ __forceinline__ void xcd_barrier(const XcdBarrier& b) {
    asm volatile("s_waitcnt vmcnt(0)" ::: "memory");
    __syncthreads();
    if (threadIdx.x == 0) {
        unsigned* bar = b.bar;
        __builtin_amdgcn_s_waitcnt(0);
        unsigned nloc = b.st[0], nx = b.st[1];
        if (nloc == 0u) { xcd_barrier_complete(bar, b.x, nloc, nx); b.st[0] = nloc; b.st[1] = nx; }
        const unsigned old = xb_add(&bar[XB_XSUB(b.x)], 1u);
        const unsigned gen = old / nloc;
        if (old + 1u == (gen + 1u) * nloc) {
            __builtin_amdgcn_fence(__ATOMIC_RELEASE, "agent");
            asm volatile("s_waitcnt vmcnt(0)" ::: "memory");
            const unsigned og = xb_add(&bar[XB_TOP], 1u);
            const unsigned tg = og / nx;
            if (og + 1u == (tg + 1u) * nx) xb_add(&bar[XB_TOPGEN], 1u);
            else XB_SPIN(xb_ld(&bar[XB_TOPGEN]) == tg, bar);
            __builtin_amdgcn_fence(__ATOMIC_ACQUIRE, "agent");
            xb_add(&bar[XB_XGEN(b.x)], 1u);
            asm volatile("s_waitcnt vmcnt(0)" ::: "memory");
        } else {
            XB_SPIN(xb_ld(&bar[XB_XGEN(b.x)]) == gen, bar);
            __builtin_amdgcn_fence(__ATOMIC_ACQUIRE, "agent");
            asm volatile("s_waitcnt vmcnt(0)" ::: "memory");
        }
    }
    __syncthreads();
}
namespace att {
using bf16x8 = __attribute__((ext_vector_type(8))) short;
using s16x4 = __attribute__((ext_vector_type(4))) short;
using f32x16 = __attribute__((ext_vector_type(16))) float;
using u32x4 = __attribute__((ext_vector_type(4))) unsigned;
typedef short v4i16_t __attribute__((ext_vector_type(4)));
typedef __attribute__((address_space(3))) char* lptr;
typedef __attribute__((address_space(3))) const char* lcptr;
constexpr int KSLOT = 12288, VSLOT = 8192, BSLOT = 1024;
constexpr int NSLOT = 4;
constexpr int LDS_K = 0, LDS_V = NSLOT * KSLOT, LDS_B = LDS_V + NSLOT * VSLOT, LDS_WS = LDS_B + NSLOT * BSLOT, LDS_OST = LDS_WS + 8 * 512, LDS_BYTES = LDS_OST + 8 * 4096;
__device__ __forceinline__ int crow(int r, int hi) { return (r & 3) + 8 * (r >> 2) + 4 * hi; }
__device__ __forceinline__ void glds16(const void* g, unsigned lds_base) {
    unsigned sv; asm volatile("s_mov_b32 %0, m0\n\ts_mov_b32 m0, %2\n\ts_nop 0\n\tglobal_load_lds_dwordx4 %1, off\n\ts_mov_b32 m0, %0" : "=&s"(sv) : "v"(g), "s"(lds_base) : "memory"); }
typedef __bf16 bf2_t __attribute__((ext_vector_type(2)));
typedef float fl2_t __attribute__((ext_vector_type(2)));
__device__ __forceinline__ unsigned cvtpk(float lo, float hi) { const fl2_t v = {lo, hi}; return __builtin_bit_cast(unsigned, __builtin_convertvector(v, bf2_t)); }
__device__ __forceinline__ s16x4 vtr(lcptr p) { return __builtin_bit_cast(s16x4, __builtin_amdgcn_ds_read_tr16_b64_v4i16((__attribute__((address_space(3))) v4i16_t*)p)); }
#define ATT_MX3(a, b, c) __builtin_fmaxf(__builtin_fmaxf((a), (b)), (c))
__device__ __forceinline__ float rowmax(const f32x16& p0, const f32x16& p1) {
    float a = ATT_MX3(p0[0], p0[1], p1[0]), b = ATT_MX3(p0[2], p0[3], p1[1]); a = ATT_MX3(a, p1[2], p1[3]);
#pragma unroll
    for (int r = 4; r < 16; r += 4) { a = ATT_MX3(a, p0[r], p0[r + 1]); b = ATT_MX3(b, p0[r + 2], p0[r + 3]); a = ATT_MX3(a, p1[r], p1[r + 1]); b = ATT_MX3(b, p1[r + 2], p1[r + 3]); }
    float m = __builtin_fmaxf(a, b); auto rr = __builtin_amdgcn_permlane32_swap(__float_as_uint(m), __float_as_uint(m), false, false);
    return __builtin_fmaxf(__uint_as_float(rr[0]), __uint_as_float(rr[1])); }
__device__ __forceinline__ void cmask(f32x16& p0, f32x16& p1, int jb, int qrel, int hi) {
    const int kb = 64 * jb + 4 * hi;
#pragma unroll
    for (int r = 0; r < 16; ++r) { const int kv = kb + (r & 3) + 8 * (r >> 2); if (kv > qrel) p0[r] = -INFINITY; if (kv + 32 > qrel) p1[r] = -INFINITY; } }
#define ATT_WAIT_BAR(N) asm volatile("s_waitcnt vmcnt(" #N ") lgkmcnt(0)\n\ts_barrier" ::: "memory")
#define ATT_MFMA(a, b, c) __builtin_amdgcn_mfma_f32_32x32x16_bf16(a, b, c, 0, 0, 0)

template <int ND, bool BIAS>
__device__ __forceinline__ void attn_unit(const unsigned short* Qh, int pq, const unsigned short* Kh, int pk, const unsigned short* Vh, int pv, unsigned short* Oh, int po,
                                          const float* cbx, int hb, int qb, lptr lds, int wid) {
    const int lane = lane_id(), r32 = lane & 31, hi = lane >> 5;
    const int q0 = qb * 512, NT = 8 * qb + 8;
    constexpr int KSL = ND * 2048;
    const unsigned lds0 = (unsigned)(uintptr_t)lds;
    bf16x8 qa[ND], qc[ND];
    const int ra0 = 32 * wid, rb0 = 480 - 32 * wid;
    const int da_ = wid >> 1, db_ = 7 - (wid >> 1);
    const int oa_ = 32 * (wid & 1), ob_ = (wid & 1) ? 0 : 32;
    { const unsigned short* Qwa = Qh + (size_t)(q0 + ra0 + r32) * pq + hi * 8; const unsigned short* Qwb = Qh + (size_t)(q0 + rb0 + r32) * pq + hi * 8;
#pragma unroll
      for (int d0 = 0; d0 < ND; ++d0) { qa[d0] = *reinterpret_cast<const bf16x8*>(Qwa + d0 * 16); qc[d0] = *reinterpret_cast<const bf16x8*>(Qwb + d0 * 16); }
 }
    const unsigned short* ksrc0 = Kh + (size_t)lane * pk + wid * 8;
    const unsigned short* ksrc1 = Kh + (size_t)lane * pk + (8 + (wid & 3)) * 8;
    const unsigned short* vsrc = Vh + (size_t)(16 * (wid & 3) + (lane >> 2)) * pv + (wid >> 2) * 32 + (lane & 3) * 8;
    const float* bsrc = cbx + lane * 4;
    const unsigned kdst0 = lds0 + LDS_K + wid * 1024, kdst1 = lds0 + LDS_K + (8 + (wid & 3)) * 1024, vdst = lds0 + LDS_V + wid * 1024, bdst = lds0 + LDS_B;
#define ATT_DMA(t, s) do { glds16(ksrc0 + (size_t)(t) * 64 * pk, (unsigned)__builtin_amdgcn_readfirstlane(kdst0 + (s) * KSL)); \
        if (ND == 6) glds16(ksrc1 + (size_t)(t) * 64 * pk, (unsigned)__builtin_amdgcn_readfirstlane(kdst1 + (s) * KSL)); \
        glds16(vsrc + (size_t)(t) * 64 * pv, (unsigned)__builtin_amdgcn_readfirstlane(vdst + (s) * VSLOT)); \
        if (BIAS) glds16(bsrc + (size_t)(t) * 256, (unsigned)__builtin_amdgcn_readfirstlane(bdst + (s) * BSLOT)); } while (0)
    const lcptr kp0 = (lcptr)lds + LDS_K + hi * 1024 + r32 * 16;
    const lcptr vp0 = (lcptr)lds + LDS_V + ((lane >> 4) & 1) * 32 + (lane & 3) * 8 + (4 * hi + ((lane & 15) >> 2)) * 64;
    const lcptr bp0 = (lcptr)lds + LDS_B + hb * 256 + hi * 128;
    __attribute__((address_space(3))) float* wsf = (__attribute__((address_space(3))) float*)(lds + LDS_WS) + wid * 128;
    ATT_DMA(NT - 1, 0); ATT_DMA(NT - 2, 1); ATT_DMA(NT - 3, 2);
#pragma unroll
    for (int d0 = 0; d0 < ND; ++d0) { asm volatile("" : "+v"(qa[d0])); asm volatile("" : "+v"(qc[d0])); }
    float ma = -INFINITY, la = 0.f, mb = -INFINITY, lb = 0.f; f32x16 oa[2], ob[2];
    { float z0; asm volatile("v_mov_b32 %0, 0" : "=v"(z0));
#pragma unroll
      for (int r = 0; r < 16; ++r) { oa[0][r] = z0; oa[1][r] = z0; ob[0][r] = z0; ob[1][r] = z0; } }
    f32x16 pa, pb, pa2, pb2;
#define ATT_SKIP(t) ((t) < 8 && (7 - (t)) > db_)
#define ATT_AACT(t) ((t) >= 8 || (7 - (t)) <= da_)
#define ATT_CINIT(PA_, PB_, t, H) do { if (BIAS) { const lcptr bp = bp0 + ((t) & 3) * BSLOT + (H) * 64; \
            _Pragma("unroll") for (int g = 0; g < 4; ++g) { const f32x4 x_ = *(const __attribute__((address_space(3))) f32x4*)(bp + g * 16); \
                _Pragma("unroll") for (int e = 0; e < 4; ++e) { PA_[4 * g + e] = x_[e]; PB_[4 * g + e] = x_[e]; } } } \
        else { PA_ = f32x16{}; PB_ = f32x16{}; } } while (0)
#define ATT_QK(t, H) do { const lcptr kb_ = kp0 + ((t) & 3) * KSL + (H) * 512; ATT_CINIT(pa, pb, t, H); bf16x8 kf_[ND]; \
        _Pragma("unroll") for (int d0 = 0; d0 < ND; ++d0) kf_[d0] = *(const __attribute__((address_space(3))) bf16x8*)(kb_ + d0 * 2048); \
        __builtin_amdgcn_s_setprio(1); _Pragma("unroll") for (int d0 = 0; d0 < ND; ++d0) { pa = ATT_MFMA(kf_[d0], qa[d0], pa); pb = ATT_MFMA(kf_[d0], qc[d0], pb); } __builtin_amdgcn_s_setprio(0); } while (0)
#define ATT_VF(i) ({ const s16x4 lo_ = vtr(vp + (((i) >> 2) * 4096 + ((i) & 3) * 1024)), hi_ = vtr(vp + (((i) >> 2) * 4096 + ((i) & 3) * 1024 + 512)); (bf16x8){lo_[0], lo_[1], lo_[2], lo_[3], hi_[0], hi_[1], hi_[2], hi_[3]}; })
#define ATT_RMAX(P, RM) do { float a_ = ATT_MX3(P[0], P[1], P[2]), b_ = ATT_MX3(P[3], P[4], P[5]); a_ = ATT_MX3(a_, P[6], P[7]); b_ = ATT_MX3(b_, P[8], P[9]); a_ = ATT_MX3(a_, P[10], P[11]); b_ = ATT_MX3(b_, P[12], P[13]); a_ = ATT_MX3(a_, P[14], P[15]); \
        RM = __builtin_fmaxf(a_, b_); { auto rr_ = __builtin_amdgcn_permlane32_swap(__float_as_uint(RM), __float_as_uint(RM), false, false); RM = __builtin_fmaxf(__uint_as_float(rr_[0]), __uint_as_float(rr_[1])); } } while (0)
#define ATT_EXPS(P, MR, LR) do { float sum_ = 0.f; \
        _Pragma("unroll") for (int r = 0; r < 16; ++r) { P[r] = __builtin_amdgcn_exp2f(P[r] - MR); sum_ += P[r]; } \
        asm volatile("" : "+v"(sum_));            \
        LR += sum_; asm volatile("" : "+v"(LR)); } while (0)
#define ATT_PK(P, o) (u32x4){cvtpk(P[o], P[o + 1]), cvtpk(P[o + 2], P[o + 3]), cvtpk(P[o + 4], P[o + 5]), cvtpk(P[o + 6], P[o + 7])}
#define ATT_PV(WA, WB, i) do { const bf16x8 v0_ = ATT_VF(i), v1_ = ATT_VF((i) + 4); __builtin_amdgcn_s_setprio(1); \
        oa[0] = ATT_MFMA(__builtin_bit_cast(bf16x8, WA), v0_, oa[0]); ob[0] = ATT_MFMA(__builtin_bit_cast(bf16x8, WB), v0_, ob[0]); \
        oa[1] = ATT_MFMA(__builtin_bit_cast(bf16x8, WA), v1_, oa[1]); ob[1] = ATT_MFMA(__builtin_bit_cast(bf16x8, WB), v1_, ob[1]); __builtin_amdgcn_s_setprio(0); } while (0)
#define ATT_SMPV(t, H, MASKED_) do { const int s_ = (t) & 3; \
        if (MASKED_) { if (7 - (t) == da_) { const int l3_ = lane_id(), kb3_ = 32 * (H) + 4 * (l3_ >> 5), qa3_ = oa_ + (l3_ & 31); \
            _Pragma("unroll") for (int r = 0; r < 16; ++r) { const int kv = kb3_ + (r & 3) + 8 * (r >> 2); if (kv > qa3_) pa[r] = -INFINITY; } } } \
        float rma, rmb; ATT_RMAX(pa, rma); ATT_RMAX(pb, rmb); \
          \
        if (__any(rma > ma + 40.f || rmb > mb + 40.f)) { \
            const float na = __builtin_fmaxf(ma, rma), nb = __builtin_fmaxf(mb, rmb); const float ala = __builtin_amdgcn_exp2f(ma - na), alb = __builtin_amdgcn_exp2f(mb - nb); ma = na; mb = nb; la *= ala; lb *= alb; \
            if (hi == 0) { wsf[r32] = ala; wsf[32 + r32] = alb; } \
            asm volatile("s_waitcnt lgkmcnt(0)" ::: "memory"); \
            asm volatile("" : "+v"(oa[0]), "+v"(oa[1]));       \
            _Pragma("unroll") for (int r = 0; r < 16; ++r) { const float fa = wsf[crow(r, hi)]; oa[0][r] *= fa; oa[1][r] *= fa; if ((r & 3) == 3) asm volatile("" ::: "memory"); } \
            asm volatile("" : "+v"(oa[0]), "+v"(oa[1])); \
            asm volatile("" : "+v"(ob[0]), "+v"(ob[1])); \
            _Pragma("unroll") for (int r = 0; r < 16; ++r) { const float fb = wsf[32 + crow(r, hi)]; ob[0][r] *= fb; ob[1][r] *= fb; if ((r & 3) == 3) asm volatile("" ::: "memory"); } \
            asm volatile("" : "+v"(ob[0]), "+v"(ob[1])); } \
        ATT_EXPS(pa, ma, la); ATT_EXPS(pb, mb, lb); \
        const lcptr vp = vp0 + s_ * VSLOT; \
        { const u32x4 wa_ = ATT_PK(pa, 0), wb_ = ATT_PK(pb, 0); ATT_PV(wa_, wb_, 2 * (H)); } \
        { const u32x4 wa_ = ATT_PK(pa, 8), wb_ = ATT_PK(pb, 8); ATT_PV(wa_, wb_, 2 * (H) + 1); } } while (0)
#define ATT_QK_B(t, H) do { const lcptr kb_ = kp0 + ((t) & 3) * KSL + (H) * 512; \
        if (BIAS) { const lcptr bp = bp0 + ((t) & 3) * BSLOT + (H) * 64; \
            _Pragma("unroll") for (int g = 0; g < 4; ++g) { const f32x4 x_ = *(const __attribute__((address_space(3))) f32x4*)(bp + g * 16); \
                _Pragma("unroll") for (int e = 0; e < 4; ++e) pb[4 * g + e] = x_[e]; } } \
        else pb = f32x16{}; \
        bf16x8 kf_[ND]; _Pragma("unroll") for (int d0 = 0; d0 < ND; ++d0) kf_[d0] = *(const __attribute__((address_space(3))) bf16x8*)(kb_ + d0 * 2048); \
        _Pragma("unroll") for (int d0 = 0; d0 < ND; ++d0) pb = ATT_MFMA(kf_[d0], qc[d0], pb); } while (0)
#define ATT_SMPV_B(t, H) do { const int s_ = (t) & 3; \
        if (7 - (t) == db_) { const int l3_ = lane_id(), kb3_ = 32 * (H) + 4 * (l3_ >> 5), qb3_ = ob_ + (l3_ & 31); \
            _Pragma("unroll") for (int r = 0; r < 16; ++r) { const int kv = kb3_ + (r & 3) + 8 * (r >> 2); if (kv > qb3_) pb[r] = -INFINITY; } } \
        float rmb; ATT_RMAX(pb, rmb); \
        if (__any(rmb > mb + 40.f)) { \
            const float nb = __builtin_fmaxf(mb, rmb); const float alb = __builtin_amdgcn_exp2f(mb - nb); mb = nb; lb *= alb; \
            if (hi == 0) wsf[32 + r32] = alb; \
            asm volatile("s_waitcnt lgkmcnt(0)" ::: "memory"); \
            asm volatile("" : "+v"(ob[0]), "+v"(ob[1])); \
            _Pragma("unroll") for (int r = 0; r < 16; ++r) { const float fb = wsf[32 + crow(r, hi)]; ob[0][r] *= fb; ob[1][r] *= fb; if ((r & 3) == 3) asm volatile("" ::: "memory"); } \
            asm volatile("" : "+v"(ob[0]), "+v"(ob[1])); } \
        ATT_EXPS(pb, mb, lb); \
        const lcptr vp = vp0 + s_ * VSLOT; \
        { const u32x4 wb_ = ATT_PK(pb, 0); const bf16x8 v0_ = ATT_VF(2 * (H)), v1_ = ATT_VF(2 * (H) + 4); \
          ob[0] = ATT_MFMA(__builtin_bit_cast(bf16x8, wb_), v0_, ob[0]); ob[1] = ATT_MFMA(__builtin_bit_cast(bf16x8, wb_), v1_, ob[1]); } \
        { const u32x4 wb_ = ATT_PK(pb, 8); const bf16x8 v0_ = ATT_VF(2 * (H) + 1), v1_ = ATT_VF(2 * (H) + 5); \
          ob[0] = ATT_MFMA(__builtin_bit_cast(bf16x8, wb_), v0_, ob[0]); ob[1] = ATT_MFMA(__builtin_bit_cast(bf16x8, wb_), v1_, ob[1]); } } while (0)
#define ATT_HALF(CA, CB, NA, NB, t, H, tn, Hn, HASNEXT) do { const int s_ = (t) & 3; \
        bf16x8 kf_[ND]; if (HASNEXT) { const lcptr kb_ = kp0 + ((tn) & 3) * KSL + (Hn) * 512; \
            _Pragma("unroll") for (int d0 = 0; d0 < ND; ++d0) kf_[d0] = *(const __attribute__((address_space(3))) bf16x8*)(kb_ + d0 * 2048); } \
        float rma, rmb; ATT_RMAX(CA, rma); ATT_RMAX(CB, rmb); \
        if (__any(rma > ma + 40.f || rmb > mb + 40.f)) { \
            const float na = __builtin_fmaxf(ma, rma), nb = __builtin_fmaxf(mb, rmb); const float ala = __builtin_amdgcn_exp2f(ma - na), alb = __builtin_amdgcn_exp2f(mb - nb); ma = na; mb = nb; la *= ala; lb *= alb; \
            if (hi == 0) { wsf[r32] = ala; wsf[32 + r32] = alb; } \
            asm volatile("s_waitcnt lgkmcnt(0)" ::: "memory"); \
            asm volatile("" : "+v"(oa[0]), "+v"(oa[1])); \
            _Pragma("unroll") for (int r = 0; r < 16; ++r) { const float fa = wsf[crow(r, hi)]; oa[0][r] *= fa; oa[1][r] *= fa; if ((r & 3) == 3) asm volatile("" ::: "memory"); } \
            asm volatile("" : "+v"(oa[0]), "+v"(oa[1])); \
            asm volatile("" : "+v"(ob[0]), "+v"(ob[1])); \
            _Pragma("unroll") for (int r = 0; r < 16; ++r) { const float fb = wsf[32 + crow(r, hi)]; ob[0][r] *= fb; ob[1][r] *= fb; if ((r & 3) == 3) asm volatile("" ::: "memory"); } \
            asm volatile("" : "+v"(ob[0]), "+v"(ob[1])); } \
        float suma_ = 0.f, sumb_ = 0.f; if (HASNEXT) ATT_CINIT(NA, NB, tn, Hn); \
        __builtin_amdgcn_sched_barrier(0); \
        _Pragma("unroll") for (int d0 = 0; d0 < ND; ++d0) { \
            if (HASNEXT) { NA = ATT_MFMA(kf_[d0], qa[d0], NA); NB = ATT_MFMA(kf_[d0], qc[d0], NB); } \
            _Pragma("unroll") for (int r = (16 * d0) / ND; r < (16 * (d0 + 1)) / ND; ++r) { CA[r] = __builtin_amdgcn_exp2f(CA[r] - ma); suma_ += CA[r]; CB[r] = __builtin_amdgcn_exp2f(CB[r] - mb); sumb_ += CB[r]; } \
            asm volatile("" : "+v"(suma_), "+v"(sumb_)); \
            __builtin_amdgcn_sched_barrier(0); } \
        la += suma_; lb += sumb_; asm volatile("" : "+v"(la), "+v"(lb)); \
        const lcptr vp = vp0 + s_ * VSLOT; \
        { const u32x4 wa_ = ATT_PK(CA, 0), wb_ = ATT_PK(CB, 0); ATT_PV(wa_, wb_, 2 * (H)); } \
        { const u32x4 wa_ = ATT_PK(CA, 8), wb_ = ATT_PK(CB, 8); ATT_PV(wa_, wb_, 2 * (H) + 1); } } while (0)
    asm volatile("s_waitcnt vmcnt(6) lgkmcnt(0)\n\ts_barrier" ::: "memory");
    const int tb_ = 7 - db_, ta_ = 7 - da_;
    if (tb_ == 0) ATT_QK_B(0, 0);
    int t = 0;
    for (; t < tb_; ++t) {
        if (t + 2 < NT) { ATT_WAIT_BAR(3); } else { ATT_WAIT_BAR(0); }
        if (t + 3 < NT) ATT_DMA(NT - 4 - t, (t + 3) & 3);
        if (t + 1 == tb_) ATT_QK_B(t + 1, 0);
    }
    for (; t < ta_; ++t) {
        if (t + 2 < NT) { ATT_WAIT_BAR(3); } else { ATT_WAIT_BAR(0); }
        if (t + 3 < NT) ATT_DMA(NT - 4 - t, (t + 3) & 3);
        ATT_SMPV_B(t, 0); ATT_QK_B(t, 1); ATT_SMPV_B(t, 1);
        __builtin_amdgcn_sched_barrier(0);
        if (t + 1 < ta_) ATT_QK_B(t + 1, 0); else ATT_QK(t + 1, 0);
    }
    for (; t < 8; ++t) {
        if (t + 2 < NT) { ATT_WAIT_BAR(3); } else { ATT_WAIT_BAR(0); }
        if (t + 3 < NT) ATT_DMA(NT - 4 - t, (t + 3) & 3);
        ATT_SMPV(t, 0, true); ATT_QK(t, 1); ATT_SMPV(t, 1, true);
        __builtin_amdgcn_sched_barrier(0);
        if (t + 1 < NT) ATT_QK(t + 1, 0);
    }
    for (; t < NT; ++t) {
        if (t + 2 < NT) { ATT_WAIT_BAR(3); } else { ATT_WAIT_BAR(0); }
        if (t + 3 < NT) ATT_DMA(NT - 4 - t, (t + 3) & 3);
        ATT_HALF(pa, pb, pa2, pb2, t, 0, t, 1, true);
        ATT_HALF(pa2, pb2, pa, pb, t, 1, t + 1, 0, t + 1 < NT);
    }
#undef ATT_SKIP
#undef ATT_AACT
#undef ATT_QK_B
#undef ATT_SMPV_B
#undef ATT_HALF
#undef ATT_QK
#undef ATT_CINIT
#undef ATT_SMPV
#undef ATT_VF
#undef ATT_RMAX
#undef ATT_EXPS
#undef ATT_PK
#undef ATT_PV
    { auto rr = __builtin_amdgcn_permlane32_swap(__float_as_uint(la), __float_as_uint(la), false, false); la = __uint_as_float(rr[0]) + __uint_as_float(rr[1]); }
    { auto rr = __builtin_amdgcn_permlane32_swap(__float_as_uint(lb), __float_as_uint(lb), false, false); lb = __uint_as_float(rr[0]) + __uint_as_float(rr[1]); }
    if (hi == 0) { wsf[64 + r32] = la; wsf[96 + r32] = lb; }
    asm volatile("s_waitcnt lgkmcnt(0)" ::: "memory");
    { const int l2 = lane_id(), c2 = l2 & 31, h2 = l2 >> 5;
      __attribute__((address_space(3))) unsigned short* stg = (__attribute__((address_space(3))) unsigned short*)(lds + LDS_OST) + wid * 2048;
      __attribute__((address_space(3))) unsigned short* stw = stg + h2 * 256 + c2;
      const __attribute__((address_space(3))) float* wl = wsf + 64 + 4 * h2;
#pragma unroll
      for (int sb = 0; sb < 2; ++sb) {
#pragma unroll
        for (int r = 0; r < 16; ++r) { constexpr int dummy = 0; (void)dummy; const int cr = (r & 3) + 8 * (r >> 2); const float rl = __builtin_amdgcn_rcpf(wl[sb * 32 + cr]);
#pragma unroll
            for (int d0 = 0; d0 < 2; ++d0) stw[cr * 64 + d0 * 32] = (unsigned short)f2bf((sb ? ob[d0][r] : oa[d0][r]) * rl); }
        asm volatile("s_waitcnt lgkmcnt(0)" ::: "memory");
        unsigned short* Ow = Oh + (size_t)(q0 + (sb ? rb0 : ra0)) * po;
#pragma unroll
        for (int i = 0; i < 4; ++i) { const int row = i * 8 + (l2 >> 3), ch = l2 & 7; *(u32x4*)(Ow + (size_t)row * po + ch * 8) = *(const __attribute__((address_space(3))) u32x4*)(stg + row * 64 + ch * 8); }
        asm volatile("s_waitcnt lgkmcnt(0)" ::: "memory");
      } }
    asm volatile("s_waitcnt lgkmcnt(0)\n\ts_barrier" ::: "memory");
#undef ATT_DMA
}
}
namespace mid {
using bf16x8 = __attribute__((ext_vector_type(8))) short;
using f32x16 = __attribute__((ext_vector_type(16))) float;
using u32x4 = __attribute__((ext_vector_type(4))) unsigned;
typedef __attribute__((address_space(3))) char* lptr;
#define MID_MFMA(a, b, c) __builtin_amdgcn_mfma_f32_32x32x16_bf16(a, b, c, 0, 0, 0)
__device__ __forceinline__ int crow(int r, int hi) { return (r & 3) + 8 * (r >> 2) + 4 * hi; }
__device__ __forceinline__ float bf_lo(unsigned w) { return __uint_as_float(w << 16); }
__device__ __forceinline__ float bf_hi(unsigned w) { return __uint_as_float(w & 0xffff0000u); }
__device__ __forceinline__ float bfu(unsigned short v) { return __uint_as_float((unsigned)v << 16); }
__device__ __forceinline__ float xhalf_sum(float x) { auto t = __builtin_amdgcn_permlane32_swap(__float_as_uint(x), __float_as_uint(x), false, false); return __uint_as_float(t[0]) + __uint_as_float(t[1]); }
__device__ __forceinline__ float sumsq8(bf16x8 v) { float s = 0.f;
#pragma unroll
    for (int j = 0; j < 8; ++j) { const float f = bfu((unsigned short)v[j]); s += f * f; } return s; }

typedef __bf16 bf2_t __attribute__((ext_vector_type(2)));
typedef float fl2_t __attribute__((ext_vector_type(2)));
__device__ __forceinline__ unsigned cvtpk(float lo, float hi) { const fl2_t v = {lo, hi}; return __builtin_bit_cast(unsigned, __builtin_convertvector(v, bf2_t)); }
template <int KS, int NT>
__device__ __forceinline__ void latent_gemm(f32x16 (&acc)[NT], __attribute__((address_space(3))) const char* arow  , const unsigned short* wt  , float post) {
    float ss = 0.f;
#pragma unroll
    for (int nt = 0; nt < NT; ++nt) acc[nt] = f32x16{};
#pragma unroll
    for (int ks = 0; ks < KS; ++ks) { const bf16x8 a = *(const __attribute__((address_space(3))) bf16x8*)(arow + 32 * ks); ss += sumsq8(a);
#pragma unroll
        for (int nt = 0; nt < NT; ++nt) { const bf16x8 b = *reinterpret_cast<const bf16x8*>(wt + (size_t)(nt * KS + ks) * 512); acc[nt] = MID_MFMA(b, a, acc[nt]); }
        if ((ks & 3) == 3) asm volatile("" ::: "memory"); }
    ss = xhalf_sum(ss);
    const float rstd = rsqrtf(ss * (1.0f / (16 * KS)) + EPS) * post;
#pragma unroll
    for (int nt = 0; nt < NT; ++nt) acc[nt] = acc[nt] * rstd;
}
__device__ __forceinline__ void rope_tile(f32x16& x, const float* rp, int hi) {
#pragma unroll
    for (int g = 0; g < 2; ++g) { const f32x4 c0 = *(const f32x4*)(rp + (8 * g + 4 * hi) * 2), c1 = *(const f32x4*)(rp + (8 * g + 4 * hi) * 2 + 4);
        const float cs[4][2] = {{c0[0], c0[1]}, {c0[2], c0[3]}, {c1[0], c1[1]}, {c1[2], c1[3]}};
#pragma unroll
        for (int e = 0; e < 4; ++e) { const int r = 4 * g + e; const float x1 = x[r], x2 = x[r + 8]; x[r] = x1 * cs[e][0] - x2 * cs[e][1]; x[r + 8] = x2 * cs[e][0] + x1 * cs[e][1]; } }
}
__device__ __forceinline__ void stage_tiles(__attribute__((address_space(3))) char* stg, const f32x16& t0, const f32x16& t1, int r32, int hi) {
    typedef unsigned u32x2_ __attribute__((ext_vector_type(2)));
#pragma unroll
    for (int n2 = 0; n2 < 2; ++n2) { const f32x16& t = n2 ? t1 : t0;
#pragma unroll
        for (int g = 0; g < 4; ++g) { u32x2_ w; w.x = cvtpk(t[4 * g], t[4 * g + 1]); w.y = cvtpk(t[4 * g + 2], t[4 * g + 3]);
            *(__attribute__((address_space(3))) u32x2_*)(stg + r32 * 144 + (32 * n2 + 8 * g + 4 * hi) * 2) = w; } }
}

constexpr float QSCALE = 0.10206207261596577f * 1.4426950408889634f;
constexpr int STG_BYTES = 16384;
template <class F> __device__ __forceinline__ void stage_out(__attribute__((address_space(3))) const char* stg, int lane, F dst) {
#pragma unroll
    for (int it = 0; it < 4; ++it) { const int row = it * 8 + (lane >> 3), ch = lane & 7;
        *(u32x4*)dst(row, ch) = *(const __attribute__((address_space(3))) u32x4*)(stg + row * 144 + ch * 16); }
}

constexpr int ATILE_BYTES = 128 * 704, OSTG_OFF = ATILE_BYTES, OSTG_BYTES = 4608;
__device__ __forceinline__ void glds16(const void* g, unsigned lds_base) {
    unsigned sv; asm volatile("s_mov_b32 %0, m0\n\ts_mov_b32 m0, %2\n\ts_nop 0\n\tglobal_load_lds_dwordx4 %1, off\n\ts_mov_b32 m0, %0" : "=&s"(sv) : "v"(g), "s"(lds_base) : "memory"); }
constexpr int LAT_TBL = OSTG_OFF + 8 * OSTG_BYTES;
template <int KS> __device__ __forceinline__ void latent_tile(f32x16 (&acc)[4], __attribute__((address_space(3))) const char* a0, const unsigned short* wt) {
#pragma unroll
    for (int blk = 0; blk < 4; ++blk) acc[blk] = f32x16{};
#pragma unroll
    for (int ks = 0; ks < KS; ++ks) { const bf16x8 w = *reinterpret_cast<const bf16x8*>(wt + (size_t)ks * 512);
#pragma unroll
        for (int blk = 0; blk < 4; ++blk) { const bf16x8 a = *(const __attribute__((address_space(3))) bf16x8*)(a0 + blk * (32 * 704) + 32 * ks); acc[blk] = MID_MFMA(w, a, acc[blk]); } }
}
__device__ __forceinline__ void p2_latent(KArgs ka, int l, int tok0, lptr L, int wv) {
    unsigned char* ws = ka->ws; const int lane = lane_id(), r32 = lane & 31, hi = lane >> 5, tb = wv & 3, g = wv >> 2;
    const unsigned short* Z = (const unsigned short*)(ws + WS_Z); const size_t wl = WS_W + (size_t)l * W_LAYER;
    {
        const unsigned lds0 = (unsigned)(uintptr_t)L;
#pragma unroll
        for (int p = 0; p < 11; ++p) { const int id = (wv * 11 + p) * 64 + lane, row = id / 44, ch = id % 44;
            glds16(Z + (size_t)(tok0 + row) * DINP + ch * 8, (unsigned)__builtin_amdgcn_readfirstlane(lds0 + (wv * 11 + p) * 1024)); }
        asm volatile("s_waitcnt vmcnt(0)" ::: "memory"); __syncthreads();
    }
    __attribute__((address_space(3))) float* tbl = (__attribute__((address_space(3))) float*)(L + LAT_TBL);
    {   const int tid = wv * 64 + lane, tl = tid & 127, lat = (tid >> 7) & 1, half = tid >> 8;
        __attribute__((address_space(3))) const char* row = (__attribute__((address_space(3))) const char*)L + tl * 704 + (lat ? O_KVC * 2 + half * 128 : half * 192);
        float sq = 0.f;
#pragma unroll
        for (int c = 0; c < 12; ++c) if (c < 8 || lat == 0) sq += sumsq8(*(const __attribute__((address_space(3))) bf16x8*)(row + 16 * c));
        tbl[(half * 2 + lat) * 128 + tl] = sq;
        __syncthreads();
        if (tid < 256) { const int l2 = tid >> 7, t2 = tid & 127; const float ss = tbl[l2 * 128 + t2] + tbl[(2 + l2) * 128 + t2];
            tbl[512 + l2 * 128 + t2] = rsqrtf(ss * (l2 ? 1.0f / 128.0f : 1.0f / 192.0f) + EPS) * (l2 ? 1.0f : QSCALE); }
        __syncthreads();
    }
    __attribute__((address_space(3))) char* stg = (__attribute__((address_space(3))) char*)(L + OSTG_OFF + wv * OSTG_BYTES);
    for (int it = 0; it < 4; ++it) {
        int jt; bool isq;
        if (wv < 4) { if (it == 3) break; isq = it < 2; jt = it < 2 ? wv + 8 * it : wv; }
        else { isq = it == 0; jt = it == 0 ? wv : 4 + 3 * (wv - 4) + (it - 1); }
        f32x16 acc[4];
        __attribute__((address_space(3))) const char* a0 = (__attribute__((address_space(3))) const char*)L + r32 * 704 + 16 * hi + (isq ? 0 : O_KVC * 2);
        if (isq) latent_tile<12>(acc, a0, (const unsigned short*)(ws + wl + W_UQ) + (size_t)jt * 12 * 512 + lane * 8);
        else latent_tile<8>(acc, a0, (const unsigned short*)(ws + wl + W_UKV) + (size_t)jt * 8 * 512 + lane * 8);
        const bool rope = isq && (jt % 3) == 2;
#pragma unroll
        for (int blk = 0; blk < 4; ++blk) {
            const float rs = tbl[512 + (isq ? 0 : 128) + 32 * blk + r32];
            f32x16 t = acc[blk] * rs;
            if (rope) rope_tile(t, (const float*)(ws + WS_ROPE) + (size_t)(tok0 + 32 * blk + r32) * 32, hi);
            typedef unsigned u32x2_ __attribute__((ext_vector_type(2)));
#pragma unroll
            for (int g = 0; g < 4; ++g) { u32x2_ w; w.x = cvtpk(t[4 * g], t[4 * g + 1]); w.y = cvtpk(t[4 * g + 2], t[4 * g + 3]);
                *(__attribute__((address_space(3))) u32x2_*)(stg + r32 * 80 + (8 * g + 4 * hi) * 2) = w; }
            asm volatile("s_waitcnt lgkmcnt(0)" ::: "memory");
            unsigned short* dst; int pitch;
            if (isq) { dst = (unsigned short*)(ws + WS_Q) + (size_t)(tok0 + 32 * blk) * 384 + 32 * jt; pitch = 384; }
            else { const int head = jt >> 2, nt = jt & 3;
                if (nt < 2) { dst = (unsigned short*)(ws + WS_K) + (size_t)(tok0 + 32 * blk) * 384 + head * 96 + 32 * nt; pitch = 384; }
                else { dst = (unsigned short*)(ws + WS_V) + (size_t)(tok0 + 32 * blk) * 256 + head * 64 + 32 * (nt - 2); pitch = 256; } }
#pragma unroll
            for (int i2 = 0; i2 < 2; ++i2) { const int row = i2 * 16 + (lane >> 2), ch = lane & 3;
                *(u32x4*)(dst + (size_t)row * pitch + ch * 8) = *(const __attribute__((address_space(3))) u32x4*)(stg + row * 80 + ch * 16); }
            asm volatile("s_waitcnt lgkmcnt(0)" ::: "memory");
        }
    }
    {
        const int tid = wv * 64 + lane, tl = tid & 127, t = tok0 + tl, i0 = 4 * (tid >> 7);
        __attribute__((address_space(3))) const unsigned short* zr = (__attribute__((address_space(3))) const unsigned short*)(L + tl * 704 + O_KR * 2); const float* rk = (const float*)(ws + WS_ROPE) + (size_t)t * 32;
        __syncthreads();
        __attribute__((address_space(3))) unsigned short* rt = (__attribute__((address_space(3))) unsigned short*)(L + OSTG_OFF);
#pragma unroll
        for (int q = 0; q < 4; ++q) { const int i = i0 + q; const float x1 = bfu(zr[i]), x2 = bfu(zr[16 + i]), c = rk[2 * i], sn = rk[2 * i + 1];
            rt[tl * 32 + i] = (unsigned short)f2bf(x1 * c - x2 * sn); rt[tl * 32 + 16 + i] = (unsigned short)f2bf(x2 * c + x1 * sn); }
        __syncthreads();
        unsigned short* K = (unsigned short*)(ws + WS_K) + (size_t)tok0 * 384;
#pragma unroll
        for (int k = 0; k < 4; ++k) { const int cidx = tid + 512 * k, tok = cidx >> 4, hd = (cidx >> 2) & 3, part = cidx & 3;
            *(u32x4*)(K + (size_t)tok * 384 + hd * 96 + 64 + part * 8) = *(const __attribute__((address_space(3))) u32x4*)(rt + tok * 32 + part * 8); }
    }
    __syncthreads();
}

__device__ __forceinline__ float log_sigmoid(float x) { return fminf(x, 0.f) - 0.6931471805599453f * __builtin_amdgcn_logf(1.f + __builtin_amdgcn_exp2f(-1.4426950408889634f * fabsf(x))); }
__device__ __forceinline__ void p2_forget(KArgs ka, int l, int b, int tt, lptr L, int wv) {
    unsigned char* ws = ka->ws; const int lane = lane_id(), tid = wv * 64 + lane, h = tid & 3, j = tid >> 2;
    const float* FL = (const float*)(ws + WS_FL) + (size_t)b * S * 4; const float bf = ka->in[9][l * 4 + h];
    __attribute__((address_space(3))) double* red = (__attribute__((address_space(3))) double*)(L + 8 * STG_BYTES + 1024);
    __attribute__((address_space(3))) float* own = (__attribute__((address_space(3))) float*)(L + 8 * STG_BYTES + 1024 + 4096);
    double part = 0.0;
#pragma unroll 8
    for (int t = j; t < 128 * tt; t += 128) part += (double)log_sigmoid(FL[(size_t)t * 4 + h] + bf);
    red[h * 128 + j] = part; own[h * 128 + j] = log_sigmoid(FL[(size_t)(128 * tt + j) * 4 + h] + bf);
    __syncthreads();
    if (wv < 4) {
        const int hh = wv; double c = red[hh * 128 + 2 * lane] + red[hh * 128 + 2 * lane + 1];
#pragma unroll
        for (int o = 1; o < 64; o <<= 1) c += lshfl(c, lane ^ o);
        const float v0 = own[hh * 128 + 2 * lane], v1 = own[hh * 128 + 2 * lane + 1]; float s = v0 + v1, incl = s;
#pragma unroll
        for (int o = 1; o < 64; o <<= 1) { const float up = lshfl(incl, (lane - o) & 63); if (lane >= o) incl += up; }
        const double c0 = c + (double)(incl - s) + (double)v0, c1 = c0 + (double)v1;
        float* cbx = (float*)(ws + WS_CBX) + ((size_t)(b * 64 + 2 * tt) * 4 + hh) * 64;
#pragma unroll
        for (int q = 0; q < 2; ++q) { const int k128 = 2 * lane + q, tile = k128 >> 6, k = k128 & 63, khi = (k >> 2) & 1, n = k >> 5, r = (k & 3) + 4 * ((k & 31) >> 3);
            cbx[(size_t)tile * 256 + khi * 32 + n * 16 + r] = (float)(-(q ? c1 : c0) * 1.4426950408889634); }
    }
    __syncthreads();
}

__device__ __forceinline__ float gelu_tanh(float x) { const float u = 0.7978845608028654f * (x + 0.044715f * x * x * x); const float e = __expf(2.f * u); return x * (1.f - __builtin_amdgcn_rcpf(e + 1.f)); }
__device__ __forceinline__ void lru_load_table(KArgs ka, int l, lptr L, int wv) {
    const int tid = wv * 64 + lane_id(); __attribute__((address_space(3))) float* tab = (__attribute__((address_space(3))) float*)(L + LRU_TAB_OFF);
    const float* cw = ka->in[10] + (size_t)l * 4 * LRU_W; const float* cbias = ka->in[11] + (size_t)l * LRU_W;
    for (int i = tid; i < 5 * LRU_W; i += 512) tab[i] = i < 4 * LRU_W ? cw[i] : cbias[i - 4 * LRU_W];
    __syncthreads();
}
__device__ __forceinline__ void lru_pass1(KArgs ka, int l, int b, int tt, lptr L, int wv) {
    unsigned char* ws = ka->ws; const int lane = lane_id(), r32 = lane & 31, hi = lane >> 5;
    const int cb0 = 64 * wv, u = b * 32 + tt;
    const unsigned short* Z = (const unsigned short*)(ws + WS_Z); const size_t wl = WS_W + (size_t)l * W_LAYER;
    const __attribute__((address_space(3))) float* tab = (const __attribute__((address_space(3))) float*)(L + LRU_TAB_OFF) + cb0 + 8 * hi;
    bf16x8 idf[2];
#pragma unroll
    for (int q = 0; q < 2; ++q)
#pragma unroll
        for (int j = 0; j < 8; ++j) idf[q][j] = ((r32 >> 4) == q && (r32 & 15) == 8 * hi + j) ? (short)0x3f80 : (short)0;
    float A_run[2] = {1.f, 1.f}, H_run[2] = {0.f, 0.f};
    const unsigned short* zl = Z + (size_t)(b * S) * DINP + O_LX + cb0 + 8 * hi;
#define LRU_LOADZ(dst, sbi) do { const int t_ = 128 * tt + 32 * (sbi) + r32; const int tc_ = t_ < 0 ? 0 : t_; _Pragma("unroll") for (int ks = 0; ks < 4; ++ks) { \
        bf16x8 v_ = *reinterpret_cast<const bf16x8*>(zl + (size_t)tc_ * DINP + 16 * ks); if (t_ < 0) v_ = bf16x8{}; dst[ks] = v_; } } while (0)
    bf16x8 wrf[2][4], wif[2][4];
#pragma unroll
    for (int nt = 0; nt < 2; ++nt)
#pragma unroll
        for (int ks = 0; ks < 4; ++ks) { const size_t o = (size_t)wv * 4096 + (size_t)(nt * 4 + ks) * 512 + lane * 8;
            wrf[nt][ks] = *reinterpret_cast<const bf16x8*>((const unsigned short*)(ws + wl + W_R) + o); wif[nt][ks] = *reinterpret_cast<const bf16x8*>((const unsigned short*)(ws + wl + W_I) + o); }
    bf16x8 zprev[4], zcur[4], znext[4];
    LRU_LOADZ(zprev, -1); LRU_LOADZ(zcur, 0);
    for (int sb = 0; sb < 4; ++sb) {
        if (sb < 3) LRU_LOADZ(znext, sb + 1);
        bf16x8 af[4];
#pragma unroll
        for (int ks = 0; ks < 4; ++ks) {
            float xv[8];
            { const f32x4 b0 = *(const __attribute__((address_space(3))) f32x4*)(tab + 4 * LRU_W + 16 * ks), b1 = *(const __attribute__((address_space(3))) f32x4*)(tab + 4 * LRU_W + 16 * ks + 4);
              const f32x4 w0 = *(const __attribute__((address_space(3))) f32x4*)(tab + 3 * LRU_W + 16 * ks), w1 = *(const __attribute__((address_space(3))) f32x4*)(tab + 3 * LRU_W + 16 * ks + 4);
#pragma unroll
              for (int j = 0; j < 4; ++j) { xv[j] = b0[j] + w0[j] * bfu((unsigned short)zcur[ks][j]); xv[4 + j] = b1[j] + w1[j] * bfu((unsigned short)zcur[ks][4 + j]); } }
            const u32x4 cu = __builtin_bit_cast(u32x4, zcur[ks]), pu = __builtin_bit_cast(u32x4, zprev[ks]);
#pragma unroll
            for (int d = 1; d <= 3; ++d) {
                const int src = (((r32 - d) & 31) + 32 * hi) * 4; u32x4 sh;
#pragma unroll
                for (int q = 0; q < 4; ++q) { const unsigned c_ = (unsigned)__builtin_amdgcn_ds_bpermute(src, (int)cu[q]), p_ = (unsigned)__builtin_amdgcn_ds_bpermute(src, (int)pu[q]); sh[q] = r32 >= d ? c_ : p_; }
                const f32x4 w0 = *(const __attribute__((address_space(3))) f32x4*)(tab + (3 - d) * LRU_W + 16 * ks), w1 = *(const __attribute__((address_space(3))) f32x4*)(tab + (3 - d) * LRU_W + 16 * ks + 4);
                xv[0] += w0[0] * bf_lo(sh[0]); xv[1] += w0[1] * bf_hi(sh[0]); xv[2] += w0[2] * bf_lo(sh[1]); xv[3] += w0[3] * bf_hi(sh[1]);
                xv[4] += w1[0] * bf_lo(sh[2]); xv[5] += w1[1] * bf_hi(sh[2]); xv[6] += w1[2] * bf_lo(sh[3]); xv[7] += w1[3] * bf_hi(sh[3]); }
#pragma unroll
            for (int j = 0; j < 8; ++j) af[ks][j] = (short)f2bf(xv[j]);
        }
#pragma unroll
        for (int nt = 0; nt < 2; ++nt) {
            __builtin_amdgcn_sched_barrier(0);
            const int ch = cb0 + 32 * nt + r32;
            f32x16 rp = f32x16{}, ip = f32x16{}, xc = f32x16{};
#pragma unroll
            for (int ks = 0; ks < 4; ++ks) { rp = MID_MFMA(af[ks], wrf[nt][ks], rp); ip = MID_MFMA(af[ks], wif[nt][ks], ip); }
            xc = MID_MFMA(af[2 * nt], idf[0], xc); xc = MID_MFMA(af[2 * nt + 1], idf[1], xc);
            u32x4 pk[4];
            {   const float br = ka->in[13][l * LRU_W + ch], bi = ka->in[15][l * LRU_W + ch]; const float nl = -ka->in[16][l * LRU_W + ch]; const float la8 = -8.0f * (fmaxf(nl, 0.f) + 0.6931471805599453f * __builtin_amdgcn_logf(1.f + __builtin_amdgcn_exp2f(-1.4426950408889634f * fabsf(nl))));
#pragma unroll
                for (int r = 0; r < 16; ++r) { const float rg = __builtin_amdgcn_rcpf(1.f + __expf(-(rp[r] + br))), ig = __builtin_amdgcn_rcpf(1.f + __expf(-(ip[r] + bi)));
                    const float a = __expf(rg * la8); rp[r] = 1.f - a; ip[r] = __builtin_amdgcn_sqrtf(fmaxf(1.f - a * a, 0.f)) * (ig * xc[r]); }
#pragma unroll
                for (int r = 0; r < 16; r += 2) { const unsigned wa = pk2(rp[r], rp[r + 1]), wb = pk2(ip[r], ip[r + 1]); pk[r >> 3][(r >> 1) & 3] = wa; pk[2 + (r >> 3)][(r >> 1) & 3] = wb;
                    rp[r] = 1.f - bf_lo(wa); rp[r + 1] = 1.f - bf_hi(wa); ip[r] = bf_lo(wb); ip[r + 1] = bf_hi(wb); } }
            { u32x4* dst = (u32x4*)(ws + WS_PP) + ((((size_t)u * 8 + wv) * 4 + sb) * 2 + nt) * 256 + lane * 4;
#pragma unroll
              for (int q = 0; q < 4; ++q) dst[q] = pk[q]; }
            float st = H_run[nt], ap = A_run[nt];
#pragma unroll
            for (int g = 0; g < 4; ++g) { float A = 1.f, Bv = 0.f;
#pragma unroll
                for (int q = 0; q < 4; ++q) { const float a = rp[4 * g + q]; Bv = a * Bv + ip[4 * g + q]; A *= a; }
                auto ta = __builtin_amdgcn_permlane32_swap(__float_as_uint(A), __float_as_uint(A), false, false); auto tb = __builtin_amdgcn_permlane32_swap(__float_as_uint(Bv), __float_as_uint(Bv), false, false);
                const float oA = __uint_as_float(hi ? ta[0] : ta[1]), oB = __uint_as_float(hi ? tb[0] : tb[1]);
                const float pA = hi ? oA : A, pB = hi ? oB : Bv, qA = hi ? A : oA, qB = hi ? Bv : oB;
                st = pA * st + pB; st = qA * st + qB; ap *= pA * qA; }
            H_run[nt] = st; A_run[nt] = ap;
        }
#pragma unroll
        for (int ks = 0; ks < 4; ++ks) { zprev[ks] = zcur[ks]; zcur[ks] = znext[ks]; }
    }
#undef LRU_LOADZ
    if (hi == 0) {
#pragma unroll
        for (int nt = 0; nt < 2; ++nt) { float* sum = (float*)(ws + WS_LRUSUM) + (size_t)u * 1024 + cb0 + 32 * nt + r32; sum[0] = A_run[nt]; sum[512] = H_run[nt]; } }
}
__device__ __forceinline__ void lru_pass2(KArgs ka, int l, int b, int tt, lptr L, int wv) {
    unsigned char* ws = ka->ws; const int lane = lane_id(), r32 = lane & 31, hi = lane >> 5;
    const int tok0 = b * S + 128 * tt, cb0 = 64 * wv, u = b * 32 + tt;
    const unsigned short* Z = (const unsigned short*)(ws + WS_Z);
    bf16x8 idf[2];
#pragma unroll
    for (int q = 0; q < 2; ++q)
#pragma unroll
        for (int j = 0; j < 8; ++j) idf[q][j] = ((r32 >> 4) == q && (r32 & 15) == 8 * hi + j) ? (short)0x3f80 : (short)0;
    float H_run[2] = {0.f, 0.f};
    { const float* sum = (const float*)(ws + WS_LRUSUM) + (size_t)(b * 32) * 1024;
#pragma unroll 8
      for (int t2 = 0; t2 < tt; ++t2)
#pragma unroll
          for (int nt = 0; nt < 2; ++nt) { const int ch = cb0 + 32 * nt + r32; H_run[nt] = sum[(size_t)t2 * 1024 + ch] * H_run[nt] + sum[(size_t)t2 * 1024 + 512 + ch]; } }
    __attribute__((address_space(3))) float* otile = (__attribute__((address_space(3))) float*)L;
    const u32x4* ab = (const u32x4*)(ws + WS_PP) + (((size_t)u * 8 + wv) * 4) * 2 * 256 + lane * 4;
    u32x4 pk[2][4]; bf16x8 lg[4];
#define LRU_LOAD2(sbi) do { _Pragma("unroll") for (int nt = 0; nt < 2; ++nt) _Pragma("unroll") for (int q = 0; q < 4; ++q) pk[nt][q] = ab[((size_t)(sbi) * 2 + nt) * 256 + q]; \
        _Pragma("unroll") for (int ks = 0; ks < 4; ++ks) lg[ks] = *reinterpret_cast<const bf16x8*>(Z + (size_t)(tok0 + 32 * (sbi) + r32) * DINP + O_LG + cb0 + 16 * ks + 8 * hi); } while (0)
    LRU_LOAD2(0);
    for (int sb = 0; sb < 4; ++sb) {
        float av[2][16], bv[2][16]; f32x16 lgc[2];
#pragma unroll
        for (int nt = 0; nt < 2; ++nt) {
#pragma unroll
            for (int r = 0; r < 16; r += 2) { const unsigned wa = pk[nt][r >> 3][(r >> 1) & 3], wb = pk[nt][2 + (r >> 3)][(r >> 1) & 3];
                av[nt][r] = 1.f - bf_lo(wa); av[nt][r + 1] = 1.f - bf_hi(wa); bv[nt][r] = bf_lo(wb); bv[nt][r + 1] = bf_hi(wb); }
            lgc[nt] = f32x16{}; lgc[nt] = MID_MFMA(lg[2 * nt], idf[0], lgc[nt]); lgc[nt] = MID_MFMA(lg[2 * nt + 1], idf[1], lgc[nt]); }
        if (sb < 3) LRU_LOAD2(sb + 1);
#pragma unroll
        for (int nt = 0; nt < 2; ++nt) {
            const int ch = cb0 + 32 * nt + r32; float carry[4]; float st = H_run[nt];
#pragma unroll
            for (int g = 0; g < 4; ++g) { float A = 1.f, Bv = 0.f;
#pragma unroll
                for (int q = 0; q < 4; ++q) { const float a = av[nt][4 * g + q]; Bv = a * Bv + bv[nt][4 * g + q]; A *= a; }
                auto ta = __builtin_amdgcn_permlane32_swap(__float_as_uint(A), __float_as_uint(A), false, false); auto tb = __builtin_amdgcn_permlane32_swap(__float_as_uint(Bv), __float_as_uint(Bv), false, false);
                const float oA = __uint_as_float(hi ? ta[0] : ta[1]), oB = __uint_as_float(hi ? tb[0] : tb[1]);
                const float pA = hi ? oA : A, pB = hi ? oB : Bv, qA = hi ? A : oA, qB = hi ? Bv : oB;
                const float c0 = st; st = pA * st + pB; const float c1 = st; st = qA * st + qB; carry[g] = hi ? c1 : c0; }
            H_run[nt] = st;
#pragma unroll
            for (int g = 0; g < 4; ++g) { float hcur = carry[g];
#pragma unroll
                for (int q = 0; q < 4; ++q) { const int r = 4 * g + q; hcur = av[nt][r] * hcur + bv[nt][r]; otile[(sb & 1) * 16384 + crow(r, hi) * 512 + ch] = hcur * gelu_tanh(lgc[nt][r]); } }
        }
        __syncthreads();
#pragma unroll
        for (int q = 0; q < 4; ++q) { const int row = 4 * wv + q; const __attribute__((address_space(3))) float* src = otile + (sb & 1) * 16384 + row * 512 + 8 * lane;
            const f32x4 x0 = *(const __attribute__((address_space(3))) f32x4*)src, x1 = *(const __attribute__((address_space(3))) f32x4*)(src + 4);
            float s = (x0[0] * x0[0] + x0[1] * x0[1]) + (x0[2] * x0[2] + x0[3] * x0[3]) + (x1[0] * x1[0] + x1[1] * x1[1]) + (x1[2] * x1[2] + x1[3] * x1[3]);
            s = wave_sum(s, lane); const float rn = rsqrtf(s * (1.0f / 512.0f) + EPS);
            u32x4 o; o.x = pk2(x0[0] * rn, x0[1] * rn); o.y = pk2(x0[2] * rn, x0[3] * rn); o.z = pk2(x1[0] * rn, x1[1] * rn); o.w = pk2(x1[2] * rn, x1[3] * rn);
            *(u32x4*)((unsigned short*)(ws + WS_O) + (size_t)(tok0 + 32 * sb + row) * D + 512 + 8 * lane) = o; }
    }
#undef LRU_LOAD2
#pragma unroll
    for (int q0 = 0; q0 < 16; q0 += 8) { u32x4 v[8]; unsigned short* p0 = (unsigned short*)(ws + WS_O) + (size_t)(tok0 + 16 * wv + q0) * D + 8 * lane;
#pragma unroll
        for (int q = 0; q < 8; ++q) v[q] = *(const u32x4*)(p0 + (size_t)q * D);
#pragma unroll
        for (int q = 0; q < 8; ++q) {
            float f[8] = {bf_lo(v[q].x), bf_hi(v[q].x), bf_lo(v[q].y), bf_hi(v[q].y), bf_lo(v[q].z), bf_hi(v[q].z), bf_lo(v[q].w), bf_hi(v[q].w)};
            float s = 0.f;
#pragma unroll
            for (int j = 0; j < 8; ++j) s += f[j] * f[j];
#pragma unroll
            for (int o = 1; o < 32; o <<= 1) s += lshfl(s, lane ^ o);
            const float rn = rsqrtf(s * (1.0f / 256.0f) + EPS);
            u32x4 w; w.x = pk2(f[0] * rn, f[1] * rn); w.y = pk2(f[2] * rn, f[3] * rn); w.z = pk2(f[4] * rn, f[5] * rn); w.w = pk2(f[6] * rn, f[7] * rn); *(u32x4*)(p0 + (size_t)q * D) = w; } }
}
}
__device__ __forceinline__ int zcol_perm(int n) { return n < 1120 ? n : (n < 1124 ? 2144 + (n - 1120) : (n < DIN ? n - 4 : n)); }
__device__ __forceinline__ int up_perm(int n) { return n < DFF ? 256 * (n >> 7) + (n & 127) : 256 * ((n - DFF) >> 7) + 128 + ((n - DFF) & 127); }
__device__ __forceinline__ void tr_item(const float* W, int K, int N, const float* g, bf16* WT, int mode, LAS float* scr, int kb, int nb, int lane) {
    const int k0 = 64 * kb, n0 = 32 * nb;
#pragma unroll 8
    for (int i = 0; i < 32; ++i) { const int kk = 2 * i + (lane >> 5), n = n0 + (lane & 31); float v = (n < N) ? W[(size_t)(k0 + kk) * N + n] : 0.f; if (g) v *= g[k0 + kk]; scr[kk * 33 + (lane & 31)] = v; }
    LDS_WAIT(); asm volatile("" ::: "memory");
    const int c = lane & 7;
#pragma unroll
    for (int j = 0; j < 4; ++j) { const int nl = (lane >> 3) + 8 * j, n = n0 + nl; const int dest = mode == 1 ? up_perm(n) : (mode == 2 ? zcol_perm(n) : n); const LAS float* s = scr + (8 * c) * 33 + nl;
        v4u o; o.x = pk2(s[0 * 33], s[1 * 33]); o.y = pk2(s[2 * 33], s[3 * 33]); o.z = pk2(s[4 * 33], s[5 * 33]); o.w = pk2(s[6 * 33], s[7 * 33]);
        if (mode == 3) { const int c8 = (k0 >> 3) + c;
            *(GAS v4u*)(WT + ((size_t)((n >> 5) * (K >> 4) + (c8 >> 1)) * 64 + (c8 & 1) * 32 + (n & 31)) * 8) = o; }
        else *(GAS v4u*)(WT + (size_t)dest * K + k0 + 8 * c) = o; }
    LDS_WAIT(); asm volatile("" ::: "memory");
}
__global__ void __launch_bounds__(NWAVES * 64, 2) mega(Args args) {
    extern __shared__ __attribute__((aligned(16))) unsigned char lds[];
    LAS unsigned char* L = (LAS unsigned char*)lds;
    const int wave = __builtin_amdgcn_readfirstlane((int)threadIdx.x >> 6);
    {
        const int t0 = wave * 64 + lane_id();
        for (int u = t0; u < (LDS_BYTES - LDSCTL_OFF) / 4; u += NWAVES * 64) ((LAS unsigned*)(L + LDSCTL_OFF))[u] = 0u;
        __syncthreads();
        if (kargs()->ph_hi - kargs()->ph_lo > 1) (void)xcd_barrier_post((unsigned*)(kargs()->ws + WS_CTL) + CW_BAR, (volatile LAS unsigned*)(L + MISC_OFF) + 8);
    }
#define GRID_BAR(p) do { if (IN(p) && IN((p) + 1)) { XcdBarrier gb_; gb_.bar = (unsigned*)(kargs()->ws + WS_CTL) + CW_BAR; gb_.x = xb_xcc_id(); gb_.st = (volatile LAS unsigned*)(L + MISC_OFF) + 8; xcd_barrier(gb_); } } while (0)
#define GRID_IDS int G = gridDim.x, bx = blockIdx.x, wv = wave; asm volatile("" : "+s"(G), "+s"(bx), "+s"(wv)); const int vcu = (G % 8 == 0) ? (bx % 8) * (G / 8) + bx / 8 : bx; const int gw = vcu * NWAVES + wv, NGW = G * NWAVES; (void)gw; (void)NGW
#ifndef PH_MASK
#define PH_MASK 0xFFFFFF
#endif
#ifndef REPEAT_MASK
#define REPEAT_MASK 0
#endif
#define IN(p) (kargs()->ph_lo <= (p) && (p) < kargs()->ph_hi)
#define PHASE_PTRS const KArgs ka = kargs(); unsigned char* ws = ka->ws; (void)ws; GRID_IDS
#define LANE_IDS const int lane = lane_id(), tid = wv * 64 + lane; (void)tid
    if ((PH_MASK & 1) && IN(0)) {
            PHASE_PTRS; LANE_IDS; bf16* HB = (bf16*)(ws + WS_HB); float* SSA = (float*)(ws + WS_SSA);
            LAS float* scr = (LAS float*)(L + RING_OFF + wv * 16384);
            {
                constexpr int I_IN = (D / 64) * (DINP / 32), I_O = (D / 64) * (D / 32), I_UP = (D / 64) * (2 * DFF / 32), I_DN = (DFF / 64) * (D / 32), I_PG = I_O, I_PP = (PLE / 64) * (D / 32);
                constexpr int I_UQ = (192 / 64) * (384 / 32), I_UKV = (128 / 64) * (512 / 32), I_RI = 32;
                constexpr int I_LAYER = I_IN + I_O + I_UP + I_DN + I_PG + I_PP + I_UQ + I_UKV + I_RI;
                for (int it0 = gw; it0 < DEPTH * I_LAYER; it0 += NGW) {
                    const int ll = it0 / I_LAYER; int it = it0 % I_LAYER;
                    unsigned char* w2 = ws + WS_W + (size_t)ll * W_LAYER;
                    const float* W; const float* gs; bf16* WT; int K, N, Npad, mode = 0;
                    if (it < I_IN) { W = ka->in[4] + (size_t)ll * D * DIN; gs = ka->in[3] + ll * D; WT = (bf16*)(w2 + W_IN); K = D; N = DIN; Npad = DINP; mode = 2; }
                    else if ((it -= I_IN) < I_O) { W = ka->in[18] + (size_t)ll * D * D; gs = ka->in[17] + ll * D; WT = (bf16*)(w2 + W_O); K = D; N = D; Npad = D; }
                    else if ((it -= I_O) < I_UP) { W = ka->in[20] + (size_t)ll * D * 2 * DFF; gs = ka->in[19] + ll * D; WT = (bf16*)(w2 + W_UP); K = D; N = 2 * DFF; Npad = 2 * DFF; mode = 1; }
                    else if ((it -= I_UP) < I_DN) { W = ka->in[23] + (size_t)ll * DFF * D; gs = nullptr; WT = (bf16*)(w2 + W_DN); K = DFF; N = D; Npad = D; }
                    else if ((it -= I_DN) < I_PG) { W = ka->in[25] + (size_t)ll * D * D; gs = ka->in[24] + ll * D; WT = (bf16*)(w2 + W_PG); K = D; N = D; Npad = D; }
                    else if ((it -= I_PG) < I_PP) { W = ka->in[26] + (size_t)ll * PLE * D; gs = nullptr; WT = (bf16*)(w2 + W_PP); K = PLE; N = D; Npad = D; }
                    else if ((it -= I_PP) < I_UQ) { W = ka->in[6] + (size_t)ll * 192 * 384; gs = ka->in[5] + ll * 192; WT = (bf16*)(w2 + W_UQ); K = 192; N = 384; Npad = 384; mode = 3; }
                    else if ((it -= I_UQ) < I_UKV) { W = ka->in[8] + (size_t)ll * 128 * 512; gs = ka->in[7] + ll * 128; WT = (bf16*)(w2 + W_UKV); K = 128; N = 512; Npad = 512; mode = 3; }
                    else { it -= I_UKV; const int mi = it >> 1; it &= 1;
                        W = (mi < 8 ? ka->in[12] : ka->in[14]) + ((size_t)ll * 8 + (mi & 7)) * 4096; gs = nullptr; WT = (bf16*)(w2 + (mi < 8 ? W_R : W_I)) + (size_t)(mi & 7) * 4096; K = 64; N = 64; Npad = 64; mode = 3; }
                    const int nblk = Npad / 32;
                    tr_item(W, K, N, gs, WT, mode, scr, it / nblk, it % nblk, lane);
                }
            }
            const float* x = ka->in[0];
            for (int m = gw; m < M; m += NGW) {
                const GAS f32x4* xr = (const GAS f32x4*)(x + (size_t)m * D) + lane;
                f32x4 v[4]; float s = 0.f;
#pragma unroll
                for (int j = 0; j < 4; ++j) { v[j] = xr[64 * j]; s += (v[j].x * v[j].x + v[j].y * v[j].y) + (v[j].z * v[j].z + v[j].w * v[j].w); }
                s = wave_sum(s, lane);
                GAS unsigned long long* o8 = (GAS unsigned long long*)(HB + (size_t)m * D) + lane;
#pragma unroll
                for (int j = 0; j < 4; ++j) o8[64 * j] = (unsigned long long)pk2(v[j].x, v[j].y) | ((unsigned long long)pk2(v[j].z, v[j].w) << 32);
                if (lane < 4) { f32x4 z4 = {lane == 0 ? s : 0.f, 0.f, 0.f, 0.f}; *(f32x4*)(SSA + (size_t)m * 16 + lane * 4) = z4; }
            }
            {
                float* rope = (float*)(ws + WS_ROPE); const int* pos = (const int*)ka->in[2];
                for (int i = bx * 512 + tid; i < M * 16; i += G * 512) { const int t = i >> 4, f = i & 15;
                    const float ang = (float)pos[t] * __builtin_amdgcn_exp2f(-0.8304820237218406f * (float)f);
                    double rv = (double)ang * 0.15915494309189535; rv -= __builtin_floor(rv); const float fr = (float)rv;
                    rope[2 * i] = __builtin_amdgcn_cosf(fr); rope[2 * i + 1] = __builtin_amdgcn_sinf(fr); }
            }
            {
                float* cwt = (float*)(ws + WS_CWT);
                for (int i = bx * 512 + tid; i < DEPTH * 704 * 32; i += G * 512) {
                    const int e = i & 3, slot = (i >> 2) & 7, jg = (i >> 5) % 704, ll = i / (704 * 32);
                    const int col = (slot < 4 ? 0 : DFF) + 4 * jg + e, k = slot & 3;
                    cwt[i] = (slot < 4 ? -1.4426950408889634f : -0.6931471805599453f) * (k < 3 ? ka->in[21][(size_t)ll * 3 * 2 * DFF + (size_t)k * 2 * DFF + col] : ka->in[22][(size_t)ll * 2 * DFF + col]);
                }
            }
            const float* p = ka->in[1]; bf16* PB = (bf16*)(ws + WS_PB);
            const size_t n8 = (size_t)DEPTH * M * PLE / 8;
            for (size_t i = (size_t)bx * 512 + tid; i < n8; i += (size_t)G * 512) {
                const f32x4 a = *(const f32x4*)(p + i * 8), b = *(const f32x4*)(p + i * 8 + 4);
                v4u o; o.x = pk2(a.x, a.y); o.y = pk2(a.z, a.w); o.z = pk2(b.x, b.y); o.w = pk2(b.z, b.w);
                *(v4u*)(PB + i * 8) = o;
            }
        }
    GRID_BAR(0);
    for (int l = 0; l < DEPTH; ++l) {
        const size_t wl = WS_W + (size_t)l * W_LAYER;
        if ((PH_MASK & (1 << 1)) && IN(8 * l + 1)) { for (int rep_ = 0; rep_ < ((REPEAT_MASK >> 1) & 1) + 1; ++rep_) { if (rep_) { XcdBarrier gb_; gb_.bar = (unsigned*)(kargs()->ws + WS_CTL) + CW_BAR; gb_.x = xb_xcc_id(); gb_.st = (volatile LAS unsigned*)(L + MISC_OFF) + 8; xcd_barrier(gb_); }
            PHASE_PTRS;
            pg8::Gemm g{l == 0 ? (const bf16*)(ws + WS_HB) : (const bf16*)ka->out, (const bf16*)(ws + wl + W_IN), M, DINP, D}; pg8::StatOrder So; So.init(M, DINP, G, bx); So.ss_sel = l; So.row62 = 0; So.wave = wv; So.cwt_layer = 0;
            pg8::EpiZ E{l};
            pg8::gemm_phase<pg8::EpiZ, pg8::StatOrder, true, true, false, D>(L + RING_OFF, g, So, E, wv);
            {
                pg8::Gemm gp{(const bf16*)(ws + WS_PB) + (size_t)l * M * PLE, (const bf16*)(ws + wl + W_PP), M, D, PLE}; pg8::TailOrder To; To.init(M, D, G, bx);
                To.c0 = ((M / 256) * (DINP / 256)) % G; To.u0 = 0; To.u1 = 256; if (To.c0 == 0) To.u1 = 0;
                pg8::EpiPP Ep{0};
                pg8::gemm_phase<pg8::EpiPP, pg8::TailOrder, true, true, false, PLE>(L + RING_OFF, gp, To, Ep, wv); }
        } }
        GRID_BAR(8 * l + 1);
        if ((PH_MASK & (1 << 2)) && IN(8 * l + 2)) { for (int rep_ = 0; rep_ < ((REPEAT_MASK >> 2) & 1) + 1; ++rep_) { if (rep_) { XcdBarrier gb_; gb_.bar = (unsigned*)(kargs()->ws + WS_CTL) + CW_BAR; gb_.x = xb_xcc_id(); gb_.st = (volatile LAS unsigned*)(L + MISC_OFF) + 8; xcd_barrier(gb_); }
            PHASE_PTRS;
            mid::lru_load_table(ka, l, (mid::lptr)L, wv);
            for (int u = vcu; u < 256; ) {
                const KArgs k2 = kargs(); const int b = u >> 5, tt = u & 31;
                int w2 = wv;
                asm volatile("" : "+s"(w2)); mid::lru_pass1(kargs(), l, b, tt, (mid::lptr)(L + RING_OFF), w2);
                __syncthreads();
                asm volatile("" : "+s"(w2)); mid::p2_latent(k2, l, b * S + 128 * tt, (mid::lptr)(L + RING_OFF), w2);
                asm volatile("" : "+s"(w2)); mid::p2_forget(kargs(), l, b, tt, (mid::lptr)(L + RING_OFF), w2);
                int g2 = gridDim.x; asm volatile("" : "+s"(g2)); u += g2;
            }
        } }
        GRID_BAR(8 * l + 2);
        if ((PH_MASK & (1 << 3)) && IN(8 * l + 3)) { for (int rep_ = 0; rep_ < ((REPEAT_MASK >> 3) & 1) + 1; ++rep_) { if (rep_) { XcdBarrier gb_; gb_.bar = (unsigned*)(kargs()->ws + WS_CTL) + CW_BAR; gb_.x = xb_xcc_id(); gb_.st = (volatile LAS unsigned*)(L + MISC_OFF) + 8; xcd_barrier(gb_); }
            PHASE_PTRS;
            for (int v = vcu; v < 256; ) {
                const int stream = v >> 2, s4 = v & 3, mixer = stream & 1, bh = stream >> 1, b = bh >> 2, h = bh & 3;
                if (mixer == 0) {
                    for (int i = 0; i < 2; ++i) {
                        const int qb = (i == 0) ? s4 : 7 - s4;
                        unsigned char* ws = kargs()->ws;
                        att::attn_unit<6, false>((const bf16*)(ws + WS_Q) + (size_t)b * S * 384 + h * 96, 384, (const bf16*)(ws + WS_K) + (size_t)b * S * 384 + h * 96, 384,
                                                 (const bf16*)(ws + WS_V) + (size_t)b * S * 256 + h * 64, 256, (bf16*)(ws + WS_O) + (size_t)b * S * D + h * 64, D, nullptr, 0, qb, (att::lptr)(L + RING_OFF), wv);
                    }
                } else {
                    for (int i = 0; i < 2; ++i) {
                        const int qb = (i == 0) ? s4 : 7 - s4;
                        unsigned char* ws = kargs()->ws;
                        att::attn_unit<4, true>((const bf16*)(ws + WS_Z) + (size_t)b * S * DINP + O_FQ + h * 64, DINP, (const bf16*)(ws + WS_Z) + (size_t)b * S * DINP + O_FK + h * 64, DINP,
                                                (const bf16*)(ws + WS_Z) + (size_t)b * S * DINP + O_FV + h * 64, DINP, (bf16*)(ws + WS_O) + (size_t)b * S * D + 256 + h * 64, D,
                                                (const float*)(ws + WS_CBX) + (size_t)b * 64 * 256, h, qb, (att::lptr)(L + RING_OFF), wv);
                    }
                }
                int g2 = gridDim.x; asm volatile("" : "+s"(g2)); v += g2;
            }
        } }
        GRID_BAR(8 * l + 3);
        if ((PH_MASK & (1 << 4)) && IN(8 * l + 4)) { for (int rep_ = 0; rep_ < ((REPEAT_MASK >> 4) & 1) + 1; ++rep_) { if (rep_) { XcdBarrier gb_; gb_.bar = (unsigned*)(kargs()->ws + WS_CTL) + CW_BAR; gb_.x = xb_xcc_id(); gb_.st = (volatile LAS unsigned*)(L + MISC_OFF) + 8; xcd_barrier(gb_); }
            PHASE_PTRS;
            for (int u = vcu; u < 256; ) {
                const KArgs k2 = kargs(); const int b = u >> 5, tt = u & 31;
                int w2 = wv; asm volatile("" : "+s"(w2)); mid::lru_pass2(k2, l, b, tt, (mid::lptr)(L + RING_OFF), w2);
                __syncthreads();
                int g2 = gridDim.x; asm volatile("" : "+s"(g2)); u += g2;
            }
        } }
        GRID_BAR(8 * l + 4);
        if ((PH_MASK & (1 << 5)) && IN(8 * l + 5)) {
            PHASE_PTRS;
            pg8::Gemm g{(const bf16*)(ws + WS_O), (const bf16*)(ws + wl + W_O), M, D, D}; pg8::StaticOrder So; So.init(M, D, G, bx);
            pg8::EpiRes<0> E{l == 0 ? 0 : 1, 0, l == 0 ? 1 : 0};
            pg8::gemm_phase<pg8::EpiRes<0>, pg8::StaticOrder, true, true, false, D>(L + RING_OFF, g, So, E, wv);
        }
        GRID_BAR(8 * l + 5);
        if ((PH_MASK & (1 << 6)) && IN(8 * l + 6)) { for (int rep_ = 0; rep_ < ((REPEAT_MASK >> 6) & 1) + 1; ++rep_) { if (rep_) { XcdBarrier gb_; gb_.bar = (unsigned*)(kargs()->ws + WS_CTL) + CW_BAR; gb_.x = xb_xcc_id(); gb_.st = (volatile LAS unsigned*)(L + MISC_OFF) + 8; xcd_barrier(gb_); }
            PHASE_PTRS;
            pg8::Gemm g{(const bf16*)(ws + WS_HB) - 2 * D, (const bf16*)(ws + wl + W_UP), 133 * 256, 2 * DFF, D}; pg8::StatOrder So; So.init(133 * 256, 2 * DFF, G, bx); So.ss_sel = l == 0 ? 1 : 0; So.row62 = 1; So.wave = wv; So.cwt_layer = l;
            pg8::EpiUp E{l, l == 0 ? 1 : 0};
            pg8::gemm_phase<pg8::EpiUp, pg8::StatOrder, true, true, true, D>(L + RING_OFF, g, So, E, wv);
            {   pg8::Gemm gp{(const bf16*)(ws + WS_PB) + (size_t)l * M * PLE, (const bf16*)(ws + wl + W_PP), M, D, PLE}; pg8::TailOrder To; To.init(M, D, G, bx);
                To.c0 = (133 * (2 * DFF / 256)) % G; To.u0 = (((M / 256) * (DINP / 256)) % G) ? 256 : 0; To.u1 = 512;
                pg8::EpiPP Ep{0};
                pg8::gemm_phase<pg8::EpiPP, pg8::TailOrder, true, true, false, PLE>(L + RING_OFF, gp, To, Ep, wv); }
        } }
        GRID_BAR(8 * l + 6);
        if ((PH_MASK & (1 << 7)) && IN(8 * l + 7)) {
            PHASE_PTRS;
            pg8::Gemm g{(const bf16*)(ws + WS_ACT), (const bf16*)(ws + wl + W_DN), M, D, DFF}; pg8::StaticOrder So; So.init(M, D, G, bx);
            pg8::EpiRes<0> E{0, 0, l == 0 ? 0 : 1};
            pg8::gemm_phase<pg8::EpiRes<0>, pg8::StaticOrder, true, true, false, DFF>(L + RING_OFF, g, So, E, wv);
        }
        GRID_BAR(8 * l + 7);
        if ((PH_MASK & (1 << 8)) && IN(8 * l + 8)) {
            PHASE_PTRS;
            {   pg8::Gemm g{(const bf16*)(ws + WS_HB), (const bf16*)(ws + wl + W_PG), M, D, D}; pg8::StatOrder So; So.init(M, D, G, bx); So.ss_sel = l == 0 ? 0 : 1; So.row62 = 0; So.wave = wv; So.cwt_layer = 0;
                pg8::EpiRes<1> E{0, l == 0 ? 1 : 2, l == 0 ? 1 : 0};
                pg8::gemm_phase<pg8::EpiRes<1>, pg8::StatOrder, true, true, false, D>(L + RING_OFF, g, So, E, wv); }
        }
        GRID_BAR(8 * l + 8);
    }
    if ((PH_MASK & (1 << 17)) && IN(17)) {
            PHASE_PTRS; LANE_IDS; const float* gf = ka->in[27]; const float* ss = (const float*)(ws + WS_SSA); float* H = ka->out;
            const bf16* hb = (const bf16*)(ws + WS_O);
            for (int m = gw; m < M; m += NGW) {
                const float rs = pg8::rstd16(ss, m);
#pragma unroll
                for (int j = 0; j < 2; ++j) { const v4u w = *((const GAS v4u*)(hb + (size_t)m * D) + lane + 64 * j); const int c0 = (lane + 64 * j) * 8;
                    const f32x4 g0 = *(const GAS f32x4*)(gf + c0), g1 = *(const GAS f32x4*)(gf + c0 + 4);
                    f32x4 o0 = {pg8::bf_lo(w.x), pg8::bf_hi(w.x), pg8::bf_lo(w.y), pg8::bf_hi(w.y)}, o1 = {pg8::bf_lo(w.z), pg8::bf_hi(w.z), pg8::bf_lo(w.w), pg8::bf_hi(w.w)};
                    o0 = o0 * rs * g0; o1 = o1 * rs * g1;
                    *(GAS f32x4*)(H + (size_t)m * D + c0) = o0; *(GAS f32x4*)(H + (size_t)m * D + c0 + 4) = o1; }
            }
    }
}

extern "C" void kernel_launch(void* const* d_in, const int* in_sizes, int n_in, void* d_out, int out_size, void* d_ws, size_t ws_size, hipStream_t stream) {
    static int grid = 0;
    if (grid == 0) {
        int dev = 0, cus = 0;
        if (hipGetDevice(&dev) != hipSuccess || hipDeviceGetAttribute(&cus, hipDeviceAttributeMultiprocessorCount, dev) != hipSuccess) { grid = -1; return; }
        if (hipFuncSetAttribute((const void*)mega, hipFuncAttributeMaxDynamicSharedMemorySize, LDS_BYTES) != hipSuccess) { fprintf(stderr, "hipFuncSetAttribute failed\n"); grid = -1; return; }
        grid = cus;
        if (ws_size < WS_END) { fprintf(stderr, "workspace too small: %zu < %zu\n", ws_size, (size_t)WS_END); grid = -1; return; }
    }
    if (grid < 0) return;
    (void)hipMemsetAsync((char*)d_ws + WS_CTL, 0, CTL_ZERO_BYTES, stream);
    Args a{};
    for (int i = 0; i < 28; ++i) a.in[i] = (const float*)d_in[i];
    a.out = (float*)d_out; a.ws = (unsigned char*)d_ws;
#ifndef N_LAUNCH_MODE
#define N_LAUNCH_MODE 1
#endif
    auto run = [&](int lo, int hi) { a.ph_lo = lo; a.ph_hi = hi; hipLaunchKernelGGL(mega, dim3(grid), dim3(NWAVES * 64), LDS_BYTES, stream, a); };
    if (N_LAUNCH_MODE == 1) run(0, 18);
    else for (int ph = 0; ph < 18; ++ph) run(ph, ph + 1);
}
```

```cpp
#include <hip/hip_runtime.h>
#include <cstdio>
#include <cstdint>
#include <math.h>
constexpr int D = 1024, NB = 8, S = 4096, DEPTH = 2, PLE = 256, M = NB * S;
constexpr int DIN = 2148, DINP = 2304;
constexpr int O_QC = 0, O_KVC = 192, O_KR = 320, O_FQ = 352, O_FK = 608, O_FV = 864, O_LX = 1120, O_LG = 1632, O_FL = 2144;
constexpr int DFF = 2816, LRU_W = 512;
constexpr float EPS = 1e-6f;
constexpr int NWAVES = 8;
constexpr size_t MiB = 1u << 20;
constexpr size_t WS_CTL = 0, CTL_ZERO_BYTES = 1 * MiB;
constexpr size_t WS_SSA = 1 * MiB, WS_SSB = 3 * MiB, WS_FL = 5 * MiB, WS_CBX = 5632 * 1024, WS_CWT = 6 * MiB, WS_LRUSUM = 6656 * 1024, WS_ROPE = 7680 * 1024;
constexpr size_t WS_W = 12 * MiB, W_LAYER = 27 * MiB;
constexpr size_t W_IN = 0, W_UQ = 4608 * 1024, W_UKV = 4864 * 1024, W_R = 5120 * 1024, W_I = 5184 * 1024, W_O = 5632 * 1024, W_UP = 7680 * 1024, W_DN = 18944 * 1024, W_PG = 24576 * 1024, W_PP = 26624 * 1024;
constexpr size_t WS_HB = 68 * MiB;
constexpr size_t WS_PB = 133 * MiB;
constexpr size_t WS_PP = 165 * MiB;
constexpr size_t WS_Z = 229 * MiB;
constexpr size_t WS_Q = 373 * MiB, WS_K = 397 * MiB, WS_V = 421 * MiB;
constexpr size_t WS_O = 437 * MiB;
constexpr size_t WS_ACT = 229 * MiB;
constexpr size_t WS_END = 501 * MiB;
static_assert(WS_ACT + (size_t)M * DFF * 2 <= WS_O && WS_O + (size_t)M * D * 2 <= WS_END && WS_W + 2 * W_LAYER <= WS_HB - MiB && WS_HB + (size_t)(M + 256) * D * 2 <= WS_PB, "ws map");
constexpr int CW_BAR = 4096;
constexpr int RING_OFF = 0, RING_BYTES = 131072;
constexpr int LDSCTL_OFF = RING_BYTES, MISC_OFF = LDSCTL_OFF + 320;
constexpr int LDS_BYTES = 163840, LRU_TAB_OFF = 147456;

struct Args { const float* in[28]; float* out; unsigned char* ws; int ph_lo, ph_hi, pad0, pad1; };


typedef const __attribute__((address_space(4))) Args* KArgs;
__device__ __forceinline__ KArgs kargs() { KArgs p = (KArgs)__builtin_amdgcn_kernarg_segment_ptr(); asm volatile("" : "+s"(p)); return p; }
__device__ __forceinline__ int lane_id() { int r; asm volatile("v_mbcnt_lo_u32_b32 %0, -1, 0\n\tv_mbcnt_hi_u32_b32 %0, -1, %0" : "=v"(r)); return r; }
__device__ __forceinline__ float lshfl(float v, int src_lane) { return __builtin_bit_cast(float, __builtin_amdgcn_ds_bpermute(src_lane << 2, __builtin_bit_cast(int, v))); }
__device__ __forceinline__ double lshfl(double v, int src_lane) { const unsigned long long u = __builtin_bit_cast(unsigned long long, v);
    const unsigned lo = (unsigned)__builtin_amdgcn_ds_bpermute(src_lane << 2, (int)(unsigned)u), hi = (unsigned)__builtin_amdgcn_ds_bpermute(src_lane << 2, (int)(unsigned)(u >> 32));
    return __builtin_bit_cast(double, ((unsigned long long)hi << 32) | lo); }
__device__ __forceinline__ float wave_sum(float v, int lane) {
#pragma unroll
    for (int o = 1; o < 64; o <<= 1) v += lshfl(v, lane ^ o);
    return v;
}
namespace pg8 {
#define PG8_LAS __attribute__((address_space(3)))
typedef unsigned short bf16_t;
typedef short bf16x8 __attribute__((ext_vector_type(8)));
typedef float f32x4 __attribute__((ext_vector_type(4)));
typedef unsigned u32x4 __attribute__((ext_vector_type(4)));
constexpr int BM = 256, BK = 64, HALF = 128, HTB = HALF * BK * 2  , STAGE_BYTES = 8 * HTB, NXCD = 8, WGM = 8;

__host__ __device__ __forceinline__ int lds_byte(int r, int c) { const int st = (r >> 4) * 2 + (c >> 5), rr = r & 15, cc = c & 31, ob = rr * 64 + cc * 2; return st * 1024 + (ob ^ (((ob >> 9) & 1) << 5)); }
__host__ __device__ __forceinline__ void stage_rc(int b, int& R, int& C) { const int st = b / 1024, sb = b % 1024, swz = sb ^ (((sb >> 9) & 1) << 5); R = (st >> 1) * 16 + swz / 64; C = (st & 1) * 32 + (swz % 64) / 2; }
__host__ __device__ __forceinline__ int perm32(int rho) { const int n = rho >> 4, i = rho & 15; return 8 * (i >> 2) + 4 * n + (i & 3); }

struct Unit { int pm, pn, par; };
struct Gemm { const bf16_t* A; const bf16_t* Bt; int M, N, K; };

struct StaticOrder {
    int nM, nN, nwg, G, c;
    __host__ __device__ void init(int M, int N, int G_, int c_) { nM = M / BM; nN = N / BM; nwg = nM * nN; G = G_; c = c_; }
    __host__ __device__ bool next(int i, Unit& u) const {
        const long L = (long)i * G + c; if (L >= nwg) return false;
        int wgid = (int)L; { const int q = nwg / NXCD, r = nwg % NXCD, xcd = wgid % NXCD, off = wgid / NXCD; wgid = (xcd < r ? xcd * (q + 1) : r * (q + 1) + (xcd - r) * q) + off; }
        const int nig = WGM * nN, gid = wgid / nig, fm = gid * WGM, gsz = (nM - fm) < WGM ? (nM - fm) : WGM;
        u.pm = fm + ((wgid % nig) % gsz); u.pn = (wgid % nig) / gsz; u.par = i & 1; return true;
    }
    __device__ __forceinline__ void a_ready(const Unit&) const {}
    __device__ __forceinline__ void done(const Unit&) const {}
};
struct TailOrder : StaticOrder {
    int c0, u0, u1;
    __host__ __device__ bool next(int i, Unit& u) const {
        if (c < c0) return false;
        const int Lu = u0 + i * (G - c0) + (c - c0); if (Lu >= u1) return false;
        u.pm = Lu / nN; u.pn = Lu % nN; u.par = i & 1; return true;
    }
};
constexpr int RSTD_TBL_OFF = 131072 + 1024;
constexpr int CWT_TBL_OFF = RSTD_TBL_OFF + 2048;
struct StatOrder : StaticOrder {
    int ss_sel, row62, wave, cwt_layer;
    __device__ __forceinline__ void a_ready(const Unit& u) const {
        if (wave < 4) { const int t = wave * 64 + lane_id();
            int row = row62 ? 248 * u.pm + 62 * (t >> 6) + (4 * (t & 15) + ((t >> 4) & 3)) - 2 : BM * u.pm + t; row = row < 0 ? 0 : (row > 32767 ? 32767 : row);
            const f32x4* p = (const f32x4*)((const float*)(kargs()->ws + (ss_sel ? WS_SSB : WS_SSA)) + (size_t)row * 16);
            const f32x4 a = p[0], b = p[1], c = p[2], d = p[3];
            const float s = (((a[0] + a[1]) + (a[2] + a[3])) + ((b[0] + b[1]) + (b[2] + b[3]))) + (((c[0] + c[1]) + (c[2] + c[3])) + ((d[0] + d[1]) + (d[2] + d[3])));
            ((PG8_LAS float*)(uintptr_t)RSTD_TBL_OFF)[u.par * 256 + t] = rsqrtf(s * (1.0f / 1024.0f) + 1e-6f); }
        else if (row62) { const int t = (wave - 4) * 64 + lane_id();
            const u32x4 v = *(const u32x4*)(kargs()->ws + WS_CWT + (size_t)cwt_layer * 90112 + (size_t)u.pn * 4096 + t * 16);
            *(PG8_LAS u32x4*)(uintptr_t)(CWT_TBL_OFF + u.par * 4096 + t * 16) = v; }
    }
};
__device__ __forceinline__ float rstd_tbl(const Unit& u, int row_in_tile) { return ((const PG8_LAS float*)(uintptr_t)RSTD_TBL_OFF)[u.par * 256 + row_in_tile]; }
typedef __bf16 bf2_t __attribute__((ext_vector_type(2)));
typedef float fl2_t __attribute__((ext_vector_type(2)));
__device__ __forceinline__ unsigned cvt_pk_bf16(float lo, float hi) { const fl2_t v = {lo, hi}; return __builtin_bit_cast(unsigned, __builtin_convertvector(v, bf2_t)); }
typedef float f32x2 __attribute__((ext_vector_type(2)));
__device__ __forceinline__ f32x2 gelu_pk(f32x2 v) {
    const f32x2 av = __builtin_elementwise_abs(v), d = av * 0.2316418882f + 1.0f;
    f32x2 t; t.x = __builtin_amdgcn_rcpf(d.x); t.y = __builtin_amdgcn_rcpf(d.y);
    f32x2 q = t * 0.5307027145f + (-0.7265760135f); q = q * t + 0.7107068705f; q = q * t + (-0.142248368f); q = q * t + 0.127414796f; q = q * t;
    const f32x2 s = (v * v) * (-0.72134752044f);
    f32x2 e; e.x = __builtin_amdgcn_exp2f(s.x); e.y = __builtin_amdgcn_exp2f(s.y);
    const f32x2 m = v * (q * e), r = v - m;
    f32x2 o; o.x = v.x < 0.f ? m.x : r.x; o.y = v.y < 0.f ? m.y : r.y; return o;
}
template <int ACT  > struct EpiBf16 {
    static constexpr bool PERM = true, AFTER_DRAIN = false; static_assert(ACT == 0 || ACT == 1, "EpiBf16: ACT is 0 (none) or 1 (gelu_pk)");
    bf16_t* O; int ldc; const float* bias; int split_cols; size_t split_stride; float scale0;
    __device__ __forceinline__ void operator()(const f32x4 (&acc)[2][2][4][2], const Unit& u, int wr, int wc, int fr, int fq) const {
        const int row0 = u.pm * BM + wr * 64 + fr; int colt = u.pn * BM; bf16_t* base = O;
        float sc = 1.f; if (split_cols) { const int t = colt / split_cols; base += (size_t)t * split_stride; colt -= t * split_cols; if (t == 0) sc = scale0; }
        const int col0 = colt + wc * 32 + 8 * fq, bcol0 = u.pn * BM + wc * 32 + 8 * fq;
        f32x4 bv[2][2];
#pragma unroll
        for (int bj = 0; bj < 2; ++bj)
#pragma unroll
            for (int n = 0; n < 2; ++n) bv[bj][n] = bias ? *(const f32x4*)(bias + bcol0 + bj * HALF + 4 * n) : (f32x4){0.f, 0.f, 0.f, 0.f};
#pragma unroll
        for (int ai = 0; ai < 2; ++ai)
#pragma unroll
            for (int m = 0; m < 4; ++m) { bf16_t* rowp = base + (size_t)(row0 + ai * HALF + m * 16) * ldc + col0;
#pragma unroll
                for (int bj = 0; bj < 2; ++bj) { f32x4 v0 = acc[ai][bj][m][0] + bv[bj][0], v1 = acc[ai][bj][m][1] + bv[bj][1];
                    if (ACT == 1) { f32x2 a = gelu_pk((f32x2){v0[0], v0[1]}), b = gelu_pk((f32x2){v0[2], v0[3]}), c = gelu_pk((f32x2){v1[0], v1[1]}), d = gelu_pk((f32x2){v1[2], v1[3]});
                        v0 = (f32x4){a.x, a.y, b.x, b.y}; v1 = (f32x4){c.x, c.y, d.x, d.y}; }
                    v0 = v0 * sc; v1 = v1 * sc; u32x4 w; w.x = cvt_pk_bf16(v0[0], v0[1]); w.y = cvt_pk_bf16(v0[2], v0[3]); w.z = cvt_pk_bf16(v1[0], v1[1]); w.w = cvt_pk_bf16(v1[2], v1[3]);
                    *(u32x4*)(rowp + bj * HALF) = w; } }
    }
};


constexpr float RMS_EPS = 1e-6f;
constexpr int TOK = 32768;
typedef unsigned u32x2 __attribute__((ext_vector_type(2)));
__device__ __forceinline__ float rstd16(const float* SS, int row) {
    const f32x4* p = (const f32x4*)(SS + (size_t)row * 16);
    const f32x4 a = p[0], b = p[1], c = p[2], d = p[3];
    const float s = (((a[0] + a[1]) + (a[2] + a[3])) + ((b[0] + b[1]) + (b[2] + b[3]))) + (((c[0] + c[1]) + (c[2] + c[3])) + ((d[0] + d[1]) + (d[2] + d[3])));
    return rsqrtf(s * (1.0f / 1024.0f) + RMS_EPS);
}
__device__ __forceinline__ float bf_lo(unsigned w) { return __uint_as_float(w << 16); }
__device__ __forceinline__ float bf_hi(unsigned w) { return __uint_as_float(w & 0xffff0000u); }
struct EpiPlain {
    static constexpr bool PERM = true, AFTER_DRAIN = false;
    size_t ws_off; int ldc;
    __device__ __forceinline__ void operator()(const f32x4 (&acc)[2][2][4][2], const Unit& u, int wr, int wc, int fr_, int fq_) const {
        int lane_ = lane_id(); asm volatile("" : "+v"(lane_)); const int fr = lane_ & 15, fq = lane_ >> 4;
        const KArgs ka = kargs(); bf16_t* O = (bf16_t*)(ka->ws + ws_off);
        const int row0 = u.pm * BM + wr * 64 + fr, col0 = u.pn * BM + wc * 32 + 8 * fq;
#pragma unroll
        for (int ai = 0; ai < 2; ++ai)
#pragma unroll
            for (int m = 0; m < 4; ++m) { bf16_t* rowp = O + (size_t)(row0 + ai * HALF + m * 16) * ldc + col0;
#pragma unroll
                for (int bj = 0; bj < 2; ++bj) { const f32x4 v0 = acc[ai][bj][m][0], v1 = acc[ai][bj][m][1];
                    u32x4 w; w.x = cvt_pk_bf16(v0[0], v0[1]); w.y = cvt_pk_bf16(v0[2], v0[3]); w.z = cvt_pk_bf16(v1[0], v1[1]); w.w = cvt_pk_bf16(v1[2], v1[3]);
                    *(u32x4*)(rowp + bj * HALF) = w; } }
    }
};
struct EpiPP {
    static constexpr bool PERM = true, AFTER_DRAIN = false;
    int pad;
    __device__ __forceinline__ void operator()(const f32x4 (&acc)[2][2][4][2], const Unit& u, int wr, int wc, int fr_, int fq_) const {
        int lane_ = lane_id(); asm volatile("" : "+v"(lane_)); const int fr = lane_ & 15, fq = lane_ >> 4;
        const KArgs ka = kargs(); bf16_t* O = (bf16_t*)ka->out + (size_t)32768 * 1024;
        const int row0 = u.pm * BM + wr * 64 + fr, col0 = u.pn * BM + wc * 32 + 8 * fq;
#pragma unroll
        for (int ai = 0; ai < 2; ++ai)
#pragma unroll
            for (int m = 0; m < 4; ++m) { bf16_t* rowp = O + (size_t)(row0 + ai * HALF + m * 16) * 1024 + col0;
#pragma unroll
                for (int bj = 0; bj < 2; ++bj) { const f32x4 v0 = acc[ai][bj][m][0], v1 = acc[ai][bj][m][1];
                    u32x4 w; w.x = cvt_pk_bf16(v0[0], v0[1]); w.y = cvt_pk_bf16(v0[2], v0[3]); w.z = cvt_pk_bf16(v1[0], v1[1]); w.w = cvt_pk_bf16(v1[2], v1[3]);
                    *(u32x4*)(rowp + bj * HALF) = w; } }
    }
};
struct EpiZ {
    static constexpr bool PERM = true, AFTER_DRAIN = false;
    int ss_sel;
    __device__ __forceinline__ void operator()(const f32x4 (&acc)[2][2][4][2], const Unit& u, int wr, int wc, int fr_, int fq_) const {
        int lane_ = lane_id(); asm volatile("" : "+v"(lane_)); const int fr = lane_ & 15, fq = lane_ >> 4;
        const KArgs ka = kargs(); unsigned char* ws = ka->ws;
        bf16_t* Z = (bf16_t*)(ws + WS_Z); const float* SS = (const float*)(ws + (ss_sel ? WS_SSB : WS_SSA)); float* FL = (float*)(ws + WS_FL);
        const int row0 = u.pm * BM + wr * 64 + fr, col0 = u.pn * BM + wc * 32 + 8 * fq;
        const bool fl = (u.pn == 8) && (wc == 3) && (fq == 0);
#pragma unroll
        for (int ai = 0; ai < 2; ++ai)
#pragma unroll
            for (int m = 0; m < 4; ++m) { const int row = row0 + ai * HALF + m * 16; const float rs = rstd_tbl(u, ai * HALF + wr * 64 + m * 16 + fr); bf16_t* rowp = Z + (size_t)row * 2304 + col0;
#pragma unroll
                for (int bj = 0; bj < 2; ++bj) { const int g32 = (u.pn * BM + bj * HALF + wc * 32) >> 5;
                    const float rq = (g32 >= 11 && g32 < 19) ? rs * 0.18033688011112042f : rs;
                    const f32x4 v0 = acc[ai][bj][m][0] * rq, v1 = acc[ai][bj][m][1] * rq;
                    u32x4 w; w.x = cvt_pk_bf16(v0[0], v0[1]); w.y = cvt_pk_bf16(v0[2], v0[3]); w.z = cvt_pk_bf16(v1[0], v1[1]); w.w = cvt_pk_bf16(v1[2], v1[3]);
                    *(u32x4*)(rowp + bj * HALF) = w; }
                if (fl) *(f32x4*)(FL + (size_t)row * 4) = acc[ai][0][m][0] * rs; asm volatile("" ::: "memory"); }
    }
};
__device__ __forceinline__ float quad16_sum(float x) {
    auto s = __builtin_amdgcn_permlane16_swap(__float_as_uint(x), __float_as_uint(x), false, false); x = __uint_as_float(s[0]) + __uint_as_float(s[1]);
    auto t = __builtin_amdgcn_permlane32_swap(__float_as_uint(x), __float_as_uint(x), false, false); return __uint_as_float(t[0]) + __uint_as_float(t[1]);
}
template <int MODE> struct EpiRes {
    static constexpr bool PERM = true, AFTER_DRAIN = false;
    int r_src;
    int o_dst;
    int sso_sel;
    __device__ __forceinline__ void operator()(const f32x4 (&acc)[2][2][4][2], const Unit& u, int wr, int wc, int fr_, int fq_) const {
        int lane_ = lane_id(); asm volatile("" : "+v"(lane_)); const int fr = lane_ & 15, fq = lane_ >> 4;
        const KArgs ka = kargs(); unsigned char* ws = ka->ws;
        const bf16_t* R = r_src ? (const bf16_t*)ka->out : (const bf16_t*)(ws + WS_HB);
        bf16_t* HBo = o_dst == 0 ? (bf16_t*)(ws + WS_HB) : (o_dst == 1 ? (bf16_t*)ka->out : (bf16_t*)(ws + WS_O)); float* SSo = (float*)(ws + (sso_sel ? WS_SSB : WS_SSA));
        const float* SSi = (const float*)(ws + (sso_sel ? WS_SSA : WS_SSB)); const bf16_t* PP = (const bf16_t*)ka->out + (size_t)32768 * 1024;
        const int row0 = u.pm * BM + wr * 64 + fr, col0 = u.pn * BM + wc * 32 + 8 * fq;
#pragma unroll
        for (int ai = 0; ai < 2; ++ai) {
            u32x4 rwv[4][2], pwv[4][2];
#pragma unroll
            for (int m = 0; m < 4; ++m)
#pragma unroll
                for (int bj = 0; bj < 2; ++bj) { const size_t off = (size_t)(row0 + ai * HALF + m * 16) * 1024 + col0 + bj * HALF; rwv[m][bj] = *(const u32x4*)(R + off); if (MODE == 1) pwv[m][bj] = *(const u32x4*)(PP + off); }
            asm volatile("" ::: "memory");
#pragma unroll
            for (int m = 0; m < 4; ++m) { const int row = row0 + ai * HALF + m * 16; const size_t off = (size_t)row * 1024 + col0; float q = 0.f;
                float rs = 1.f; if (MODE == 1) rs = rstd_tbl(u, ai * HALF + wr * 64 + m * 16 + fr);
#pragma unroll
                for (int bj = 0; bj < 2; ++bj) { const u32x4 rw = rwv[m][bj]; f32x4 o0 = {bf_lo(rw.x), bf_hi(rw.x), bf_lo(rw.y), bf_hi(rw.y)}, o1 = {bf_lo(rw.z), bf_hi(rw.z), bf_lo(rw.w), bf_hi(rw.w)};
                    if (MODE == 0) { o0 = o0 + acc[ai][bj][m][0]; o1 = o1 + acc[ai][bj][m][1]; }
                    else { const f32x4 g0 = acc[ai][bj][m][0] * rs, g1 = acc[ai][bj][m][1] * rs; const u32x4 pw = pwv[m][bj];
                        o0[0] += bf_lo(pw.x) * __builtin_amdgcn_rcpf(1.f + __expf(-g0[0])); o0[1] += bf_hi(pw.x) * __builtin_amdgcn_rcpf(1.f + __expf(-g0[1])); o0[2] += bf_lo(pw.y) * __builtin_amdgcn_rcpf(1.f + __expf(-g0[2])); o0[3] += bf_hi(pw.y) * __builtin_amdgcn_rcpf(1.f + __expf(-g0[3]));
                        o1[0] += bf_lo(pw.z) * __builtin_amdgcn_rcpf(1.f + __expf(-g1[0])); o1[1] += bf_hi(pw.z) * __builtin_amdgcn_rcpf(1.f + __expf(-g1[1])); o1[2] += bf_lo(pw.w) * __builtin_amdgcn_rcpf(1.f + __expf(-g1[2])); o1[3] += bf_hi(pw.w) * __builtin_amdgcn_rcpf(1.f + __expf(-g1[3])); }
                    u32x4 w; w.x = cvt_pk_bf16(o0[0], o0[1]); w.y = cvt_pk_bf16(o0[2], o0[3]); w.z = cvt_pk_bf16(o1[0], o1[1]); w.w = cvt_pk_bf16(o1[2], o1[3]);
                    *(u32x4*)(HBo + off + bj * HALF) = w;
                    const float a0 = bf_lo(w.x), a1 = bf_hi(w.x), a2 = bf_lo(w.y), a3 = bf_hi(w.y), a4 = bf_lo(w.z), a5 = bf_hi(w.z), a6 = bf_lo(w.w), a7 = bf_hi(w.w);
                    q += ((a0 * a0 + a1 * a1) + (a2 * a2 + a3 * a3)) + ((a4 * a4 + a5 * a5) + (a6 * a6 + a7 * a7)); }
                q = quad16_sum(q);
                if (fq == 0) SSo[(size_t)row * 16 + u.pn * 4 + wc] = q; }
            asm volatile("" ::: "memory"); }
    }
};
template <int CTRL> __device__ __forceinline__ float dppf(float x) { return __builtin_bit_cast(float, __builtin_amdgcn_update_dpp(0, __builtin_bit_cast(int, x), CTRL, 0xf, 0xf, false)); }
struct EpiUp {
    static constexpr bool PERM = true, AFTER_DRAIN = false;
    int layer, ss_sel;
#define EPIUP_FMAC_DPP(y, x, w, CTRL) asm volatile("v_fmac_f32_dpp %0, %1, %2 " CTRL " row_mask:0xf bank_mask:0xf" : "+v"(y) : "v"(x), "v"(w))
    template <bool SEQ> __device__ __forceinline__ void conv(f32x4 (&x)[4][2], int n, int tb  , unsigned cwt  , bool silu) const {
        const f32x4 w0 = *(const PG8_LAS f32x4*)(uintptr_t)cwt, w1 = *(const PG8_LAS f32x4*)(uintptr_t)(cwt + 16), w2 = *(const PG8_LAS f32x4*)(uintptr_t)(cwt + 32), b = *(const PG8_LAS f32x4*)(uintptr_t)(cwt + 48);
        float k1[4] = {1.f, 1.f, 1.f, 1.f}, k2[4] = {1.f, 1.f, 1.f, 1.f};
        if (SEQ) {
#pragma unroll
            for (int m = 0; m < 4; ++m) { const int tpos = (tb + m) & 4095; k1[m] = tpos < 1 ? 0.f : 1.f; k2[m] = tpos < 2 ? 0.f : 1.f; } }
#pragma unroll
        for (int e = 0; e < 4; ++e) {
            const float x0 = x[0][n][e], x1 = x[1][n][e], x2 = x[2][n][e], x3 = x[3][n][e];
            float yv[4];
            { float y = b[e] + w2[e] * x0; const float a1 = SEQ ? w1[e] * k1[0] : w1[e], a0 = SEQ ? w0[e] * k2[0] : w0[e];
              EPIUP_FMAC_DPP(y, x3, a1, "row_shr:1"); EPIUP_FMAC_DPP(y, x2, a0, "row_shr:1"); yv[0] = y; }
            { float y = b[e] + w2[e] * x1; y += (SEQ ? w1[e] * k1[1] : w1[e]) * x0; const float a0 = SEQ ? w0[e] * k2[1] : w0[e];
              EPIUP_FMAC_DPP(y, x3, a0, "row_shr:1"); yv[1] = y; }
            yv[2] = b[e] + w2[e] * x2 + (SEQ ? w1[e] * k1[2] : w1[e]) * x1 + (SEQ ? w0[e] * k2[2] : w0[e]) * x0;
            yv[3] = b[e] + w2[e] * x3 + (SEQ ? w1[e] * k1[3] : w1[e]) * x2 + (SEQ ? w0[e] * k2[3] : w0[e]) * x1;
            if (silu) {
                float t[4];
#pragma unroll
                for (int m = 0; m < 4; ++m) t[m] = __builtin_amdgcn_exp2f(yv[m]);
#pragma unroll
                for (int m = 0; m < 4; ++m) t[m] = 1.f + t[m];
#pragma unroll
                for (int m = 0; m < 4; ++m) t[m] = __builtin_amdgcn_rcpf(t[m]);
#pragma unroll
                for (int m = 0; m < 4; ++m) yv[m] *= t[m]; }
#pragma unroll
            for (int m = 0; m < 4; ++m) x[m][n][e] = yv[m]; }
    }
    __device__ __forceinline__ void operator()(f32x4 (&acc)[2][2][4][2], const Unit& u, int wr, int wc, int fr_, int fq_) const {
        int lane_ = lane_id(); asm volatile("" : "+v"(lane_));
        const int fr = lane_ & 15, fq = lane_ >> 4;
        const KArgs ka = kargs(); unsigned char* ws = ka->ws;
        char* ACT = (char*)(ws + WS_ACT);
        const unsigned j0 = 128 * u.pn + 32 * wc + 8 * fq;
        const unsigned cw0 = CWT_TBL_OFF + u.par * 4096 + (8 * wc + 2 * fq) * 128;
#pragma unroll
        for (int ai = 0; ai < 2; ++ai) {
            asm volatile("" ::: "memory");
            const int tb0 = 248 * u.pm + 62 * (2 * ai + wr) - 2;
            const int tb = tb0 + 4 * fr;
#pragma unroll
            for (int m = 0; m < 4; ++m) { const float rs = rstd_tbl(u, ai * HALF + wr * 64 + m * 16 + fr);
#pragma unroll
                for (int bj = 0; bj < 2; ++bj)
#pragma unroll
                    for (int n = 0; n < 2; ++n) acc[ai][bj][m][n] = acc[ai][bj][m][n] * rs; }
            const bool seq = ((tb0 + 63) & 4095) < 65;
#pragma unroll
            for (int n = 0; n < 2; ++n) {
                __builtin_amdgcn_sched_barrier(0);
                if (seq) { conv<true>(acc[ai][0], n, tb, cw0 + n * 128, true); conv<true>(acc[ai][1], n, tb, cw0 + n * 128 + 64, false); }
                else { conv<false>(acc[ai][0], n, tb, cw0 + n * 128, true); __builtin_amdgcn_sched_barrier(0); conv<false>(acc[ai][1], n, tb, cw0 + n * 128 + 64, false); }
            }
#pragma unroll
            for (int m = 0; m < 4; ++m) { const int tok = tb + m; const f32x4 a0 = acc[ai][0][m][0] * acc[ai][1][m][0], a1 = acc[ai][0][m][1] * acc[ai][1][m][1];
                u32x4 w; w.x = cvt_pk_bf16(a0[0], a0[1]); w.y = cvt_pk_bf16(a0[2], a0[3]); w.z = cvt_pk_bf16(a1[0], a1[1]); w.w = cvt_pk_bf16(a1[2], a1[3]);
                if (4 * fr + m >= 2 && tok < TOK) *(u32x4*)(ACT + ((unsigned)tok * 5632u + j0 * 2u)) = w; }
            asm volatile("" ::: "memory");
        }
    }
#undef EPIUP_FMAC_DPP
};

template <class Epi, class Sched, bool ALIGN_EPI = false, bool SP2 = false, bool ROW62 = false, int KC = 0>
__device__ __forceinline__ void gemm_phase(PG8_LAS unsigned char* lds, const Gemm g, const Sched& S, const Epi& E, int wave_id) {
    int lane_ = lane_id(); asm volatile("" : "+v"(lane_));
    const int wid = wave_id, lane = lane_, tid = wid * 64 + lane, wr = wid >> 2, wc = wid & 3, fr = lane & 15, fq = lane >> 4;
    const int K = KC ? KC : g.K, nt = K / BK;
    unsigned voffA, voffB;
    { int R, C; stage_rc(tid * 16, R, C); const int Rb = Epi::PERM ? ((R & ~31) + perm32(R & 31)) : R; const int Ra = ROW62 ? 4 * (R & 15) + (R >> 4) : R;
      voffA = (unsigned)(Ra * K + C) * 2u; voffB = (unsigned)(Rb * K + C) * 2u; }
    const size_t dltA = (size_t)(ROW62 ? 62 : 64) * K * 2, dltB = (size_t)64 * K * 2;
    const size_t kstep = (size_t)(BK * 2);
    const size_t hstepB = (size_t)HALF * K * 2; const size_t hstepA = ROW62 ? (size_t)124 * K * 2 : hstepB;
    const size_t tstepB = 2 * hstepB, tstepA = 2 * hstepA;
    const unsigned ldsw = (unsigned)wid * 1024u;
    const int aoff = lds_byte(wr * 64 + fr, fq * 8), boff = lds_byte(wc * 32 + fr, fq * 8);
#define PG8_SA(b, h) (((b) * 2 + (h)) * HTB)
#define PG8_SB(b, h) ((4 + (b) * 2 + (h)) * HTB)
#define PG8_STAGE(bufoff, gbase, voff) do { _Pragma("unroll") for (int _i = 0; _i < 2; ++_i) \
        __builtin_amdgcn_global_load_lds((const unsigned*)((const char*)(gbase) + _i * dlt_##voff + voff), (PG8_LAS unsigned*)(lds + (bufoff) + ldsw + _i * 8192), 16, 0, 0); } while (0)
#define dlt_voffA dltA
#define dlt_voffB dltB
#define PG8_LDA(dst, b, h) do { _Pragma("unroll") for (int m = 0; m < 4; ++m) _Pragma("unroll") for (int k = 0; k < 2; ++k) dst[m][k] = *(const PG8_LAS bf16x8*)(lds + PG8_SA(b, h) + aoff + m * 2048 + k * 1024); } while (0)
#define PG8_LDB(dst, b, h) do { _Pragma("unroll") for (int n = 0; n < 2; ++n) _Pragma("unroll") for (int k = 0; k < 2; ++k) dst[n][k] = *(const PG8_LAS bf16x8*)(lds + PG8_SB(b, h) + boff + n * 2048 + k * 1024); } while (0)
#define PG8_MMA(ai, bj, At, Bt) do { __builtin_amdgcn_s_setprio(1); _Pragma("unroll") for (int m = 0; m < 4; ++m) _Pragma("unroll") for (int n = 0; n < 2; ++n) _Pragma("unroll") for (int k = 0; k < 2; ++k) \
        acc[ai][bj][m][n] = __builtin_amdgcn_mfma_f32_16x16x32_bf16(Bt[n][k], At[m][k], acc[ai][bj][m][n], 0, 0, 0); __builtin_amdgcn_s_setprio(0); } while (0)
#define PG8_WAIT_V(n) asm volatile("s_waitcnt vmcnt(" #n ")" ::: "memory")
#define PG8_WAIT_L(n) asm volatile("s_waitcnt lgkmcnt(" #n ")" ::: "memory")
#define PG8_BAR __builtin_amdgcn_s_barrier()
#define PG8_SCHED __builtin_amdgcn_sched_barrier(0)
    Unit cur, nxt; int ui = 0;
    if (!S.next(0, cur)) return;
    f32x4 acc[2][2][4][2];
#pragma unroll
    for (int a = 0; a < 2; ++a)
#pragma unroll
        for (int b = 0; b < 2; ++b)
#pragma unroll
            for (int m = 0; m < 4; ++m)
#pragma unroll
                for (int n = 0; n < 2; ++n) acc[a][b][m][n] = (f32x4){0.f, 0.f, 0.f, 0.f};
    bf16x8 At[4][2], B0[2][2], B1[2][2];
    const char* cA = (const char*)g.A + (size_t)cur.pm * tstepA; const char* cB = (const char*)g.Bt + (size_t)cur.pn * tstepB;
    S.a_ready(cur);
    if constexpr (SP2) {
        PG8_STAGE(PG8_SB(0, 0), cB, voffB); PG8_STAGE(PG8_SB(0, 1), cB + hstepB, voffB); PG8_STAGE(PG8_SA(0, 0), cA, voffA); PG8_STAGE(PG8_SA(0, 1), cA + hstepA, voffA);
        if (wr == 1) PG8_BAR;
        PG8_WAIT_V(2); PG8_BAR;
        PG8_STAGE(PG8_SB(1, 0), cB + kstep, voffB); PG8_STAGE(PG8_SA(1, 0), cA + kstep, voffA); PG8_STAGE(PG8_SB(1, 1), cB + hstepB + kstep, voffB);
        PG8_WAIT_V(6); PG8_BAR;
    } else {
        PG8_STAGE(PG8_SB(0, 0), cB, voffB); PG8_STAGE(PG8_SA(0, 0), cA, voffA); PG8_STAGE(PG8_SB(0, 1), cB + hstepB, voffB); PG8_STAGE(PG8_SA(0, 1), cA + hstepA, voffA);
        if (wr == 1) PG8_BAR;
        PG8_WAIT_V(4); PG8_BAR;
        PG8_STAGE(PG8_SB(1, 0), cB + kstep, voffB); PG8_STAGE(PG8_SA(1, 0), cA + kstep, voffA); PG8_STAGE(PG8_SB(1, 1), cB + hstepB + kstep, voffB);
        PG8_WAIT_V(6); PG8_BAR;
    }
    for (;;) {
        const bool has_next = S.next(ui + 1, nxt);
        const char* nA = has_next ? (const char*)g.A + (size_t)nxt.pm * tstepA : cA; const char* nB = has_next ? (const char*)g.Bt + (size_t)nxt.pn * tstepB : cB;
#pragma nounroll
        for (int t = 0; t < nt; t += 2) {
            const bool last = (t == nt - 2);
            const char* a1 = cA + (size_t)(t + 1) * kstep;
            const char* a2 = last ? nA : cA + (size_t)(t + 2) * kstep; const char* b2 = last ? nB : cB + (size_t)(t + 2) * kstep;
            const char* a3 = a2 + kstep; const char* b3 = b2 + kstep;
            if (last && has_next) S.a_ready(nxt);
            if constexpr (SP2) {
            PG8_LDB(B0, 0, 0); PG8_LDB(B1, 0, 1); PG8_SCHED; PG8_LDA(At, 0, 0); PG8_STAGE(PG8_SA(1, 1), a1 + hstepA, voffA);
            PG8_WAIT_V(8); PG8_WAIT_L(0); PG8_BAR; PG8_MMA(0, 0, At, B0); PG8_MMA(0, 1, At, B1); PG8_BAR; PG8_SCHED;
            PG8_LDA(At, 0, 1); PG8_STAGE(PG8_SB(0, 0), b2, voffB); PG8_STAGE(PG8_SB(0, 1), b2 + hstepB, voffB); PG8_STAGE(PG8_SA(0, 0), a2, voffA);
            PG8_WAIT_V(8); PG8_WAIT_L(0); PG8_BAR; PG8_MMA(1, 0, At, B0); PG8_MMA(1, 1, At, B1); PG8_BAR; PG8_SCHED;
            PG8_LDB(B0, 1, 0); PG8_LDB(B1, 1, 1); PG8_SCHED; PG8_LDA(At, 1, 0); PG8_STAGE(PG8_SA(0, 1), a2 + hstepA, voffA);
            PG8_WAIT_V(8); PG8_WAIT_L(0); PG8_BAR; PG8_MMA(0, 0, At, B0); PG8_MMA(0, 1, At, B1); PG8_BAR; PG8_SCHED;
            PG8_LDA(At, 1, 1); PG8_STAGE(PG8_SB(1, 0), b3, voffB); PG8_STAGE(PG8_SB(1, 1), b3 + hstepB, voffB); PG8_STAGE(PG8_SA(1, 0), a3, voffA);
            PG8_WAIT_V(8); PG8_WAIT_L(0); PG8_BAR; PG8_MMA(1, 0, At, B0); PG8_MMA(1, 1, At, B1); PG8_BAR; PG8_SCHED;
            } else {
            PG8_LDB(B0, 0, 0); PG8_SCHED; PG8_LDA(At, 0, 0); PG8_STAGE(PG8_SA(1, 1), a1 + hstepA, voffA);
            PG8_WAIT_L(8); PG8_BAR; PG8_WAIT_L(0); PG8_MMA(0, 0, At, B0); PG8_BAR; PG8_SCHED;
            PG8_LDB(B1, 0, 1); PG8_STAGE(PG8_SB(0, 0), b2, voffB);
            PG8_BAR; PG8_WAIT_L(0); PG8_MMA(0, 1, At, B1); PG8_BAR;
            PG8_LDA(At, 0, 1); PG8_STAGE(PG8_SA(0, 0), a2, voffA);
            PG8_BAR; PG8_WAIT_L(0); PG8_MMA(1, 0, At, B0); PG8_BAR; PG8_SCHED;
            PG8_STAGE(PG8_SB(0, 1), b2 + hstepB, voffB);
            PG8_WAIT_V(6); PG8_BAR; PG8_MMA(1, 1, At, B1); PG8_BAR;
            PG8_LDB(B0, 1, 0); PG8_SCHED; PG8_LDA(At, 1, 0); PG8_STAGE(PG8_SA(0, 1), a2 + hstepA, voffA);
            PG8_WAIT_L(8); PG8_BAR; PG8_WAIT_L(0); PG8_MMA(0, 0, At, B0); PG8_BAR; PG8_SCHED;
            PG8_LDB(B1, 1, 1); PG8_STAGE(PG8_SB(1, 0), b3, voffB);
            PG8_BAR; PG8_WAIT_L(0); PG8_MMA(0, 1, At, B1); PG8_BAR;
            PG8_LDA(At, 1, 1); PG8_STAGE(PG8_SA(1, 0), a3, voffA);
            PG8_BAR; PG8_WAIT_L(0); PG8_MMA(1, 0, At, B0); PG8_BAR; PG8_SCHED;
            PG8_STAGE(PG8_SB(1, 1), b3 + hstepB, voffB);
            PG8_WAIT_V(6); PG8_BAR; PG8_MMA(1, 1, At, B1); PG8_BAR;
            }
        }
        if constexpr (ALIGN_EPI) { if (wr == 0) PG8_BAR; }
        if constexpr (!Epi::AFTER_DRAIN) { E(acc, cur, wr, wc, fr, fq); S.done(cur); }
        if (!has_next) break;
#pragma unroll
        for (int a = 0; a < 2; ++a)
#pragma unroll
            for (int b = 0; b < 2; ++b)
#pragma unroll
                for (int m = 0; m < 4; ++m)
#pragma unroll
                    for (int n = 0; n < 2; ++n) acc[a][b][m][n] = (f32x4){0.f, 0.f, 0.f, 0.f};
        cur = nxt; cA = nA; cB = nB; ++ui;
        if constexpr (ALIGN_EPI) { if (wr == 1) PG8_BAR; }
    }
    PG8_WAIT_V(0);
    if constexpr (!ALIGN_EPI) { if (wr == 0) PG8_BAR; }
    PG8_BAR;
    if constexpr (Epi::AFTER_DRAIN) { E.fused(acc, cur, wr, wc, fr, fq, lds, wid, lane); S.done(cur); }
#undef PG8_SA
#undef PG8_SB
#undef PG8_STAGE
#undef dlt_voffA
#undef dlt_voffB
#undef PG8_LDA
#undef PG8_LDB
#undef PG8_MMA
#undef PG8_WAIT_V
#undef PG8_WAIT_L
#undef PG8_BAR
#undef PG8_SCHED
}
}
#define GAS __attribute__((address_space(1)))
#define LAS __attribute__((address_space(3)))
typedef unsigned short bf16;
typedef unsigned v4u __attribute__((ext_vector_type(4)));
typedef float f32x4 __attribute__((ext_vector_type(4)));
typedef short bf16x8 __attribute__((ext_vector_type(8)));
typedef GAS unsigned gu32;
typedef GAS unsigned long long gu64;
#define RLX_AGENT __ATOMIC_RELAXED, __HIP_MEMORY_SCOPE_AGENT
#define LDS_WAIT() asm volatile("s_waitcnt lgkmcnt(0)" ::: "memory")
#define VM_WAIT() asm volatile("s_waitcnt vmcnt(0)" ::: "memory")
__device__ __forceinline__ unsigned long long rt() { return __builtin_amdgcn_s_memrealtime(); }
__device__ __forceinline__ unsigned f2bf(float f) { unsigned u = __builtin_bit_cast(unsigned, f); return (u + 0x7fffu + ((u >> 16) & 1u)) >> 16; }
__device__ __forceinline__ unsigned pk2(float lo, float hi) { return f2bf(lo) | (f2bf(hi) << 16); }

#define XB_TMO      128
#define XB_XCNT(j)  (256  + 64 * (j))
#define XB_XSUB(j)  (1280 + 64 * (j))
#define XB_XGEN(j)  (2304 + 64 * (j))
#define XB_TOP      3328
#define XB_TOPGEN   3392
#define XCD_BAR_WORDS 3456
#define XB_SPIN_CAP (1u << 18)

__device__ __forceinline__ unsigned xb_ld(unsigned* p)              { return __hip_atomic_load(p, __ATOMIC_RELAXED, __HIP_MEMORY_SCOPE_AGENT); }
__device__ __forceinline__ unsigned xb_add(unsigned* p, unsigned v) { return __hip_atomic_fetch_add(p, v, __ATOMIC_RELAXED, __HIP_MEMORY_SCOPE_AGENT); }
__device__ __forceinline__ unsigned xb_xcc_id() { return (unsigned)__builtin_amdgcn_s_getreg((3 << 11) | 20) & 0xFu; }
#define XB_SPIN(cond, bar) do { unsigned _sp = 0; while (cond) { __builtin_amdgcn_s_sleep(1); \
    if ((++_sp & 255u) == 0u) { if (xb_ld(&(bar)[XB_TMO])) break; if (_sp > XB_SPIN_CAP) { atomicAdd(&(bar)[XB_TMO], 1u); break; } } } } while (0)

struct XcdBarrier {
    unsigned* bar; unsigned x;
    volatile LAS unsigned* st;
};

__device__ __forceinline__ XcdBarrier xcd_barrier_post(unsigned* bar, volatile LAS unsigned* st) {
    XcdBarrier b; b.bar = bar; b.x = xb_xcc_id(); b.st = st;
    if (threadIdx.x == 0) (void)xb_add(&bar[XB_XCNT(b.x)], 1u);
    return b;
}
__device__ __forceinline__ void xcd_barrier_complete(unsigned* bar, unsigned x, unsigned& nloc, unsigned& nx) {
    const unsigned G = gridDim.x * gridDim.y * gridDim.z;
    unsigned sum, cnt, mine, sp = 0u;
    for (;;) {
        sum = 0u; cnt = 0u; mine = 0u;
#pragma unroll
        for (unsigned j = 0; j < 16; ++j) { const unsigned c = xb_ld(&bar[XB_XCNT(j)]); sum += c; cnt += (c > 0u) ? 1u : 0u; mine = (j == x) ? c : mine; }
        if (sum == G) break;
        __builtin_amdgcn_s_sleep(1);
        if ((++sp & 255u) == 0u) { if (xb_ld(&bar[XB_TMO])) break; if (sp > XB_SPIN_CAP) { atomicAdd(&bar[XB_TMO], 1u); break; } }
    }
    nloc = mine > 0u ? mine : 1u; nx = cnt > 0u ? cnt : 1u;
}

__device__ __forceinline__ void xcd_barrier(const XcdBarrier& b) {
    asm volatile("s_waitcnt vmcnt(0)" ::: "memory");
    __syncthreads();
    if (threadIdx.x == 0) {
        unsigned* bar = b.bar;
        __builtin_amdgcn_s_waitcnt(0);
        unsigned nloc = b.st[0], nx = b.st[1];
        if (nloc == 0u) { xcd_barrier_complete(bar, b.x, nloc, nx); b.st[0] = nloc; b.st[1] = nx; }
        const unsigned old = xb_add(&bar[XB_XSUB(b.x)], 1u);
        const unsigned gen = old / nloc;
        if (old + 1u == (gen + 1u) * nloc) {
            __builtin_amdgcn_fence(__ATOMIC_RELEASE, "agent");
            asm volatile("s_waitcnt vmcnt(0)" ::: "memory");
            const unsigned og = xb_add(&bar[XB_TOP], 1u);
            const unsigned tg = og / nx;
            if (og + 1u == (tg + 1u) * nx) xb_add(&bar[XB_TOPGEN], 1u);
            else XB_SPIN(xb_ld(&bar[XB_TOPGEN]) == tg, bar);
            __builtin_amdgcn_fence(__ATOMIC_ACQUIRE, "agent");
            xb_add(&bar[XB_XGEN(b.x)], 1u);
            asm volatile("s_waitcnt vmcnt(0)" ::: "memory");
        } else {
            XB_SPIN(xb_ld(&bar[XB_XGEN(b.x)]) == gen, bar);
            __builtin_amdgcn_fence(__ATOMIC_ACQUIRE, "agent");
            asm volatile("s_waitcnt vmcnt(0)" ::: "memory");
        }
    }
    __syncthreads();
}
namespace att {
using bf16x8 = __attribute__((ext_vector_type(8))) short;
using s16x4 = __attribute__((ext_vector_type(4))) short;
using f32x16 = __attribute__((ext_vector_type(16))) float;
using u32x4 = __attribute__((ext_vector_type(4))) unsigned;
typedef short v4i16_t __attribute__((ext_vector_type(4)));
typedef __attribute__((address_space(3))) char* lptr;
typedef __attribute__((address_space(3))) const char* lcptr;
constexpr int KSLOT = 12288, VSLOT = 8192, BSLOT = 1024;
constexpr int NSLOT = 4;
constexpr int LDS_K = 0, LDS_V = NSLOT * KSLOT, LDS_B = LDS_V + NSLOT * VSLOT, LDS_WS = LDS_B + NSLOT * BSLOT, LDS_OST = LDS_WS + 8 * 512, LDS_BYTES = LDS_OST + 8 * 4096;
__device__ __forceinline__ int crow(int r, int hi) { return (r & 3) + 8 * (r >> 2) + 4 * hi; }
__device__ __forceinline__ void glds16(const void* g, unsigned lds_base) {
    unsigned sv; asm volatile("s_mov_b32 %0, m0\n\ts_mov_b32 m0, %2\n\ts_nop 0\n\tglobal_load_lds_dwordx4 %1, off\n\ts_mov_b32 m0, %0" : "=&s"(sv) : "v"(g), "s"(lds_base) : "memory"); }
typedef __bf16 bf2_t __attribute__((ext_vector_type(2)));
typedef float fl2_t __attribute__((ext_vector_type(2)));
__device__ __forceinline__ unsigned cvtpk(float lo, float hi) { const fl2_t v = {lo, hi}; return __builtin_bit_cast(unsigned, __builtin_convertvector(v, bf2_t)); }
__device__ __forceinline__ s16x4 vtr(lcptr p) { return __builtin_bit_cast(s16x4, __builtin_amdgcn_ds_read_tr16_b64_v4i16((__attribute__((address_space(3))) v4i16_t*)p)); }
#define ATT_MX3(a, b, c) __builtin_fmaxf(__builtin_fmaxf((a), (b)), (c))
__device__ __forceinline__ float rowmax(const f32x16& p0, const f32x16& p1) {
    float a = ATT_MX3(p0[0], p0[1], p1[0]), b = ATT_MX3(p0[2], p0[3], p1[1]); a = ATT_MX3(a, p1[2], p1[3]);
#pragma unroll
    for (int r = 4; r < 16; r += 4) { a = ATT_MX3(a, p0[r], p0[r + 1]); b = ATT_MX3(b, p0[r + 2], p0[r + 3]); a = ATT_MX3(a, p1[r], p1[r + 1]); b = ATT_MX3(b, p1[r + 2], p1[r + 3]); }
    float m = __builtin_fmaxf(a, b); auto rr = __builtin_amdgcn_permlane32_swap(__float_as_uint(m), __float_as_uint(m), false, false);
    return __builtin_fmaxf(__uint_as_float(rr[0]), __uint_as_float(rr[1])); }
__device__ __forceinline__ void cmask(f32x16& p0, f32x16& p1, int jb, int qrel, int hi) {
    const int kb = 64 * jb + 4 * hi;
#pragma unroll
    for (int r = 0; r < 16; ++r) { const int kv = kb + (r & 3) + 8 * (r >> 2); if (kv > qrel) p0[r] = -INFINITY; if (kv + 32 > qrel) p1[r] = -INFINITY; } }
#define ATT_WAIT_BAR(N) asm volatile("s_waitcnt vmcnt(" #N ") lgkmcnt(0)\n\ts_barrier" ::: "memory")
#define ATT_MFMA(a, b, c) __builtin_amdgcn_mfma_f32_32x32x16_bf16(a, b, c, 0, 0, 0)

template <int ND, bool BIAS>
__device__ __forceinline__ void attn_unit(const unsigned short* Qh, int pq, const unsigned short* Kh, int pk, const unsigned short* Vh, int pv, unsigned short* Oh, int po,
                                          const float* cbx, int hb, int qb, lptr lds, int wid) {
    const int lane = lane_id(), r32 = lane & 31, hi = lane >> 5;
    const int q0 = qb * 512, NT = 8 * qb + 8;
    constexpr int KSL = ND * 2048;
    const unsigned lds0 = (unsigned)(uintptr_t)lds;
    bf16x8 qa[ND], qc[ND];
    const int ra0 = 32 * wid, rb0 = 480 - 32 * wid;
    const int da_ = wid >> 1, db_ = 7 - (wid >> 1);
    const int oa_ = 32 * (wid & 1), ob_ = (wid & 1) ? 0 : 32;
    { const unsigned short* Qwa = Qh + (size_t)(q0 + ra0 + r32) * pq + hi * 8; const unsigned short* Qwb = Qh + (size_t)(q0 + rb0 + r32) * pq + hi * 8;
#pragma unroll
      for (int d0 = 0; d0 < ND; ++d0) { qa[d0] = *reinterpret_cast<const bf16x8*>(Qwa + d0 * 16); qc[d0] = *reinterpret_cast<const bf16x8*>(Qwb + d0 * 16); }
 }
    const unsigned short* ksrc0 = Kh + (size_t)lane * pk + wid * 8;
    const unsigned short* ksrc1 = Kh + (size_t)lane * pk + (8 + (wid & 3)) * 8;
    const unsigned short* vsrc = Vh + (size_t)(16 * (wid & 3) + (lane >> 2)) * pv + (wid >> 2) * 32 + (lane & 3) * 8;
    const float* bsrc = cbx + lane * 4;
    const unsigned kdst0 = lds0 + LDS_K + wid * 1024, kdst1 = lds0 + LDS_K + (8 + (wid & 3)) * 1024, vdst = lds0 + LDS_V + wid * 1024, bdst = lds0 + LDS_B;
#define ATT_DMA(t, s) do { glds16(ksrc0 + (size_t)(t) * 64 * pk, (unsigned)__builtin_amdgcn_readfirstlane(kdst0 + (s) * KSL)); \
        if (ND == 6) glds16(ksrc1 + (size_t)(t) * 64 * pk, (unsigned)__builtin_amdgcn_readfirstlane(kdst1 + (s) * KSL)); \
        glds16(vsrc + (size_t)(t) * 64 * pv, (unsigned)__builtin_amdgcn_readfirstlane(vdst + (s) * VSLOT)); \
        if (BIAS) glds16(bsrc + (size_t)(t) * 256, (unsigned)__builtin_amdgcn_readfirstlane(bdst + (s) * BSLOT)); } while (0)
    const lcptr kp0 = (lcptr)lds + LDS_K + hi * 1024 + r32 * 16;
    const lcptr vp0 = (lcptr)lds + LDS_V + ((lane >> 4) & 1) * 32 + (lane & 3) * 8 + (4 * hi + ((lane & 15) >> 2)) * 64;
    const lcptr bp0 = (lcptr)lds + LDS_B + hb * 256 + hi * 128;
    __attribute__((address_space(3))) float* wsf = (__attribute__((address_space(3))) float*)(lds + LDS_WS) + wid * 128;
    ATT_DMA(NT - 1, 0); ATT_DMA(NT - 2, 1); ATT_DMA(NT - 3, 2);
#pragma unroll
    for (int d0 = 0; d0 < ND; ++d0) { asm volatile("" : "+v"(qa[d0])); asm volatile("" : "+v"(qc[d0])); }
    float ma = -INFINITY, la = 0.f, mb = -INFINITY, lb = 0.f; f32x16 oa[2], ob[2];
    { float z0; asm volatile("v_mov_b32 %0, 0" : "=v"(z0));
#pragma unroll
      for (int r = 0; r < 16; ++r) { oa[0][r] = z0; oa[1][r] = z0; ob[0][r] = z0; ob[1][r] = z0; } }
    f32x16 pa, pb, pa2, pb2;
#define ATT_SKIP(t) ((t) < 8 && (7 - (t)) > db_)
#define ATT_AACT(t) ((t) >= 8 || (7 - (t)) <= da_)
#define ATT_CINIT(PA_, PB_, t, H) do { if (BIAS) { const lcptr bp = bp0 + ((t) & 3) * BSLOT + (H) * 64; \
            _Pragma("unroll") for (int g = 0; g < 4; ++g) { const f32x4 x_ = *(const __attribute__((address_space(3))) f32x4*)(bp + g * 16); \
                _Pragma("unroll") for (int e = 0; e < 4; ++e) { PA_[4 * g + e] = x_[e]; PB_[4 * g + e] = x_[e]; } } } \
        else { PA_ = f32x16{}; PB_ = f32x16{}; } } while (0)
#define ATT_QK(t, H) do { const lcptr kb_ = kp0 + ((t) & 3) * KSL + (H) * 512; ATT_CINIT(pa, pb, t, H); bf16x8 kf_[ND]; \
        _Pragma("unroll") for (int d0 = 0; d0 < ND; ++d0) kf_[d0] = *(const __attribute__((address_space(3))) bf16x8*)(kb_ + d0 * 2048); \
        __builtin_amdgcn_s_setprio(1); _Pragma("unroll") for (int d0 = 0; d0 < ND; ++d0) { pa = ATT_MFMA(kf_[d0], qa[d0], pa); pb = ATT_MFMA(kf_[d0], qc[d0], pb); } __builtin_amdgcn_s_setprio(0); } while (0)
#define ATT_VF(i) ({ const s16x4 lo_ = vtr(vp + (((i) >> 2) * 4096 + ((i) & 3) * 1024)), hi_ = vtr(vp + (((i) >> 2) * 4096 + ((i) & 3) * 1024 + 512)); (bf16x8){lo_[0], lo_[1], lo_[2], lo_[3], hi_[0], hi_[1], hi_[2], hi_[3]}; })
#define ATT_RMAX(P, RM) do { float a_ = ATT_MX3(P[0], P[1], P[2]), b_ = ATT_MX3(P[3], P[4], P[5]); a_ = ATT_MX3(a_, P[6], P[7]); b_ = ATT_MX3(b_, P[8], P[9]); a_ = ATT_MX3(a_, P[10], P[11]); b_ = ATT_MX3(b_, P[12], P[13]); a_ = ATT_MX3(a_, P[14], P[15]); \
        RM = __builtin_fmaxf(a_, b_); { auto rr_ = __builtin_amdgcn_permlane32_swap(__float_as_uint(RM), __float_as_uint(RM), false, false); RM = __builtin_fmaxf(__uint_as_float(rr_[0]), __uint_as_float(rr_[1])); } } while (0)
#define ATT_EXPS(P, MR, LR) do { float sum_ = 0.f; \
        _Pragma("unroll") for (int r = 0; r < 16; ++r) { P[r] = __builtin_amdgcn_exp2f(P[r] - MR); sum_ += P[r]; } \
        asm volatile("" : "+v"(sum_));            \
        LR += sum_; asm volatile("" : "+v"(LR)); } while (0)
#define ATT_PK(P, o) (u32x4){cvtpk(P[o], P[o + 1]), cvtpk(P[o + 2], P[o + 3]), cvtpk(P[o + 4], P[o + 5]), cvtpk(P[o + 6], P[o + 7])}
#define ATT_PV(WA, WB, i) do { const bf16x8 v0_ = ATT_VF(i), v1_ = ATT_VF((i) + 4); __builtin_amdgcn_s_setprio(1); \
        oa[0] = ATT_MFMA(__builtin_bit_cast(bf16x8, WA), v0_, oa[0]); ob[0] = ATT_MFMA(__builtin_bit_cast(bf16x8, WB), v0_, ob[0]); \
        oa[1] = ATT_MFMA(__builtin_bit_cast(bf16x8, WA), v1_, oa[1]); ob[1] = ATT_MFMA(__builtin_bit_cast(bf16x8, WB), v1_, ob[1]); __builtin_amdgcn_s_setprio(0); } while (0)
#define ATT_SMPV(t, H, MASKED_) do { const int s_ = (t) & 3; \
        if (MASKED_) { if (7 - (t) == da_) { const int l3_ = lane_id(), kb3_ = 32 * (H) + 4 * (l3_ >> 5), qa3_ = oa_ + (l3_ & 31); \
            _Pragma("unroll") for (int r = 0; r < 16; ++r) { const int kv = kb3_ + (r & 3) + 8 * (r >> 2); if (kv > qa3_) pa[r] = -INFINITY; } } } \
        float rma, rmb; ATT_RMAX(pa, rma); ATT_RMAX(pb, rmb); \
          \
        if (__any(rma > ma + 40.f || rmb > mb + 40.f)) { \
            const float na = __builtin_fmaxf(ma, rma), nb = __builtin_fmaxf(mb, rmb); const float ala = __builtin_amdgcn_exp2f(ma - na), alb = __builtin_amdgcn_exp2f(mb - nb); ma = na; mb = nb; la *= ala; lb *= alb; \
            if (hi == 0) { wsf[r32] = ala; wsf[32 + r32] = alb; } \
            asm volatile("s_waitcnt lgkmcnt(0)" ::: "memory"); \
            asm volatile("" : "+v"(oa[0]), "+v"(oa[1]));       \
            _Pragma("unroll") for (int r = 0; r < 16; ++r) { const float fa = wsf[crow(r, hi)]; oa[0][r] *= fa; oa[1][r] *= fa; if ((r & 3) == 3) asm volatile("" ::: "memory"); } \
            asm volatile("" : "+v"(oa[0]), "+v"(oa[1])); \
            asm volatile("" : "+v"(ob[0]), "+v"(ob[1])); \
            _Pragma("unroll") for (int r = 0; r < 16; ++r) { const float fb = wsf[32 + crow(r, hi)]; ob[0][r] *= fb; ob[1][r] *= fb; if ((r & 3) == 3) asm volatile("" ::: "memory"); } \
            asm volatile("" : "+v"(ob[0]), "+v"(ob[1])); } \
        ATT_EXPS(pa, ma, la); ATT_EXPS(pb, mb, lb); \
        const lcptr vp = vp0 + s_ * VSLOT; \
        { const u32x4 wa_ = ATT_PK(pa, 0), wb_ = ATT_PK(pb, 0); ATT_PV(wa_, wb_, 2 * (H)); } \
        { const u32x4 wa_ = ATT_PK(pa, 8), wb_ = ATT_PK(pb, 8); ATT_PV(wa_, wb_, 2 * (H) + 1); } } while (0)
#define ATT_QK_B(t, H) do { const lcptr kb_ = kp0 + ((t) & 3) * KSL + (H) * 512; \
        if (BIAS) { const lcptr bp = bp0 + ((t) & 3) * BSLOT + (H) * 64; \
            _Pragma("unroll") for (int g = 0; g < 4; ++g) { const f32x4 x_ = *(const __attribute__((address_space(3))) f32x4*)(bp + g * 16); \
                _Pragma("unroll") for (int e = 0; e < 4; ++e) pb[4 * g + e] = x_[e]; } } \
        else pb = f32x16{}; \
        bf16x8 kf_[ND]; _Pragma("unroll") for (int d0 = 0; d0 < ND; ++d0) kf_[d0] = *(const __attribute__((address_space(3))) bf16x8*)(kb_ + d0 * 2048); \
        _Pragma("unroll") for (int d0 = 0; d0 < ND; ++d0) pb = ATT_MFMA(kf_[d0], qc[d0], pb); } while (0)
#define ATT_SMPV_B(t, H) do { const int s_ = (t) & 3; \
        if (7 - (t) == db_) { const int l3_ = lane_id(), kb3_ = 32 * (H) + 4 * (l3_ >> 5), qb3_ = ob_ + (l3_ & 31); \
            _Pragma("unroll") for (int r = 0; r < 16; ++r) { const int kv = kb3_ + (r & 3) + 8 * (r >> 2); if (kv > qb3_) pb[r] = -INFINITY; } } \
        float rmb; ATT_RMAX(pb, rmb); \
        if (__any(rmb > mb + 40.f)) { \
            const float nb = __builtin_fmaxf(mb, rmb); const float alb = __builtin_amdgcn_exp2f(mb - nb); mb = nb; lb *= alb; \
            if (hi == 0) wsf[32 + r32] = alb; \
            asm volatile("s_waitcnt lgkmcnt(0)" ::: "memory"); \
            asm volatile("" : "+v"(ob[0]), "+v"(ob[1])); \
            _Pragma("unroll") for (int r = 0; r < 16; ++r) { const float fb = wsf[32 + crow(r, hi)]; ob[0][r] *= fb; ob[1][r] *= fb; if ((r & 3) == 3) asm volatile("" ::: "memory"); } \
            asm volatile("" : "+v"(ob[0]), "+v"(ob[1])); } \
        ATT_EXPS(pb, mb, lb); \
        const lcptr vp = vp0 + s_ * VSLOT; \
        { const u32x4 wb_ = ATT_PK(pb, 0); const bf16x8 v0_ = ATT_VF(2 * (H)), v1_ = ATT_VF(2 * (H) + 4); \
          ob[0] = ATT_MFMA(__builtin_bit_cast(bf16x8, wb_), v0_, ob[0]); ob[1] = ATT_MFMA(__builtin_bit_cast(bf16x8, wb_), v1_, ob[1]); } \
        { const u32x4 wb_ = ATT_PK(pb, 8); const bf16x8 v0_ = ATT_VF(2 * (H) + 1), v1_ = ATT_VF(2 * (H) + 5); \
          ob[0] = ATT_MFMA(__builtin_bit_cast(bf16x8, wb_), v0_, ob[0]); ob[1] = ATT_MFMA(__builtin_bit_cast(bf16x8, wb_), v1_, ob[1]); } } while (0)
#define ATT_HALF(CA, CB, NA, NB, t, H, tn, Hn, HASNEXT) do { const int s_ = (t) & 3; \
        bf16x8 kf_[ND]; if (HASNEXT) { const lcptr kb_ = kp0 + ((tn) & 3) * KSL + (Hn) * 512; \
            _Pragma("unroll") for (int d0 = 0; d0 < ND; ++d0) kf_[d0] = *(const __attribute__((address_space(3))) bf16x8*)(kb_ + d0 * 2048); } \
        float rma, rmb; ATT_RMAX(CA, rma); ATT_RMAX(CB, rmb); \
        if (__any(rma > ma + 40.f || rmb > mb + 40.f)) { \
            const float na = __builtin_fmaxf(ma, rma), nb = __builtin_fmaxf(mb, rmb); const float ala = __builtin_amdgcn_exp2f(ma - na), alb = __builtin_amdgcn_exp2f(mb - nb); ma = na; mb = nb; la *= ala; lb *= alb; \
            if (hi == 0) { wsf[r32] = ala; wsf[32 + r32] = alb; } \
            asm volatile("s_waitcnt lgkmcnt(0)" ::: "memory"); \
            asm volatile("" : "+v"(oa[0]), "+v"(oa[1])); \
            _Pragma("unroll") for (int r = 0; r < 16; ++r) { const float fa = wsf[crow(r, hi)]; oa[0][r] *= fa; oa[1][r] *= fa; if ((r & 3) == 3) asm volatile("" ::: "memory"); } \
            asm volatile("" : "+v"(oa[0]), "+v"(oa[1])); \
            asm volatile("" : "+v"(ob[0]), "+v"(ob[1])); \
            _Pragma("unroll") for (int r = 0; r < 16; ++r) { const float fb = wsf[32 + crow(r, hi)]; ob[0][r] *= fb; ob[1][r] *= fb; if ((r & 3) == 3) asm volatile("" ::: "memory"); } \
            asm volatile("" : "+v"(ob[0]), "+v"(ob[1])); } \
        float suma_ = 0.f, sumb_ = 0.f; if (HASNEXT) ATT_CINIT(NA, NB, tn, Hn); \
        __builtin_amdgcn_sched_barrier(0); \
        _Pragma("unroll") for (int d0 = 0; d0 < ND; ++d0) { \
            if (HASNEXT) { NA = ATT_MFMA(kf_[d0], qa[d0], NA); NB = ATT_MFMA(kf_[d0], qc[d0], NB); } \
            _Pragma("unroll") for (int r = (16 * d0) / ND; r < (16 * (d0 + 1)) / ND; ++r) { CA[r] = __builtin_amdgcn_exp2f(CA[r] - ma); suma_ += CA[r]; CB[r] = __builtin_amdgcn_exp2f(CB[r] - mb); sumb_ += CB[r]; } \
            asm volatile("" : "+v"(suma_), "+v"(sumb_)); \
            __builtin_amdgcn_sched_barrier(0); } \
        la += suma_; lb += sumb_; asm volatile("" : "+v"(la), "+v"(lb)); \
        const lcptr vp = vp0 + s_ * VSLOT; \
        { const u32x4 wa_ = ATT_PK(CA, 0), wb_ = ATT_PK(CB, 0); ATT_PV(wa_, wb_, 2 * (H)); } \
        { const u32x4 wa_ = ATT_PK(CA, 8), wb_ = ATT_PK(CB, 8); ATT_PV(wa_, wb_, 2 * (H) + 1); } } while (0)
    asm volatile("s_waitcnt vmcnt(6) lgkmcnt(0)\n\ts_barrier" ::: "memory");
    const int tb_ = 7 - db_, ta_ = 7 - da_;
    if (tb_ == 0) ATT_QK_B(0, 0);
    int t = 0;
    for (; t < tb_; ++t) {
        if (t + 2 < NT) { ATT_WAIT_BAR(3); } else { ATT_WAIT_BAR(0); }
        if (t + 3 < NT) ATT_DMA(NT - 4 - t, (t + 3) & 3);
        if (t + 1 == tb_) ATT_QK_B(t + 1, 0);
    }
    for (; t < ta_; ++t) {
        if (t + 2 < NT) { ATT_WAIT_BAR(3); } else { ATT_WAIT_BAR(0); }
        if (t + 3 < NT) ATT_DMA(NT - 4 - t, (t + 3) & 3);
        ATT_SMPV_B(t, 0); ATT_QK_B(t, 1); ATT_SMPV_B(t, 1);
        __builtin_amdgcn_sched_barrier(0);
        if (t + 1 < ta_) ATT_QK_B(t + 1, 0); else ATT_QK(t + 1, 0);
    }
    for (; t < 8; ++t) {
        if (t + 2 < NT) { ATT_WAIT_BAR(3); } else { ATT_WAIT_BAR(0); }
        if (t + 3 < NT) ATT_DMA(NT - 4 - t, (t + 3) & 3);
        ATT_SMPV(t, 0, true); ATT_QK(t, 1); ATT_SMPV(t, 1, true);
        __builtin_amdgcn_sched_barrier(0);
        if (t + 1 < NT) ATT_QK(t + 1, 0);
    }
    for (; t < NT; ++t) {
        if (t + 2 < NT) { ATT_WAIT_BAR(3); } else { ATT_WAIT_BAR(0); }
        if (t + 3 < NT) ATT_DMA(NT - 4 - t, (t + 3) & 3);
        ATT_HALF(pa, pb, pa2, pb2, t, 0, t, 1, true);
        ATT_HALF(pa2, pb2, pa, pb, t, 1, t + 1, 0, t + 1 < NT);
    }
#undef ATT_SKIP
#undef ATT_AACT
#undef ATT_QK_B
#undef ATT_SMPV_B
#undef ATT_HALF
#undef ATT_QK
#undef ATT_CINIT
#undef ATT_SMPV
#undef ATT_VF
#undef ATT_RMAX
#undef ATT_EXPS
#undef ATT_PK
#undef ATT_PV
    { auto rr = __builtin_amdgcn_permlane32_swap(__float_as_uint(la), __float_as_uint(la), false, false); la = __uint_as_float(rr[0]) + __uint_as_float(rr[1]); }
    { auto rr = __builtin_amdgcn_permlane32_swap(__float_as_uint(lb), __float_as_uint(lb), false, false); lb = __uint_as_float(rr[0]) + __uint_as_float(rr[1]); }
    if (hi == 0) { wsf[64 + r32] = la; wsf[96 + r32] = lb; }
    asm volatile("s_waitcnt lgkmcnt(0)" ::: "memory");
    { const int l2 = lane_id(), c2 = l2 & 31, h2 = l2 >> 5;
      __attribute__((address_space(3))) unsigned short* stg = (__attribute__((address_space(3))) unsigned short*)(lds + LDS_OST) + wid * 2048;
      __attribute__((address_space(3))) unsigned short* stw = stg + h2 * 256 + c2;
      const __attribute__((address_space(3))) float* wl = wsf + 64 + 4 * h2;
#pragma unroll
      for (int sb = 0; sb < 2; ++sb) {
#pragma unroll
        for (int r = 0; r < 16; ++r) { constexpr int dummy = 0; (void)dummy; const int cr = (r & 3) + 8 * (r >> 2); const float rl = __builtin_amdgcn_rcpf(wl[sb * 32 + cr]);
#pragma unroll
            for (int d0 = 0; d0 < 2; ++d0) stw[cr * 64 + d0 * 32] = (unsigned short)f2bf((sb ? ob[d0][r] : oa[d0][r]) * rl); }
        asm volatile("s_waitcnt lgkmcnt(0)" ::: "memory");
        unsigned short* Ow = Oh + (size_t)(q0 + (sb ? rb0 : ra0)) * po;
#pragma unroll
        for (int i = 0; i < 4; ++i) { const int row = i * 8 + (l2 >> 3), ch = l2 & 7; *(u32x4*)(Ow + (size_t)row * po + ch * 8) = *(const __attribute__((address_space(3))) u32x4*)(stg + row * 64 + ch * 8); }
        asm volatile("s_waitcnt lgkmcnt(0)" ::: "memory");
      } }
    asm volatile("s_waitcnt lgkmcnt(0)\n\ts_barrier" ::: "memory");
#undef ATT_DMA
}
}
namespace mid {
using bf16x8 = __attribute__((ext_vector_type(8))) short;
using f32x16 = __attribute__((ext_vector_type(16))) float;
using u32x4 = __attribute__((ext_vector_type(4))) unsigned;
typedef __attribute__((address_space(3))) char* lptr;
#define MID_MFMA(a, b, c) __builtin_amdgcn_mfma_f32_32x32x16_bf16(a, b, c, 0, 0, 0)
__device__ __forceinline__ int crow(int r, int hi) { return (r & 3) + 8 * (r >> 2) + 4 * hi; }
__device__ __forceinline__ float bf_lo(unsigned w) { return __uint_as_float(w << 16); }
__device__ __forceinline__ float bf_hi(unsigned w) { return __uint_as_float(w & 0xffff0000u); }
__device__ __forceinline__ float bfu(unsigned short v) { return __uint_as_float((unsigned)v << 16); }
__device__ __forceinline__ float xhalf_sum(float x) { auto t = __builtin_amdgcn_permlane32_swap(__float_as_uint(x), __float_as_uint(x), false, false); return __uint_as_float(t[0]) + __uint_as_float(t[1]); }
__device__ __forceinline__ float sumsq8(bf16x8 v) { float s = 0.f;
#pragma unroll
    for (int j = 0; j < 8; ++j) { const float f = bfu((unsigned short)v[j]); s += f * f; } return s; }

typedef __bf16 bf2_t __attribute__((ext_vector_type(2)));
typedef float fl2_t __attribute__((ext_vector_type(2)));
__device__ __forceinline__ unsigned cvtpk(float lo, float hi) { const fl2_t v = {lo, hi}; return __builtin_bit_cast(unsigned, __builtin_convertvector(v, bf2_t)); }
template <int KS, int NT>
__device__ __forceinline__ void latent_gemm(f32x16 (&acc)[NT], __attribute__((address_space(3))) const char* arow  , const unsigned short* wt  , float post) {
    float ss = 0.f;
#pragma unroll
    for (int nt = 0; nt < NT; ++nt) acc[nt] = f32x16{};
#pragma unroll
    for (int ks = 0; ks < KS; ++ks) { const bf16x8 a = *(const __attribute__((address_space(3))) bf16x8*)(arow + 32 * ks); ss += sumsq8(a);
#pragma unroll
        for (int nt = 0; nt < NT; ++nt) { const bf16x8 b = *reinterpret_cast<const bf16x8*>(wt + (size_t)(nt * KS + ks) * 512); acc[nt] = MID_MFMA(b, a, acc[nt]); }
        if ((ks & 3) == 3) asm volatile("" ::: "memory"); }
    ss = xhalf_sum(ss);
    const float rstd = rsqrtf(ss * (1.0f / (16 * KS)) + EPS) * post;
#pragma unroll
    for (int nt = 0; nt < NT; ++nt) acc[nt] = acc[nt] * rstd;
}
__device__ __forceinline__ void rope_tile(f32x16& x, const float* rp, int hi) {
#pragma unroll
    for (int g = 0; g < 2; ++g) { const f32x4 c0 = *(const f32x4*)(rp + (8 * g + 4 * hi) * 2), c1 = *(const f32x4*)(rp + (8 * g + 4 * hi) * 2 + 4);
        const float cs[4][2] = {{c0[0], c0[1]}, {c0[2], c0[3]}, {c1[0], c1[1]}, {c1[2], c1[3]}};
#pragma unroll
        for (int e = 0; e < 4; ++e) { const int r = 4 * g + e; const float x1 = x[r], x2 = x[r + 8]; x[r] = x1 * cs[e][0] - x2 * cs[e][1]; x[r + 8] = x2 * cs[e][0] + x1 * cs[e][1]; } }
}
__device__ __forceinline__ void stage_tiles(__attribute__((address_space(3))) char* stg, const f32x16& t0, const f32x16& t1, int r32, int hi) {
    typedef unsigned u32x2_ __attribute__((ext_vector_type(2)));
#pragma unroll
    for (int n2 = 0; n2 < 2; ++n2) { const f32x16& t = n2 ? t1 : t0;
#pragma unroll
        for (int g = 0; g < 4; ++g) { u32x2_ w; w.x = cvtpk(t[4 * g], t[4 * g + 1]); w.y = cvtpk(t[4 * g + 2], t[4 * g + 3]);
            *(__attribute__((address_space(3))) u32x2_*)(stg + r32 * 144 + (32 * n2 + 8 * g + 4 * hi) * 2) = w; } }
}

constexpr float QSCALE = 0.10206207261596577f * 1.4426950408889634f;
constexpr int STG_BYTES = 16384;
template <class F> __device__ __forceinline__ void stage_out(__attribute__((address_space(3))) const char* stg, int lane, F dst) {
#pragma unroll
    for (int it = 0; it < 4; ++it) { const int row = it * 8 + (lane >> 3), ch = lane & 7;
        *(u32x4*)dst(row, ch) = *(const __attribute__((address_space(3))) u32x4*)(stg + row * 144 + ch * 16); }
}

constexpr int ATILE_BYTES = 128 * 704, OSTG_OFF = ATILE_BYTES, OSTG_BYTES = 4608;
__device__ __forceinline__ void glds16(const void* g, unsigned lds_base) {
    unsigned sv; asm volatile("s_mov_b32 %0, m0\n\ts_mov_b32 m0, %2\n\ts_nop 0\n\tglobal_load_lds_dwordx4 %1, off\n\ts_mov_b32 m0, %0" : "=&s"(sv) : "v"(g), "s"(lds_base) : "memory"); }
constexpr int LAT_TBL = OSTG_OFF + 8 * OSTG_BYTES;
template <int KS> __device__ __forceinline__ void latent_tile(f32x16 (&acc)[4], __attribute__((address_space(3))) const char* a0, const unsigned short* wt) {
#pragma unroll
    for (int blk = 0; blk < 4; ++blk) acc[blk] = f32x16{};
#pragma unroll
    for (int ks = 0; ks < KS; ++ks) { const bf16x8 w = *reinterpret_cast<const bf16x8*>(wt + (size_t)ks * 512);
#pragma unroll
        for (int blk = 0; blk < 4; ++blk) { const bf16x8 a = *(const __attribute__((address_space(3))) bf16x8*)(a0 + blk * (32 * 704) + 32 * ks); acc[blk] = MID_MFMA(w, a, acc[blk]); } }
}
__device__ __forceinline__ void p2_latent(KArgs ka, int l, int tok0, lptr L, int wv) {
    unsigned char* ws = ka->ws; const int lane = lane_id(), r32 = lane & 31, hi = lane >> 5, tb = wv & 3, g = wv >> 2;
    const unsigned short* Z = (const unsigned short*)(ws + WS_Z); const size_t wl = WS_W + (size_t)l * W_LAYER;
    {
        const unsigned lds0 = (unsigned)(uintptr_t)L;
#pragma unroll
        for (int p = 0; p < 11; ++p) { const int id = (wv * 11 + p) * 64 + lane, row = id / 44, ch = id % 44;
            glds16(Z + (size_t)(tok0 + row) * DINP + ch * 8, (unsigned)__builtin_amdgcn_readfirstlane(lds0 + (wv * 11 + p) * 1024)); }
        asm volatile("s_waitcnt vmcnt(0)" ::: "memory"); __syncthreads();
    }
    __attribute__((address_space(3))) float* tbl = (__attribute__((address_space(3))) float*)(L + LAT_TBL);
    {   const int tid = wv * 64 + lane, tl = tid & 127, lat = (tid >> 7) & 1, half = tid >> 8;
        __attribute__((address_space(3))) const char* row = (__attribute__((address_space(3))) const char*)L + tl * 704 + (lat ? O_KVC * 2 + half * 128 : half * 192);
        float sq = 0.f;
#pragma unroll
        for (int c = 0; c < 12; ++c) if (c < 8 || lat == 0) sq += sumsq8(*(const __attribute__((address_space(3))) bf16x8*)(row + 16 * c));
        tbl[(half * 2 + lat) * 128 + tl] = sq;
        __syncthreads();
        if (tid < 256) { const int l2 = tid >> 7, t2 = tid & 127; const float ss = tbl[l2 * 128 + t2] + tbl[(2 + l2) * 128 + t2];
            tbl[512 + l2 * 128 + t2] = rsqrtf(ss * (l2 ? 1.0f / 128.0f : 1.0f / 192.0f) + EPS) * (l2 ? 1.0f : QSCALE); }
        __syncthreads();
    }
    __attribute__((address_space(3))) char* stg = (__attribute__((address_space(3))) char*)(L + OSTG_OFF + wv * OSTG_BYTES);
    for (int it = 0; it < 4; ++it) {
        int jt; bool isq;
        if (wv < 4) { if (it == 3) break; isq = it < 2; jt = it < 2 ? wv + 8 * it : wv; }
        else { isq = it == 0; jt = it == 0 ? wv : 4 + 3 * (wv - 4) + (it - 1); }
        f32x16 acc[4];
        __attribute__((address_space(3))) const char* a0 = (__attribute__((address_space(3))) const char*)L + r32 * 704 + 16 * hi + (isq ? 0 : O_KVC * 2);
        if (isq) latent_tile<12>(acc, a0, (const unsigned short*)(ws + wl + W_UQ) + (size_t)jt * 12 * 512 + lane * 8);
        else latent_tile<8>(acc, a0, (const unsigned short*)(ws + wl + W_UKV) + (size_t)jt * 8 * 512 + lane * 8);
        const bool rope = isq && (jt % 3) == 2;
#pragma unroll
        for (int blk = 0; blk < 4; ++blk) {
            const float rs = tbl[512 + (isq ? 0 : 128) + 32 * blk + r32];
            f32x16 t = acc[blk] * rs;
            if (rope) rope_tile(t, (const float*)(ws + WS_ROPE) + (size_t)(tok0 + 32 * blk + r32) * 32, hi);
            typedef unsigned u32x2_ __attribute__((ext_vector_type(2)));
#pragma unroll
            for (int g = 0; g < 4; ++g) { u32x2_ w; w.x = cvtpk(t[4 * g], t[4 * g + 1]); w.y = cvtpk(t[4 * g + 2], t[4 * g + 3]);
                *(__attribute__((address_space(3))) u32x2_*)(stg + r32 * 80 + (8 * g + 4 * hi) * 2) = w; }
            asm volatile("s_waitcnt lgkmcnt(0)" ::: "memory");
            unsigned short* dst; int pitch;
            if (isq) { dst = (unsigned short*)(ws + WS_Q) + (size_t)(tok0 + 32 * blk) * 384 + 32 * jt; pitch = 384; }
            else { const int head = jt >> 2, nt = jt & 3;
                if (nt < 2) { dst = (unsigned short*)(ws + WS_K) + (size_t)(tok0 + 32 * blk) * 384 + head * 96 + 32 * nt; pitch = 384; }
                else { dst = (unsigned short*)(ws + WS_V) + (size_t)(tok0 + 32 * blk) * 256 + head * 64 + 32 * (nt - 2); pitch = 256; } }
#pragma unroll
            for (int i2 = 0; i2 < 2; ++i2) { const int row = i2 * 16 + (lane >> 2), ch = lane & 3;
                *(u32x4*)(dst + (size_t)row * pitch + ch * 8) = *(const __attribute__((address_space(3))) u32x4*)(stg + row * 80 + ch * 16); }
            asm volatile("s_waitcnt lgkmcnt(0)" ::: "memory");
        }
    }
    {
        const int tid = wv * 64 + lane, tl = tid & 127, t = tok0 + tl, i0 = 4 * (tid >> 7);
        __attribute__((address_space(3))) const unsigned short* zr = (__attribute__((address_space(3))) const unsigned short*)(L + tl * 704 + O_KR * 2); const float* rk = (const float*)(ws + WS_ROPE) + (size_t)t * 32;
        asm volatile("s_waitcnt lgkmcnt(0)\n\ts_barrier" ::: "memory");
        __attribute__((address_space(3))) unsigned short* rt = (__attribute__((address_space(3))) unsigned short*)(L + OSTG_OFF);
#pragma unroll
        for (int q = 0; q < 4; ++q) { const int i = i0 + q; const float x1 = bfu(zr[i]), x2 = bfu(zr[16 + i]), c = rk[2 * i], sn = rk[2 * i + 1];
            rt[tl * 32 + i] = (unsigned short)f2bf(x1 * c - x2 * sn); rt[tl * 32 + 16 + i] = (unsigned short)f2bf(x2 * c + x1 * sn); }
        asm volatile("s_waitcnt lgkmcnt(0)\n\ts_barrier" ::: "memory");
        unsigned short* K = (unsigned short*)(ws + WS_K) + (size_t)tok0 * 384;
#pragma unroll
        for (int k = 0; k < 4; ++k) { const int cidx = tid + 512 * k, tok = cidx >> 4, hd = (cidx >> 2) & 3, part = cidx & 3;
            *(u32x4*)(K + (size_t)tok * 384 + hd * 96 + 64 + part * 8) = *(const __attribute__((address_space(3))) u32x4*)(rt + tok * 32 + part * 8); }
    }
    __syncthreads();
}

__device__ __forceinline__ float log_sigmoid(float x) { return fminf(x, 0.f) - 0.6931471805599453f * __builtin_amdgcn_logf(1.f + __builtin_amdgcn_exp2f(-1.4426950408889634f * fabsf(x))); }
__device__ __forceinline__ void p2_forget(KArgs ka, int l, int b, int tt, lptr L, int wv) {
    unsigned char* ws = ka->ws; const int lane = lane_id(), tid = wv * 64 + lane, h = tid & 3, j = tid >> 2;
    const float* FL = (const float*)(ws + WS_FL) + (size_t)b * S * 4; const float bf = ka->in[9][l * 4 + h];
    __attribute__((address_space(3))) double* red = (__attribute__((address_space(3))) double*)(L + 8 * STG_BYTES + 1024);
    __attribute__((address_space(3))) float* own = (__attribute__((address_space(3))) float*)(L + 8 * STG_BYTES + 1024 + 4096);
    double part = 0.0;
#pragma unroll 8
    for (int t = j; t < 128 * tt; t += 128) part += (double)log_sigmoid(FL[(size_t)t * 4 + h] + bf);
    red[h * 128 + j] = part; own[h * 128 + j] = log_sigmoid(FL[(size_t)(128 * tt + j) * 4 + h] + bf);
    __syncthreads();
    if (wv < 4) {
        const int hh = wv; double c = red[hh * 128 + 2 * lane] + red[hh * 128 + 2 * lane + 1];
#pragma unroll
        for (int o = 1; o < 64; o <<= 1) c += lshfl(c, lane ^ o);
        const float v0 = own[hh * 128 + 2 * lane], v1 = own[hh * 128 + 2 * lane + 1]; float s = v0 + v1, incl = s;
#pragma unroll
        for (int o = 1; o < 64; o <<= 1) { const float up = lshfl(incl, (lane - o) & 63); if (lane >= o) incl += up; }
        const double c0 = c + (double)(incl - s) + (double)v0, c1 = c0 + (double)v1;
        float* cbx = (float*)(ws + WS_CBX) + ((size_t)(b * 64 + 2 * tt) * 4 + hh) * 64;
#pragma unroll
        for (int q = 0; q < 2; ++q) { const int k128 = 2 * lane + q, tile = k128 >> 6, k = k128 & 63, khi = (k >> 2) & 1, n = k >> 5, r = (k & 3) + 4 * ((k & 31) >> 3);
            cbx[(size_t)tile * 256 + khi * 32 + n * 16 + r] = (float)(-(q ? c1 : c0) * 1.4426950408889634); }
    }
    __syncthreads();
}

__device__ __forceinline__ float gelu_tanh(float x) { const float u = 0.7978845608028654f * (x + 0.044715f * x * x * x); const float e = __expf(2.f * u); return x * (1.f - __builtin_amdgcn_rcpf(e + 1.f)); }
__device__ __forceinline__ void lru_load_table(KArgs ka, int l, lptr L, int wv) {
    const int tid = wv * 64 + lane_id(); __attribute__((address_space(3))) float* tab = (__attribute__((address_space(3))) float*)(L + LRU_TAB_OFF);
    const float* cw = ka->in[10] + (size_t)l * 4 * LRU_W; const float* cbias = ka->in[11] + (size_t)l * LRU_W;
    for (int i = tid; i < 5 * LRU_W; i += 512) tab[i] = i < 4 * LRU_W ? cw[i] : cbias[i - 4 * LRU_W];
    __syncthreads();
}
__device__ __forceinline__ void lru_pass1(KArgs ka, int l, int b, int tt, lptr L, int wv) {
    unsigned char* ws = ka->ws; const int lane = lane_id(), r32 = lane & 31, hi = lane >> 5;
    const int cb0 = 64 * wv, u = b * 32 + tt;
    const unsigned short* Z = (const unsigned short*)(ws + WS_Z); const size_t wl = WS_W + (size_t)l * W_LAYER;
    const __attribute__((address_space(3))) float* tab = (const __attribute__((address_space(3))) float*)(L + LRU_TAB_OFF) + cb0 + 8 * hi;
    bf16x8 idf[2];
#pragma unroll
    for (int q = 0; q < 2; ++q)
#pragma unroll
        for (int j = 0; j < 8; ++j) idf[q][j] = ((r32 >> 4) == q && (r32 & 15) == 8 * hi + j) ? (short)0x3f80 : (short)0;
    float A_run[2] = {1.f, 1.f}, H_run[2] = {0.f, 0.f};
    const unsigned short* zl = Z + (size_t)(b * S) * DINP + O_LX + cb0 + 8 * hi;
#define LRU_LOADZ(dst, sbi) do { const int t_ = 128 * tt + 32 * (sbi) + r32; const int tc_ = t_ < 0 ? 0 : t_; _Pragma("unroll") for (int ks = 0; ks < 4; ++ks) { \
        bf16x8 v_ = *reinterpret_cast<const bf16x8*>(zl + (size_t)tc_ * DINP + 16 * ks); if (t_ < 0) v_ = bf16x8{}; dst[ks] = v_; } } while (0)
    bf16x8 wrf[2][4], wif[2][4];
#pragma unroll
    for (int nt = 0; nt < 2; ++nt)
#pragma unroll
        for (int ks = 0; ks < 4; ++ks) { const size_t o = (size_t)wv * 4096 + (size_t)(nt * 4 + ks) * 512 + lane * 8;
            wrf[nt][ks] = *reinterpret_cast<const bf16x8*>((const unsigned short*)(ws + wl + W_R) + o); wif[nt][ks] = *reinterpret_cast<const bf16x8*>((const unsigned short*)(ws + wl + W_I) + o); }
    bf16x8 zprev[4], zcur[4], znext[4];
    LRU_LOADZ(zprev, -1); LRU_LOADZ(zcur, 0);
    for (int sb = 0; sb < 4; ++sb) {
        if (sb < 3) LRU_LOADZ(znext, sb + 1);
        bf16x8 af[4];
#pragma unroll
        for (int ks = 0; ks < 4; ++ks) {
            float xv[8];
            { const f32x4 b0 = *(const __attribute__((address_space(3))) f32x4*)(tab + 4 * LRU_W + 16 * ks), b1 = *(const __attribute__((address_space(3))) f32x4*)(tab + 4 * LRU_W + 16 * ks + 4);
              const f32x4 w0 = *(const __attribute__((address_space(3))) f32x4*)(tab + 3 * LRU_W + 16 * ks), w1 = *(const __attribute__((address_space(3))) f32x4*)(tab + 3 * LRU_W + 16 * ks + 4);
#pragma unroll
              for (int j = 0; j < 4; ++j) { xv[j] = b0[j] + w0[j] * bfu((unsigned short)zcur[ks][j]); xv[4 + j] = b1[j] + w1[j] * bfu((unsigned short)zcur[ks][4 + j]); } }
            const u32x4 cu = __builtin_bit_cast(u32x4, zcur[ks]), pu = __builtin_bit_cast(u32x4, zprev[ks]);
#pragma unroll
            for (int d = 1; d <= 3; ++d) {
                const int src = (((r32 - d) & 31) + 32 * hi) * 4; u32x4 sh;
#pragma unroll
                for (int q = 0; q < 4; ++q) { const unsigned c_ = (unsigned)__builtin_amdgcn_ds_bpermute(src, (int)cu[q]), p_ = (unsigned)__builtin_amdgcn_ds_bpermute(src, (int)pu[q]); sh[q] = r32 >= d ? c_ : p_; }
                const f32x4 w0 = *(const __attribute__((address_space(3))) f32x4*)(tab + (3 - d) * LRU_W + 16 * ks), w1 = *(const __attribute__((address_space(3))) f32x4*)(tab + (3 - d) * LRU_W + 16 * ks + 4);
                xv[0] += w0[0] * bf_lo(sh[0]); xv[1] += w0[1] * bf_hi(sh[0]); xv[2] += w0[2] * bf_lo(sh[1]); xv[3] += w0[3] * bf_hi(sh[1]);
                xv[4] += w1[0] * bf_lo(sh[2]); xv[5] += w1[1] * bf_hi(sh[2]); xv[6] += w1[2] * bf_lo(sh[3]); xv[7] += w1[3] * bf_hi(sh[3]); }
#pragma unroll
            for (int j = 0; j < 8; ++j) af[ks][j] = (short)f2bf(xv[j]);
        }
#pragma unroll
        for (int nt = 0; nt < 2; ++nt) {
            __builtin_amdgcn_sched_barrier(0);
            const int ch = cb0 + 32 * nt + r32;
            f32x16 rp = f32x16{}, ip = f32x16{}, xc = f32x16{};
#pragma unroll
            for (int ks = 0; ks < 4; ++ks) { rp = MID_MFMA(af[ks], wrf[nt][ks], rp); ip = MID_MFMA(af[ks], wif[nt][ks], ip); }
            xc = MID_MFMA(af[2 * nt], idf[0], xc); xc = MID_MFMA(af[2 * nt + 1], idf[1], xc);
            u32x4 pk[4];
            {   const float br = ka->in[13][l * LRU_W + ch], bi = ka->in[15][l * LRU_W + ch]; const float nl = -ka->in[16][l * LRU_W + ch]; const float la8 = -8.0f * (fmaxf(nl, 0.f) + 0.6931471805599453f * __builtin_amdgcn_logf(1.f + __builtin_amdgcn_exp2f(-1.4426950408889634f * fabsf(nl))));
#pragma unroll
                for (int r = 0; r < 16; ++r) { const float rg = __builtin_amdgcn_rcpf(1.f + __expf(-(rp[r] + br))), ig = __builtin_amdgcn_rcpf(1.f + __expf(-(ip[r] + bi)));
                    const float a = __expf(rg * la8); rp[r] = 1.f - a; ip[r] = __builtin_amdgcn_sqrtf(fmaxf(1.f - a * a, 0.f)) * (ig * xc[r]); }
#pragma unroll
                for (int r = 0; r < 16; r += 2) { const unsigned wa = pk2(rp[r], rp[r + 1]), wb = pk2(ip[r], ip[r + 1]); pk[r >> 3][(r >> 1) & 3] = wa; pk[2 + (r >> 3)][(r >> 1) & 3] = wb;
                    rp[r] = 1.f - bf_lo(wa); rp[r + 1] = 1.f - bf_hi(wa); ip[r] = bf_lo(wb); ip[r + 1] = bf_hi(wb); } }
            { u32x4* dst = (u32x4*)(ws + WS_PP) + ((((size_t)u * 8 + wv) * 4 + sb) * 2 + nt) * 256 + lane * 4;
#pragma unroll
              for (int q = 0; q < 4; ++q) dst[q] = pk[q]; }
            float st = H_run[nt], ap = A_run[nt];
#pragma unroll
            for (int g = 0; g < 4; ++g) { float A = 1.f, Bv = 0.f;
#pragma unroll
                for (int q = 0; q < 4; ++q) { const float a = rp[4 * g + q]; Bv = a * Bv + ip[4 * g + q]; A *= a; }
                auto ta = __builtin_amdgcn_permlane32_swap(__float_as_uint(A), __float_as_uint(A), false, false); auto tb = __builtin_amdgcn_permlane32_swap(__float_as_uint(Bv), __float_as_uint(Bv), false, false);
                const float oA = __uint_as_float(hi ? ta[0] : ta[1]), oB = __uint_as_float(hi ? tb[0] : tb[1]);
                const float pA = hi ? oA : A, pB = hi ? oB : Bv, qA = hi ? A : oA, qB = hi ? Bv : oB;
                st = pA * st + pB; st = qA * st + qB; ap *= pA * qA; }
            H_run[nt] = st; A_run[nt] = ap;
        }
#pragma unroll
        for (int ks = 0; ks < 4; ++ks) { zprev[ks] = zcur[ks]; zcur[ks] = znext[ks]; }
    }
#undef LRU_LOADZ
    if (hi == 0) {
#pragma unroll
        for (int nt = 0; nt < 2; ++nt) { float* sum = (float*)(ws + WS_LRUSUM) + (size_t)u * 1024 + cb0 + 32 * nt + r32; sum[0] = A_run[nt]; sum[512] = H_run[nt]; } }
}
__device__ __forceinline__ void lru_pass2(KArgs ka, int l, int b, int tt, lptr L, int wv) {
    unsigned char* ws = ka->ws; const int lane = lane_id(), r32 = lane & 31, hi = lane >> 5;
    const int tok0 = b * S + 128 * tt, cb0 = 64 * wv, u = b * 32 + tt;
    const unsigned short* Z = (const unsigned short*)(ws + WS_Z);
    bf16x8 idf[2];
#pragma unroll
    for (int q = 0; q < 2; ++q)
#pragma unroll
        for (int j = 0; j < 8; ++j) idf[q][j] = ((r32 >> 4) == q && (r32 & 15) == 8 * hi + j) ? (short)0x3f80 : (short)0;
    float H_run[2] = {0.f, 0.f};
    { const float* sum = (const float*)(ws + WS_LRUSUM) + (size_t)(b * 32) * 1024;
#pragma unroll 8
      for (int t2 = 0; t2 < tt; ++t2)
#pragma unroll
          for (int nt = 0; nt < 2; ++nt) { const int ch = cb0 + 32 * nt + r32; H_run[nt] = sum[(size_t)t2 * 1024 + ch] * H_run[nt] + sum[(size_t)t2 * 1024 + 512 + ch]; } }
    __attribute__((address_space(3))) float* otile = (__attribute__((address_space(3))) float*)L;
    const u32x4* ab = (const u32x4*)(ws + WS_PP) + (((size_t)u * 8 + wv) * 4) * 2 * 256 + lane * 4;
    u32x4 pk[2][4]; bf16x8 lg[4];
#define LRU_LOAD2(sbi) do { _Pragma("unroll") for (int nt = 0; nt < 2; ++nt) _Pragma("unroll") for (int q = 0; q < 4; ++q) pk[nt][q] = ab[((size_t)(sbi) * 2 + nt) * 256 + q]; \
        _Pragma("unroll") for (int ks = 0; ks < 4; ++ks) lg[ks] = *reinterpret_cast<const bf16x8*>(Z + (size_t)(tok0 + 32 * (sbi) + r32) * DINP + O_LG + cb0 + 16 * ks + 8 * hi); } while (0)
    LRU_LOAD2(0);
    for (int sb = 0; sb < 4; ++sb) {
        float av[2][16], bv[2][16]; f32x16 lgc[2];
#pragma unroll
        for (int nt = 0; nt < 2; ++nt) {
#pragma unroll
            for (int r = 0; r < 16; r += 2) { const unsigned wa = pk[nt][r >> 3][(r >> 1) & 3], wb = pk[nt][2 + (r >> 3)][(r >> 1) & 3];
                av[nt][r] = 1.f - bf_lo(wa); av[nt][r + 1] = 1.f - bf_hi(wa); bv[nt][r] = bf_lo(wb); bv[nt][r + 1] = bf_hi(wb); }
            lgc[nt] = f32x16{}; lgc[nt] = MID_MFMA(lg[2 * nt], idf[0], lgc[nt]); lgc[nt] = MID_MFMA(lg[2 * nt + 1], idf[1], lgc[nt]); }
        if (sb < 3) LRU_LOAD2(sb + 1);
#pragma unroll
        for (int nt = 0; nt < 2; ++nt) {
            const int ch = cb0 + 32 * nt + r32; float carry[4]; float st = H_run[nt];
#pragma unroll
            for (int g = 0; g < 4; ++g) { float A = 1.f, Bv = 0.f;
#pragma unroll
                for (int q = 0; q < 4; ++q) { const float a = av[nt][4 * g + q]; Bv = a * Bv + bv[nt][4 * g + q]; A *= a; }
                auto ta = __builtin_amdgcn_permlane32_swap(__float_as_uint(A), __float_as_uint(A), false, false); auto tb = __builtin_amdgcn_permlane32_swap(__float_as_uint(Bv), __float_as_uint(Bv), false, false);
                const float oA = __uint_as_float(hi ? ta[0] : ta[1]), oB = __uint_as_float(hi ? tb[0] : tb[1]);
                const float pA = hi ? oA : A, pB = hi ? oB : Bv, qA = hi ? A : oA, qB = hi ? Bv : oB;
                const float c0 = st; st = pA * st + pB; const float c1 = st; st = qA * st + qB; carry[g] = hi ? c1 : c0; }
            H_run[nt] = st;
#pragma unroll
            for (int g = 0; g < 4; ++g) { float hcur = carry[g];
#pragma unroll
                for (int q = 0; q < 4; ++q) { const int r = 4 * g + q; hcur = av[nt][r] * hcur + bv[nt][r]; otile[(sb & 1) * 16384 + crow(r, hi) * 512 + ch] = hcur * gelu_tanh(lgc[nt][r]); } }
        }
        asm volatile("s_waitcnt lgkmcnt(0)\n\ts_barrier" ::: "memory");
#pragma unroll
        for (int q = 0; q < 4; ++q) { const int row = 4 * wv + q; const __attribute__((address_space(3))) float* src = otile + (sb & 1) * 16384 + row * 512 + 8 * lane;
            const f32x4 x0 = *(const __attribute__((address_space(3))) f32x4*)src, x1 = *(const __attribute__((address_space(3))) f32x4*)(src + 4);
            float s = (x0[0] * x0[0] + x0[1] * x0[1]) + (x0[2] * x0[2] + x0[3] * x0[3]) + (x1[0] * x1[0] + x1[1] * x1[1]) + (x1[2] * x1[2] + x1[3] * x1[3]);
            s = wave_sum(s, lane); const float rn = rsqrtf(s * (1.0f / 512.0f) + EPS);
            u32x4 o; o.x = pk2(x0[0] * rn, x0[1] * rn); o.y = pk2(x0[2] * rn, x0[3] * rn); o.z = pk2(x1[0] * rn, x1[1] * rn); o.w = pk2(x1[2] * rn, x1[3] * rn);
            *(u32x4*)((unsigned short*)(ws + WS_O) + (size_t)(tok0 + 32 * sb + row) * D + 512 + 8 * lane) = o; }
    }
#undef LRU_LOAD2
#pragma unroll
    for (int q0 = 0; q0 < 16; q0 += 8) { u32x4 v[8]; unsigned short* p0 = (unsigned short*)(ws + WS_O) + (size_t)(tok0 + 16 * wv + q0) * D + 8 * lane;
#pragma unroll
        for (int q = 0; q < 8; ++q) v[q] = *(const u32x4*)(p0 + (size_t)q * D);
#pragma unroll
        for (int q = 0; q < 8; ++q) {
            float f[8] = {bf_lo(v[q].x), bf_hi(v[q].x), bf_lo(v[q].y), bf_hi(v[q].y), bf_lo(v[q].z), bf_hi(v[q].z), bf_lo(v[q].w), bf_hi(v[q].w)};
            float s = 0.f;
#pragma unroll
            for (int j = 0; j < 8; ++j) s += f[j] * f[j];
#pragma unroll
            for (int o = 1; o < 32; o <<= 1) s += lshfl(s, lane ^ o);
            const float rn = rsqrtf(s * (1.0f / 256.0f) + EPS);
            u32x4 w; w.x = pk2(f[0] * rn, f[1] * rn); w.y = pk2(f[2] * rn, f[3] * rn); w.z = pk2(f[4] * rn, f[5] * rn); w.w = pk2(f[6] * rn, f[7] * rn); *(u32x4*)(p0 + (size_t)q * D) = w; } }
}
}
__device__ __forceinline__ int zcol_perm(int n) { return n < 1120 ? n : (n < 1124 ? 2144 + (n - 1120) : (n < DIN ? n - 4 : n)); }
__device__ __forceinline__ int up_perm(int n) { return n < DFF ? 256 * (n >> 7) + (n & 127) : 256 * ((n - DFF) >> 7) + 128 + ((n - DFF) & 127); }
__device__ __forceinline__ void tr_item(const float* W, int K, int N, const float* g, bf16* WT, int mode, LAS float* scr, int kb, int nb, int lane) {
    const int k0 = 64 * kb, n0 = 32 * nb;
#pragma unroll 8
    for (int i = 0; i < 32; ++i) { const int kk = 2 * i + (lane >> 5), n = n0 + (lane & 31); float v = (n < N) ? W[(size_t)(k0 + kk) * N + n] : 0.f; if (g) v *= g[k0 + kk]; scr[kk * 33 + (lane & 31)] = v; }
    LDS_WAIT(); asm volatile("" ::: "memory");
    const int c = lane & 7;
#pragma unroll
    for (int j = 0; j < 4; ++j) { const int nl = (lane >> 3) + 8 * j, n = n0 + nl; const int dest = mode == 1 ? up_perm(n) : (mode == 2 ? zcol_perm(n) : n); const LAS float* s = scr + (8 * c) * 33 + nl;
        v4u o; o.x = pk2(s[0 * 33], s[1 * 33]); o.y = pk2(s[2 * 33], s[3 * 33]); o.z = pk2(s[4 * 33], s[5 * 33]); o.w = pk2(s[6 * 33], s[7 * 33]);
        if (mode == 3) { const int c8 = (k0 >> 3) + c;
            *(GAS v4u*)(WT + ((size_t)((n >> 5) * (K >> 4) + (c8 >> 1)) * 64 + (c8 & 1) * 32 + (n & 31)) * 8) = o; }
        else *(GAS v4u*)(WT + (size_t)dest * K + k0 + 8 * c) = o; }
    LDS_WAIT(); asm volatile("" ::: "memory");
}
__global__ void __launch_bounds__(NWAVES * 64, 2) mega(Args args) {
    extern __shared__ __attribute__((aligned(16))) unsigned char lds[];
    LAS unsigned char* L = (LAS unsigned char*)lds;
    const int wave = __builtin_amdgcn_readfirstlane((int)threadIdx.x >> 6);
    {
        const int t0 = wave * 64 + lane_id();
        for (int u = t0; u < (LDS_BYTES - LDSCTL_OFF) / 4; u += NWAVES * 64) ((LAS unsigned*)(L + LDSCTL_OFF))[u] = 0u;
        __syncthreads();
        if (kargs()->ph_hi - kargs()->ph_lo > 1) (void)xcd_barrier_post((unsigned*)(kargs()->ws + WS_CTL) + CW_BAR, (volatile LAS unsigned*)(L + MISC_OFF) + 8);
    }
#define GRID_BAR(p) do { if (IN(p) && IN((p) + 1)) { XcdBarrier gb_; gb_.bar = (unsigned*)(kargs()->ws + WS_CTL) + CW_BAR; gb_.x = xb_xcc_id(); gb_.st = (volatile LAS unsigned*)(L + MISC_OFF) + 8; xcd_barrier(gb_); } } while (0)
#define GRID_IDS int G = gridDim.x, bx = blockIdx.x, wv = wave; asm volatile("" : "+s"(G), "+s"(bx), "+s"(wv)); const int vcu = (G % 8 == 0) ? (bx % 8) * (G / 8) + bx / 8 : bx; const int gw = vcu * NWAVES + wv, NGW = G * NWAVES; (void)gw; (void)NGW
#ifndef PH_MASK
#define PH_MASK 0xFFFFFF
#endif
#ifndef REPEAT_MASK
#define REPEAT_MASK 0
#endif
#define IN(p) (kargs()->ph_lo <= (p) && (p) < kargs()->ph_hi)
#define PHASE_PTRS const KArgs ka = kargs(); unsigned char* ws = ka->ws; (void)ws; GRID_IDS
#define LANE_IDS const int lane = lane_id(), tid = wv * 64 + lane; (void)tid
    if ((PH_MASK & 1) && IN(0)) {
            PHASE_PTRS; LANE_IDS; bf16* HB = (bf16*)(ws + WS_HB); float* SSA = (float*)(ws + WS_SSA);
            LAS float* scr = (LAS float*)(L + RING_OFF + wv * 16384);
            {
                constexpr int I_IN = (D / 64) * (DINP / 32), I_O = (D / 64) * (D / 32), I_UP = (D / 64) * (2 * DFF / 32), I_DN = (DFF / 64) * (D / 32), I_PG = I_O, I_PP = (PLE / 64) * (D / 32);
                constexpr int I_UQ = (192 / 64) * (384 / 32), I_UKV = (128 / 64) * (512 / 32), I_RI = 32;
                constexpr int I_LAYER = I_IN + I_O + I_UP + I_DN + I_PG + I_PP + I_UQ + I_UKV + I_RI;
                for (int it0 = gw; it0 < DEPTH * I_LAYER; it0 += NGW) {
                    const int ll = it0 / I_LAYER; int it = it0 % I_LAYER;
                    unsigned char* w2 = ws + WS_W + (size_t)ll * W_LAYER;
                    const float* W; const float* gs; bf16* WT; int K, N, Npad, mode = 0;
                    if (it < I_IN) { W = ka->in[4] + (size_t)ll * D * DIN; gs = ka->in[3] + ll * D; WT = (bf16*)(w2 + W_IN); K = D; N = DIN; Npad = DINP; mode = 2; }
                    else if ((it -= I_IN) < I_O) { W = ka->in[18] + (size_t)ll * D * D; gs = ka->in[17] + ll * D; WT = (bf16*)(w2 + W_O); K = D; N = D; Npad = D; }
                    else if ((it -= I_O) < I_UP) { W = ka->in[20] + (size_t)ll * D * 2 * DFF; gs = ka->in[19] + ll * D; WT = (bf16*)(w2 + W_UP); K = D; N = 2 * DFF; Npad = 2 * DFF; mode = 1; }
                    else if ((it -= I_UP) < I_DN) { W = ka->in[23] + (size_t)ll * DFF * D; gs = nullptr; WT = (bf16*)(w2 + W_DN); K = DFF; N = D; Npad = D; }
                    else if ((it -= I_DN) < I_PG) { W = ka->in[25] + (size_t)ll * D * D; gs = ka->in[24] + ll * D; WT = (bf16*)(w2 + W_PG); K = D; N = D; Npad = D; }
                    else if ((it -= I_PG) < I_PP) { W = ka->in[26] + (size_t)ll * PLE * D; gs = nullptr; WT = (bf16*)(w2 + W_PP); K = PLE; N = D; Npad = D; }
                    else if ((it -= I_PP) < I_UQ) { W = ka->in[6] + (size_t)ll * 192 * 384; gs = ka->in[5] + ll * 192; WT = (bf16*)(w2 + W_UQ); K = 192; N = 384; Npad = 384; mode = 3; }
                    else if ((it -= I_UQ) < I_UKV) { W = ka->in[8] + (size_t)ll * 128 * 512; gs = ka->in[7] + ll * 128; WT = (bf16*)(w2 + W_UKV); K = 128; N = 512; Npad = 512; mode = 3; }
                    else { it -= I_UKV; const int mi = it >> 1; it &= 1;
                        W = (mi < 8 ? ka->in[12] : ka->in[14]) + ((size_t)ll * 8 + (mi & 7)) * 4096; gs = nullptr; WT = (bf16*)(w2 + (mi < 8 ? W_R : W_I)) + (size_t)(mi & 7) * 4096; K = 64; N = 64; Npad = 64; mode = 3; }
                    const int nblk = Npad / 32;
                    tr_item(W, K, N, gs, WT, mode, scr, it / nblk, it % nblk, lane);
                }
            }
            const float* x = ka->in[0];
            for (int m = gw; m < M; m += NGW) {
                const GAS f32x4* xr = (const GAS f32x4*)(x + (size_t)m * D) + lane;
                f32x4 v[4]; float s = 0.f;
#pragma unroll
                for (int j = 0; j < 4; ++j) { v[j] = xr[64 * j]; s += (v[j].x * v[j].x + v[j].y * v[j].y) + (v[j].z * v[j].z + v[j].w * v[j].w); }
                s = wave_sum(s, lane);
                GAS unsigned long long* o8 = (GAS unsigned long long*)(HB + (size_t)m * D) + lane;
#pragma unroll
                for (int j = 0; j < 4; ++j) o8[64 * j] = (unsigned long long)pk2(v[j].x, v[j].y) | ((unsigned long long)pk2(v[j].z, v[j].w) << 32);
                if (lane < 4) { f32x4 z4 = {lane == 0 ? s : 0.f, 0.f, 0.f, 0.f}; *(f32x4*)(SSA + (size_t)m * 16 + lane * 4) = z4; }
            }
            {
                float* rope = (float*)(ws + WS_ROPE); const int* pos = (const int*)ka->in[2];
                for (int i = bx * 512 + tid; i < M * 16; i += G * 512) { const int t = i >> 4, f = i & 15;
                    const float ang = (float)pos[t] * __builtin_amdgcn_exp2f(-0.8304820237218406f * (float)f);
                    double rv = (double)ang * 0.15915494309189535; rv -= __builtin_floor(rv); const float fr = (float)rv;
                    rope[2 * i] = __builtin_amdgcn_cosf(fr); rope[2 * i + 1] = __builtin_amdgcn_sinf(fr); }
            }
            {
                float* cwt = (float*)(ws + WS_CWT);
                for (int i = bx * 512 + tid; i < DEPTH * 704 * 32; i += G * 512) {
                    const int e = i & 3, slot = (i >> 2) & 7, jg = (i >> 5) % 704, ll = i / (704 * 32);
                    const int col = (slot < 4 ? 0 : DFF) + 4 * jg + e, k = slot & 3;
                    cwt[i] = (slot < 4 ? -1.4426950408889634f : -0.6931471805599453f) * (k < 3 ? ka->in[21][(size_t)ll * 3 * 2 * DFF + (size_t)k * 2 * DFF + col] : ka->in[22][(size_t)ll * 2 * DFF + col]);
                }
            }
            const float* p = ka->in[1]; bf16* PB = (bf16*)(ws + WS_PB);
            const size_t n8 = (size_t)DEPTH * M * PLE / 8;
            for (size_t i = (size_t)bx * 512 + tid; i < n8; i += (size_t)G * 512) {
                const f32x4 a = *(const f32x4*)(p + i * 8), b = *(const f32x4*)(p + i * 8 + 4);
                v4u o; o.x = pk2(a.x, a.y); o.y = pk2(a.z, a.w); o.z = pk2(b.x, b.y); o.w = pk2(b.z, b.w);
                *(v4u*)(PB + i * 8) = o;
            }
        }
    GRID_BAR(0);
    for (int l = 0; l < DEPTH; ++l) {
        const size_t wl = WS_W + (size_t)l * W_LAYER;
        if ((PH_MASK & (1 << 1)) && IN(8 * l + 1)) { for (int rep_ = 0; rep_ < ((REPEAT_MASK >> 1) & 1) + 1; ++rep_) { if (rep_) { XcdBarrier gb_; gb_.bar = (unsigned*)(kargs()->ws + WS_CTL) + CW_BAR; gb_.x = xb_xcc_id(); gb_.st = (volatile LAS unsigned*)(L + MISC_OFF) + 8; xcd_barrier(gb_); }
            PHASE_PTRS;
            pg8::Gemm g{l == 0 ? (const bf16*)(ws + WS_HB) : (const bf16*)ka->out, (const bf16*)(ws + wl + W_IN), M, DINP, D}; pg8::StatOrder So; So.init(M, DINP, G, bx); So.ss_sel = l; So.row62 = 0; So.wave = wv; So.cwt_layer = 0;
            pg8::EpiZ E{l};
            pg8::gemm_phase<pg8::EpiZ, pg8::StatOrder, true, true, false, D>(L + RING_OFF, g, So, E, wv);
            {
                pg8::Gemm gp{(const bf16*)(ws + WS_PB) + (size_t)l * M * PLE, (const bf16*)(ws + wl + W_PP), M, D, PLE}; pg8::TailOrder To; To.init(M, D, G, bx);
                To.c0 = ((M / 256) * (DINP / 256)) % G; To.u0 = 0; To.u1 = 256; if (To.c0 == 0) To.u1 = 0;
                pg8::EpiPP Ep{0};
                pg8::gemm_phase<pg8::EpiPP, pg8::TailOrder, true, true, false, PLE>(L + RING_OFF, gp, To, Ep, wv); }
        } }
        GRID_BAR(8 * l + 1);
        if ((PH_MASK & (1 << 2)) && IN(8 * l + 2)) { for (int rep_ = 0; rep_ < ((REPEAT_MASK >> 2) & 1) + 1; ++rep_) { if (rep_) { XcdBarrier gb_; gb_.bar = (unsigned*)(kargs()->ws + WS_CTL) + CW_BAR; gb_.x = xb_xcc_id(); gb_.st = (volatile LAS unsigned*)(L + MISC_OFF) + 8; xcd_barrier(gb_); }
            PHASE_PTRS;
            mid::lru_load_table(ka, l, (mid::lptr)L, wv);
            for (int u = vcu; u < 256; ) {
                const KArgs k2 = kargs(); const int b = u >> 5, tt = u & 31;
                int w2 = wv;
                asm volatile("" : "+s"(w2)); mid::p2_forget(kargs(), l, b, tt, (mid::lptr)(L + RING_OFF), w2);
                asm volatile("" : "+s"(w2)); mid::lru_pass1(kargs(), l, b, tt, (mid::lptr)(L + RING_OFF), w2);
                asm volatile("" : "+s"(w2)); mid::p2_latent(k2, l, b * S + 128 * tt, (mid::lptr)(L + RING_OFF), w2);
                int g2 = gridDim.x; asm volatile("" : "+s"(g2)); u += g2;
            }
        } }
        GRID_BAR(8 * l + 2);
        if ((PH_MASK & (1 << 3)) && IN(8 * l + 3)) { for (int rep_ = 0; rep_ < ((REPEAT_MASK >> 3) & 1) + 1; ++rep_) { if (rep_) { XcdBarrier gb_; gb_.bar = (unsigned*)(kargs()->ws + WS_CTL) + CW_BAR; gb_.x = xb_xcc_id(); gb_.st = (volatile LAS unsigned*)(L + MISC_OFF) + 8; xcd_barrier(gb_); }
            PHASE_PTRS;
            for (int v = vcu; v < 256; ) {
                const int stream = v >> 2, s4 = v & 3, mixer = stream & 1, bh = stream >> 1, b = bh >> 2, h = bh & 3;
                if (mixer == 0) {
                    for (int i = 0; i < 2; ++i) {
                        const int qb = (i == 0) ? 7 - s4 : s4;
                        unsigned char* ws = kargs()->ws;
                        att::attn_unit<6, false>((const bf16*)(ws + WS_Q) + (size_t)b * S * 384 + h * 96, 384, (const bf16*)(ws + WS_K) + (size_t)b * S * 384 + h * 96, 384,
                                                 (const bf16*)(ws + WS_V) + (size_t)b * S * 256 + h * 64, 256, (bf16*)(ws + WS_O) + (size_t)b * S * D + h * 64, D, nullptr, 0, qb, (att::lptr)(L + RING_OFF), wv);
                    }
                } else {
                    for (int i = 0; i < 2; ++i) {
                        const int qb = (i == 0) ? 7 - s4 : s4;
                        unsigned char* ws = kargs()->ws;
                        att::attn_unit<4, true>((const bf16*)(ws + WS_Z) + (size_t)b * S * DINP + O_FQ + h * 64, DINP, (const bf16*)(ws + WS_Z) + (size_t)b * S * DINP + O_FK + h * 64, DINP,
                                                (const bf16*)(ws + WS_Z) + (size_t)b * S * DINP + O_FV + h * 64, DINP, (bf16*)(ws + WS_O) + (size_t)b * S * D + 256 + h * 64, D,
                                                (const float*)(ws + WS_CBX) + (size_t)b * 64 * 256, h, qb, (att::lptr)(L + RING_OFF), wv);
                    }
                }
                int g2 = gridDim.x; asm volatile("" : "+s"(g2)); v += g2;
            }
        } }
        GRID_BAR(8 * l + 3);
        if ((PH_MASK & (1 << 4)) && IN(8 * l + 4)) { for (int rep_ = 0; rep_ < ((REPEAT_MASK >> 4) & 1) + 1; ++rep_) { if (rep_) { XcdBarrier gb_; gb_.bar = (unsigned*)(kargs()->ws + WS_CTL) + CW_BAR; gb_.x = xb_xcc_id(); gb_.st = (volatile LAS unsigned*)(L + MISC_OFF) + 8; xcd_barrier(gb_); }
            PHASE_PTRS;
            for (int u = vcu; u < 256; ) {
                const KArgs k2 = kargs(); const int b = u >> 5, tt = u & 31;
                int w2 = wv; asm volatile("" : "+s"(w2)); mid::lru_pass2(k2, l, b, tt, (mid::lptr)(L + RING_OFF), w2);
                __syncthreads();
                int g2 = gridDim.x; asm volatile("" : "+s"(g2)); u += g2;
            }
        } }
        GRID_BAR(8 * l + 4);
        if ((PH_MASK & (1 << 5)) && IN(8 * l + 5)) {
            PHASE_PTRS;
            pg8::Gemm g{(const bf16*)(ws + WS_O), (const bf16*)(ws + wl + W_O), M, D, D}; pg8::StaticOrder So; So.init(M, D, G, bx);
            pg8::EpiRes<0> E{l == 0 ? 0 : 1, 0, l == 0 ? 1 : 0};
            pg8::gemm_phase<pg8::EpiRes<0>, pg8::StaticOrder, true, true, false, D>(L + RING_OFF, g, So, E, wv);
        }
        GRID_BAR(8 * l + 5);
        if ((PH_MASK & (1 << 6)) && IN(8 * l + 6)) { for (int rep_ = 0; rep_ < ((REPEAT_MASK >> 6) & 1) + 1; ++rep_) { if (rep_) { XcdBarrier gb_; gb_.bar = (unsigned*)(kargs()->ws + WS_CTL) + CW_BAR; gb_.x = xb_xcc_id(); gb_.st = (volatile LAS unsigned*)(L + MISC_OFF) + 8; xcd_barrier(gb_); }
            PHASE_PTRS;
            pg8::Gemm g{(const bf16*)(ws + WS_HB) - 2 * D, (const bf16*)(ws + wl + W_UP), 133 * 256, 2 * DFF, D}; pg8::StatOrder So; So.init(133 * 256, 2 * DFF, G, bx); So.ss_sel = l == 0 ? 1 : 0; So.row62 = 1; So.wave = wv; So.cwt_layer = l;
            pg8::EpiUp E{l, l == 0 ? 1 : 0};
            pg8::gemm_phase<pg8::EpiUp, pg8::StatOrder, true, true, true, D>(L + RING_OFF, g, So, E, wv);
            {   pg8::Gemm gp{(const bf16*)(ws + WS_PB) + (size_t)l * M * PLE, (const bf16*)(ws + wl + W_PP), M, D, PLE}; pg8::TailOrder To; To.init(M, D, G, bx);
                To.c0 = (133 * (2 * DFF / 256)) % G; To.u0 = (((M / 256) * (DINP / 256)) % G) ? 256 : 0; To.u1 = 512;
                pg8::EpiPP Ep{0};
                pg8::gemm_phase<pg8::EpiPP, pg8::TailOrder, true, true, false, PLE>(L + RING_OFF, gp, To, Ep, wv); }
        } }
        GRID_BAR(8 * l + 6);
        if ((PH_MASK & (1 << 7)) && IN(8 * l + 7)) {
            PHASE_PTRS;
            pg8::Gemm g{(const bf16*)(ws + WS_ACT), (const bf16*)(ws + wl + W_DN), M, D, DFF}; pg8::StaticOrder So; So.init(M, D, G, bx);
            pg8::EpiRes<0> E{0, 0, l == 0 ? 0 : 1};
            pg8::gemm_phase<pg8::EpiRes<0>, pg8::StaticOrder, true, true, false, DFF>(L + RING_OFF, g, So, E, wv);
        }
        GRID_BAR(8 * l + 7);
        if ((PH_MASK & (1 << 8)) && IN(8 * l + 8)) {
            PHASE_PTRS;
            {   pg8::Gemm g{(const bf16*)(ws + WS_HB), (const bf16*)(ws + wl + W_PG), M, D, D}; pg8::StatOrder So; So.init(M, D, G, bx); So.ss_sel = l == 0 ? 0 : 1; So.row62 = 0; So.wave = wv; So.cwt_layer = 0;
                pg8::EpiRes<1> E{0, l == 0 ? 1 : 2, l == 0 ? 1 : 0};
                pg8::gemm_phase<pg8::EpiRes<1>, pg8::StatOrder, true, true, false, D>(L + RING_OFF, g, So, E, wv); }
        }
        GRID_BAR(8 * l + 8);
    }
    if ((PH_MASK & (1 << 17)) && IN(17)) {
            PHASE_PTRS; LANE_IDS; const float* gf = ka->in[27]; const float* ss = (const float*)(ws + WS_SSA); float* H = ka->out;
            const bf16* hb = (const bf16*)(ws + WS_O);
            for (int m = gw; m < M; m += NGW) {
                const float rs = pg8::rstd16(ss, m);
#pragma unroll
                for (int j = 0; j < 2; ++j) { const v4u w = *((const GAS v4u*)(hb + (size_t)m * D) + lane + 64 * j); const int c0 = (lane + 64 * j) * 8;
                    const f32x4 g0 = *(const GAS f32x4*)(gf + c0), g1 = *(const GAS f32x4*)(gf + c0 + 4);
                    f32x4 o0 = {pg8::bf_lo(w.x), pg8::bf_hi(w.x), pg8::bf_lo(w.y), pg8::bf_hi(w.y)}, o1 = {pg8::bf_lo(w.z), pg8::bf_hi(w.z), pg8::bf_lo(w.w), pg8::bf_hi(w.w)};
                    o0 = o0 * rs * g0; o1 = o1 * rs * g1;
                    *(GAS f32x4*)(H + (size_t)m * D + c0) = o0; *(GAS f32x4*)(H + (size_t)m * D + c0 + 4) = o1; }
            }
    }
}

extern "C" void kernel_launch(void* const* d_in, const int* in_sizes, int n_in, void* d_out, int out_size, void* d_ws, size_t ws_size, hipStream_t stream) {
    static int grid = 0;
    if (grid == 0) {
        int dev = 0, cus = 0;
        if (hipGetDevice(&dev) != hipSuccess || hipDeviceGetAttribute(&cus, hipDeviceAttributeMultiprocessorCount, dev) != hipSuccess) { grid = -1; return; }
        if (hipFuncSetAttribute((const void*)mega, hipFuncAttributeMaxDynamicSharedMemorySize, LDS_BYTES) != hipSuccess) { fprintf(stderr, "hipFuncSetAttribute failed\n"); grid = -1; return; }
        grid = cus;
        if (ws_size < WS_END) { fprintf(stderr, "workspace too small: %zu < %zu\n", ws_size, (size_t)WS_END); grid = -1; return; }
    }
    if (grid < 0) return;
    (void)hipMemsetAsync((char*)d_ws + WS_CTL, 0, CTL_ZERO_BYTES, stream);
    Args a{};
    for (int i = 0; i < 28; ++i) a.in[i] = (const float*)d_in[i];
    a.out = (float*)d_out; a.ws = (unsigned char*)d_ws;
#ifndef N_LAUNCH_MODE
#define N_LAUNCH_MODE 1
#endif
    auto run = [&](int lo, int hi) { a.ph_lo = lo; a.ph_hi = hi; hipLaunchKernelGGL(mega, dim3(grid), dim3(NWAVES * 64), LDS_BYTES, stream, a); };
    if (N_LAUNCH_MODE == 1) run(0, 18);
    else for (int ph = 0; ph < 18; ++ph) run(ph, ph + 1);
}
```
